# Optimizing an MI355X kernel written in HIP

```python
import jax, jax.numpy as jnp
from jax import lax
import numpy as np

D_MODEL = 2048
BATCH = 2
SEQ = 16384
DEPTH = 4

HEAD_DIM = 128
Q_BLOCK = 128
RMS_EPS = 1e-6
NEG_INF = -1e30

MLA_HEADS = 6
MLA_Q_LORA = 512
MLA_KV_LORA = 512
MLA_NOPE = 128
MLA_ROPE = 64
MLA_V = 128
ROPE_BASE = 10000.0

DIL_PAIRS = ((128, 1), (512, 4), (2048, 16))
DIL_HEADS_PER_GROUP = 2
DIL_HEADS = DIL_HEADS_PER_GROUP * len(DIL_PAIRS)

NSA_HEADS = 4
NSA_CMP_LEN = 32
NSA_CMP_STRIDE = 16
NSA_SEL_LEN = 64
NSA_TOPK = 16
NSA_WINDOW = 512
NSA_FORCED_SCORE = 100.0

N_ALIBI = DIL_HEADS + NSA_HEADS

D_FF = 5504

IN_SPLITS = (MLA_Q_LORA, MLA_KV_LORA, MLA_ROPE,
             DIL_HEADS * HEAD_DIM, DIL_HEADS * HEAD_DIM, DIL_HEADS * HEAD_DIM,
             NSA_HEADS * HEAD_DIM,
             HEAD_DIM, HEAD_DIM, HEAD_DIM, HEAD_DIM, HEAD_DIM, HEAD_DIM,
             NSA_HEADS * 3)
IN_COLS = sum(IN_SPLITS)
IN_SPLIT_POINTS = [int(c) for c in np.cumsum(IN_SPLITS)[:-1]]
MIX_OUT = MLA_HEADS * MLA_V + DIL_HEADS * HEAD_DIM + NSA_HEADS * HEAD_DIM

kernel_name = 'hybrid_mla_dilated_nsa_macaron'


def rms_norm(x, g):
    xf = x.astype(jnp.float32)
    y = xf * lax.rsqrt(jnp.mean(xf * xf, axis=-1, keepdims=True) + RMS_EPS)
    return (y * g.astype(jnp.float32)).astype(x.dtype)


def swiglu_ffn(x, w_in, w_out):
    gate, up = jnp.split(x @ w_in, 2, axis=-1)
    return (jax.nn.silu(gate) * up) @ w_out


def alibi_slopes():
    return 2.0 ** (-8.0 * jnp.arange(1, N_ALIBI + 1, dtype=jnp.float32) / N_ALIBI)


def apply_rope(x, pos):
    half = x.shape[-1] // 2
    inv_freq = ROPE_BASE ** (-jnp.arange(half, dtype=jnp.float32) / half)
    ang = pos.astype(jnp.float32)[:, None] * inv_freq[None, :]
    cos, sin = jnp.cos(ang)[:, None, :], jnp.sin(ang)[:, None, :]
    xf = x.astype(jnp.float32)
    x1, x2 = xf[..., :half], xf[..., half:]
    return jnp.concatenate([x1 * cos - x2 * sin, x2 * cos + x1 * sin], axis=-1).astype(x.dtype)


def masked_softmax(s, mask):
    s = jnp.where(mask, s.astype(jnp.float32), NEG_INF)
    p = jax.nn.softmax(s, axis=-1)
    return jnp.where(mask, p, 0.0)


def mla_attention(q_lat, kv_lat, k_rope, q_norm, w_uq, kv_norm, w_ukv):
    B, S, _ = q_lat.shape
    pos = jnp.arange(S)
    q = (rms_norm(q_lat, q_norm) @ w_uq).reshape(B, S, MLA_HEADS, MLA_NOPE + MLA_ROPE)
    q = jnp.concatenate([q[..., :MLA_NOPE], apply_rope(q[..., MLA_NOPE:], pos)], axis=-1)
    kv = (rms_norm(kv_lat, kv_norm) @ w_ukv).reshape(B, S, MLA_HEADS, MLA_NOPE + MLA_V)
    k_pe = jnp.broadcast_to(apply_rope(k_rope[:, :, None, :], pos), (B, S, MLA_HEADS, MLA_ROPE))
    k = jnp.concatenate([kv[..., :MLA_NOPE], k_pe], axis=-1)
    v = kv[..., MLA_NOPE:]
    scale = (MLA_NOPE + MLA_ROPE) ** -0.5
    nb = S // Q_BLOCK
    q_blocks = q.reshape(B, nb, Q_BLOCK, MLA_HEADS, -1).transpose(1, 0, 2, 3, 4)

    def block(args):
        qb, i = args
        t = i * Q_BLOCK + jnp.arange(Q_BLOCK)
        s = jnp.einsum('bqhd,bkhd->bhqk', qb, k).astype(jnp.float32) * scale
        p = masked_softmax(s, pos[None, :] <= t[:, None])
        return jnp.einsum('bhqk,bkhd->bqhd', p.astype(v.dtype), v)

    o = lax.map(block, (q_blocks, jnp.arange(nb)))
    return o.transpose(1, 0, 2, 3, 4).reshape(B, S, MLA_HEADS * MLA_V)


def dilated_group(q, k, v, window, dilation, slopes):
    B, S, Hg, Dh = q.shape
    span = window // dilation
    L = S // dilation
    nb = -(-L // Q_BLOCK)
    Lp = nb * Q_BLOCK
    Z = B * dilation

    def strided(x):
        x = x.reshape(B, L, dilation, Hg, Dh).transpose(0, 2, 1, 3, 4).reshape(Z, L, Hg, Dh)
        return jnp.pad(x, ((0, 0), (0, Lp - L), (0, 0), (0, 0)))

    def band_keys(x):
        xb = jnp.pad(x, ((0, 0), (Q_BLOCK, 0), (0, 0), (0, 0))).reshape(Z, nb + 1, Q_BLOCK, Hg, Dh)
        return jnp.concatenate([xb[:, :-1], xb[:, 1:]], axis=2)

    qb = strided(q).reshape(Z, nb, Q_BLOCK, Hg, Dh)
    kb, vb = band_keys(strided(k)), band_keys(strided(v))
    a = jnp.arange(Q_BLOCK)[:, None]
    c = jnp.arange(2 * Q_BLOCK)[None, :]
    j = Q_BLOCK + a - c
    kpos = (jnp.arange(nb)[:, None, None] - 1) * Q_BLOCK + c[None]
    mask = ((j >= 0) & (j <= span))[None] & (kpos >= 0)
    mask = mask[:, None]
    s = jnp.einsum('znqhd,znkhd->znhqk', qb, kb).astype(jnp.float32) * (Dh ** -0.5)
    s = s - slopes[:, None, None] * (j * dilation).astype(jnp.float32)
    s = jnp.where(mask, s, NEG_INF)
    m = jnp.max(s, axis=-1, keepdims=True)
    e = jnp.where(mask, jnp.exp(s - m), 0.0)
    den = jnp.sum(e, axis=-1, keepdims=True)
    o = jnp.einsum('znhqk,znkhd->znqhd', (e / den).astype(vb.dtype), vb)
    lse = (m + jnp.log(den))[..., 0]
    o = o.reshape(Z, Lp, Hg, Dh)[:, :L].reshape(B, dilation, L, Hg, Dh)
    o = o.transpose(0, 2, 1, 3, 4).reshape(B, S, Hg, Dh)
    lse = lse.transpose(0, 1, 3, 2).reshape(Z, Lp, Hg)[:, :L].reshape(B, dilation, L, Hg)
    lse = lse.transpose(0, 2, 1, 3).reshape(B, S, Hg)
    return o, lse


def dilated_mixture(q, k, v, slopes):
    B, S, _, Dh = q.shape
    outs, lses = [], []
    for g, (window, dilation) in enumerate(DIL_PAIRS):
        sl = slice(g * DIL_HEADS_PER_GROUP, (g + 1) * DIL_HEADS_PER_GROUP)
        o, lse = dilated_group(q[:, :, sl], k[:, :, sl], v[:, :, sl], window, dilation, slopes[sl])
        outs.append(o)
        lses.append(lse)
    alpha = jax.nn.softmax(jnp.stack(lses, axis=0), axis=0)
    o = jnp.stack(outs, axis=0) * alpha[..., None].astype(outs[0].dtype)
    return o.transpose(1, 2, 0, 3, 4).reshape(B, S, DIL_HEADS * Dh)


def nsa_compress(x, pos_emb, w1, w2):
    B, S, Dh = x.shape
    nc = (S - NSA_CMP_LEN) // NSA_CMP_STRIDE + 1
    idx = jnp.arange(nc)[:, None] * NSA_CMP_STRIDE + jnp.arange(NSA_CMP_LEN)[None, :]
    blocks = x[:, idx] + pos_emb
    h = jax.nn.silu(blocks.reshape(B, nc, NSA_CMP_LEN * Dh) @ w1)
    return h @ w2


def nsa_attention(q, k_cmp, v_cmp, k_slc, v_slc, k_win, v_win, gate_logits,
                  cmp_pos, phi_k1, phi_k2, phi_v1, phi_v2, slopes):
    B, S, H, Dh = q.shape
    kc = nsa_compress(k_cmp, cmp_pos, phi_k1, phi_k2)
    vc = nsa_compress(v_cmp, cmp_pos, phi_v1, phi_v2)
    nc = kc.shape[1]
    ns = S // NSA_SEL_LEN
    topk = min(NSA_TOPK, ns)
    c_start = jnp.arange(nc) * NSA_CMP_STRIDE
    c_end = c_start + NSA_CMP_LEN - 1
    c_centre = c_start.astype(jnp.float32) + 0.5 * (NSA_CMP_LEN - 1)
    j_idx = jnp.arange(ns)
    cmp_to_sel = ((c_start[:, None] < (j_idx[None, :] + 1) * NSA_SEL_LEN)
                  & (c_end[:, None] >= j_idx[None, :] * NSA_SEL_LEN)).astype(jnp.float32)
    pad = ((0, 0), (NSA_WINDOW, 0), (0, 0))
    k_win_p, v_win_p = jnp.pad(k_win, pad), jnp.pad(v_win, pad)
    gates = jax.nn.sigmoid(gate_logits.astype(jnp.float32)).reshape(B, S, H, 3)
    nb = S // Q_BLOCK
    q_blocks = q.reshape(B, nb, Q_BLOCK, H, Dh).transpose(1, 0, 2, 3, 4)
    g_blocks = gates.reshape(B, nb, Q_BLOCK, H, 3).transpose(1, 0, 2, 3, 4)
    slope = slopes[:, None, None]
    scale = Dh ** -0.5
    gather = jax.vmap(lambda seq, idx: seq[idx])

    def block(args):
        qb, gb, i = args
        t = i * Q_BLOCK + jnp.arange(Q_BLOCK)
        tf = t.astype(jnp.float32)
        s = jnp.einsum('bqhd,bcd->bhqc', qb, kc).astype(jnp.float32) * scale
        s = s - slope * (tf[:, None] - c_centre[None, :])
        p_cmp = masked_softmax(s, c_end[None, :] <= t[:, None])
        o_cmp = jnp.einsum('bhqc,bcd->bqhd', p_cmp.astype(vc.dtype), vc)
        score = jnp.einsum('bhqc,cj->bqj', p_cmp, cmp_to_sel)
        cur = (t // NSA_SEL_LEN)[:, None]
        jj = j_idx[None, :]
        forced = (jj == 0) | (jj == cur) | (jj == cur - 1)
        score = jnp.where(jj > cur, -1.0, jnp.where(forced, NSA_FORCED_SCORE, score))
        _, sel = lax.top_k(score, topk)
        kpos = (sel[..., None] * NSA_SEL_LEN + jnp.arange(NSA_SEL_LEN)).reshape(B, Q_BLOCK, topk * NSA_SEL_LEN)
        kg, vg = gather(k_slc, kpos), gather(v_slc, kpos)
        dist = t[None, :, None] - kpos
        s = jnp.einsum('bqhd,bqnd->bhqn', qb, kg).astype(jnp.float32) * scale
        s = s - slope * dist[:, None].astype(jnp.float32)
        p = masked_softmax(s, (dist >= 0)[:, None])
        o_slc = jnp.einsum('bhqn,bqnd->bqhd', p.astype(vg.dtype), vg)
        kw = lax.dynamic_slice_in_dim(k_win_p, i * Q_BLOCK, NSA_WINDOW + Q_BLOCK, axis=1)
        vw = lax.dynamic_slice_in_dim(v_win_p, i * Q_BLOCK, NSA_WINDOW + Q_BLOCK, axis=1)
        wpos = i * Q_BLOCK - NSA_WINDOW + jnp.arange(NSA_WINDOW + Q_BLOCK)
        dist = t[:, None] - wpos[None, :]
        s = jnp.einsum('bqhd,bkd->bhqk', qb, kw).astype(jnp.float32) * scale
        s = s - slope * dist.astype(jnp.float32)
        p = masked_softmax(s, (dist >= 0) & (dist < NSA_WINDOW) & (wpos[None, :] >= 0))
        o_win = jnp.einsum('bhqk,bkd->bqhd', p.astype(vw.dtype), vw)
        g = gb.astype(o_cmp.dtype)
        return g[..., 0:1] * o_cmp + g[..., 1:2] * o_slc + g[..., 2:3] * o_win

    o = lax.map(block, (q_blocks, g_blocks, jnp.arange(nb)))
    return o.transpose(1, 0, 2, 3, 4).reshape(B, S, H * Dh)


def setup_inputs(seed: int = 0) -> dict:
    key = jax.random.key(seed)
    ks = jax.random.split(key, 20)

    def w(k, shape, fan_in):
        return jax.random.normal(k, shape, jnp.float32) * (fan_in ** -0.5)

    def gain(k, n):
        return 1.0 + 0.02 * jax.random.normal(k, (DEPTH, n), jnp.float32)

    return {
        'x': jax.random.normal(ks[0], (BATCH, SEQ, D_MODEL), jnp.float32),
        'ffn1_norm': gain(ks[1], D_MODEL),
        'ffn1_w_in': w(ks[2], (DEPTH, D_MODEL, 2 * D_FF), D_MODEL),
        'ffn1_w_out': w(ks[3], (DEPTH, D_FF, D_MODEL), D_FF),
        'mix_norm': gain(ks[4], D_MODEL),
        'w_mix_in': w(ks[5], (DEPTH, D_MODEL, IN_COLS), D_MODEL),
        'mla_q_norm': gain(ks[6], MLA_Q_LORA),
        'mla_w_uq': w(ks[7], (DEPTH, MLA_Q_LORA, MLA_HEADS * (MLA_NOPE + MLA_ROPE)), MLA_Q_LORA),
        'mla_kv_norm': gain(ks[8], MLA_KV_LORA),
        'mla_w_ukv': w(ks[9], (DEPTH, MLA_KV_LORA, MLA_HEADS * (MLA_NOPE + MLA_V)), MLA_KV_LORA),
        'nsa_cmp_pos': 0.1 * jax.random.normal(ks[10], (DEPTH, NSA_CMP_LEN, HEAD_DIM), jnp.float32),
        'nsa_phi_k1': w(ks[11], (DEPTH, NSA_CMP_LEN * HEAD_DIM, HEAD_DIM), NSA_CMP_LEN * HEAD_DIM),
        'nsa_phi_k2': w(ks[12], (DEPTH, HEAD_DIM, HEAD_DIM), HEAD_DIM),
        'nsa_phi_v1': w(ks[13], (DEPTH, NSA_CMP_LEN * HEAD_DIM, HEAD_DIM), NSA_CMP_LEN * HEAD_DIM),
        'nsa_phi_v2': w(ks[14], (DEPTH, HEAD_DIM, HEAD_DIM), HEAD_DIM),
        'w_mix_out': w(ks[15], (DEPTH, MIX_OUT, D_MODEL), MIX_OUT),
        'ffn2_norm': gain(ks[16], D_MODEL),
        'ffn2_w_in': w(ks[17], (DEPTH, D_MODEL, 2 * D_FF), D_MODEL),
        'ffn2_w_out': w(ks[18], (DEPTH, D_FF, D_MODEL), D_FF),
        'final_norm': 1.0 + 0.02 * jax.random.normal(ks[19], (D_MODEL,), jnp.float32),
    }


def reference(x, ffn1_norm, ffn1_w_in, ffn1_w_out, mix_norm, w_mix_in, mla_q_norm, mla_w_uq,
              mla_kv_norm, mla_w_ukv, nsa_cmp_pos, nsa_phi_k1, nsa_phi_k2, nsa_phi_v1, nsa_phi_v2,
              w_mix_out, ffn2_norm, ffn2_w_in, ffn2_w_out, final_norm):
    B, S, _ = x.shape
    slopes = alibi_slopes()
    dil_slopes, nsa_slopes = slopes[:DIL_HEADS], slopes[DIL_HEADS:]
    for l in range(DEPTH):
        x = x + 0.5 * swiglu_ffn(rms_norm(x, ffn1_norm[l]), ffn1_w_in[l], ffn1_w_out[l])
        h = rms_norm(x, mix_norm[l]) @ w_mix_in[l]
        (q_lat, kv_lat, k_rope, dq, dk, dv, nq,
         nkc, nvc, nks, nvs, nkw, nvw, ng) = jnp.split(h, IN_SPLIT_POINTS, axis=-1)
        o_mla = mla_attention(q_lat, kv_lat, k_rope, mla_q_norm[l], mla_w_uq[l],
                              mla_kv_norm[l], mla_w_ukv[l])
        o_dil = dilated_mixture(dq.reshape(B, S, DIL_HEADS, HEAD_DIM),
                                dk.reshape(B, S, DIL_HEADS, HEAD_DIM),
                                dv.reshape(B, S, DIL_HEADS, HEAD_DIM), dil_slopes)
        o_nsa = nsa_attention(nq.reshape(B, S, NSA_HEADS, HEAD_DIM), nkc, nvc, nks, nvs, nkw, nvw, ng,
                              nsa_cmp_pos[l], nsa_phi_k1[l], nsa_phi_k2[l], nsa_phi_v1[l], nsa_phi_v2[l],
                              nsa_slopes)
        x = x + jnp.concatenate([o_mla, o_dil, o_nsa], axis=-1) @ w_mix_out[l]
        x = x + 0.5 * swiglu_ffn(rms_norm(x, ffn2_norm[l]), ffn2_w_in[l], ffn2_w_out[l])
    return rms_norm(x, final_norm)
```

```cpp
#include <hip/hip_runtime.h>
#include <cstdio>
#include <cstdint>

#define LAS __attribute__((address_space(3)))
#define GAS __attribute__((address_space(1)))
typedef unsigned short bf16_t;
typedef short bf16x8 __attribute__((ext_vector_type(8)));
typedef short s16x4 __attribute__((ext_vector_type(4)));
typedef float f32x4 __attribute__((ext_vector_type(4)));
typedef float f32x16 __attribute__((ext_vector_type(16)));
typedef float f32x2 __attribute__((ext_vector_type(2)));
typedef unsigned u32x4 __attribute__((ext_vector_type(4)));
typedef unsigned u32x2 __attribute__((ext_vector_type(2)));
typedef GAS unsigned gu32;

constexpr int BATCH = 2, SEQ = 16384, M = BATCH * SEQ, DM = 2048, FF = 5504, NFF = 2 * FF, DEPTH = 4;
constexpr int NMIX = 4864, NMIX_LOG = 4684, NUP = 2816, LATW = 1024;
constexpr float RMS_EPS = 1e-6f;

__device__ __forceinline__ unsigned cvt_pk_bf16(float lo, float hi) { unsigned r; asm volatile("v_cvt_pk_bf16_f32 %0, %1, %2" : "=v"(r) : "v"(lo), "v"(hi)); return r; }
__device__ __forceinline__ float shx(float v, int mask, int lane) { return __int_as_float(__builtin_amdgcn_ds_bpermute((lane ^ mask) << 2, __float_as_int(v))); }
__device__ __forceinline__ unsigned shxu(unsigned v, int mask, int lane) { return (unsigned)__builtin_amdgcn_ds_bpermute((lane ^ mask) << 2, (int)v); }
__device__ __forceinline__ __amdgpu_buffer_rsrc_t mk_rsrc(const void* p) {
    const uintptr_t a = (uintptr_t)p; const unsigned lo = __builtin_amdgcn_readfirstlane((unsigned)a), hi = __builtin_amdgcn_readfirstlane((unsigned)(a >> 32));
    return __builtin_amdgcn_make_buffer_rsrc((void*)(((uintptr_t)hi << 32) | lo), 0, 0x7ffffff0, 0x00020000); }
__device__ __forceinline__ bf16x8 ld_sc1(__amdgpu_buffer_rsrc_t r, int byte_off) { const u32x4 v = __builtin_amdgcn_raw_buffer_load_b128(r, byte_off, 0, 16); return __builtin_bit_cast(bf16x8, v); }
#define LDS_WAIT() asm volatile("s_waitcnt lgkmcnt(0)" ::: "memory")
#define VM_WAIT() asm volatile("s_waitcnt vmcnt(0)" ::: "memory")

namespace pg8 {
constexpr int BM = 256, BK = 64, HALF = 128, HTB = HALF * BK * 2, STAGE_BYTES = 8 * HTB, NXCD = 8, WGM = 8;
__host__ __device__ __forceinline__ int lds_byte(int r, int c) { const int st = (r >> 4) * 2 + (c >> 5), rr = r & 15, cc = c & 31, ob = rr * 64 + cc * 2; return st * 1024 + (ob ^ (((ob >> 9) & 1) << 5)); }
__host__ __device__ __forceinline__ void stage_rc(int b, int& R, int& C) { const int st = b / 1024, sb = b % 1024, swz = sb ^ (((sb >> 9) & 1) << 5); R = (st >> 1) * 16 + swz / 64; C = (st & 1) * 32 + (swz % 64) / 2; }
__host__ __device__ __forceinline__ int perm32(int rho) { const int n = rho >> 4, i = rho & 15; return 8 * (i >> 2) + 4 * n + (i & 3); }
struct Unit { int pm, pn; };
struct Gemm { const bf16_t* A; const bf16_t* Bt; int M, N, K, lda; };
struct StaticOrder {
    int nM, nN, nwg, G, c, acol_pn, acol_off, wgm = 4;
    __device__ void init(int M_, int N_, int G_, int c_) { nM = M_ / BM; nN = N_ / BM; nwg = nM * nN; G = G_; c = c_; acol_pn = 1 << 30; acol_off = 0; }
    __device__ bool next(int i, Unit& u) const {
        if (c < 0) return false;
        const long L = (long)i * G + c; if (L >= nwg) return false;
        int wgid = (int)L; { const int q = nwg / NXCD, r = nwg % NXCD, xcd = wgid % NXCD, off = wgid / NXCD; wgid = (xcd < r ? xcd * (q + 1) : r * (q + 1) + (xcd - r) * q) + off; }
        const int nig = wgm * nN, gid = wgid / nig, fm = gid * wgm, gsz = (nM - fm) < wgm ? (nM - fm) : wgm;
        u.pm = fm + ((wgid % nig) % gsz); u.pn = (wgid % nig) / gsz; return true;
    }
    __device__ __forceinline__ int acol(const Unit& u) const { return u.pn >= acol_pn ? acol_off : 0; }
};

struct ChainOrder : StaticOrder {
    static constexpr bool CHAIN = true;
    const unsigned* need_cnt; unsigned need; unsigned* done_cnt; unsigned* tmo;
    __device__ __forceinline__ unsigned peek(const Unit& u, bool valid, int wid) const {
        if (need_cnt != nullptr && valid && wid == 0) return __hip_atomic_load(need_cnt + 16 * u.pm, __ATOMIC_RELAXED, __HIP_MEMORY_SCOPE_AGENT);
        return 0u; }
    __device__ __forceinline__ void a_ready(const Unit& u, bool valid, int wid, unsigned first = 0u) const {
        if (need_cnt != nullptr && valid) {
            if (wid == 0) {
                const unsigned* p = need_cnt + 16 * u.pm; unsigned sp = 0u;
                if ((unsigned)__builtin_amdgcn_readfirstlane(first) < need)
                while ((unsigned)__builtin_amdgcn_readfirstlane(__hip_atomic_load(p, __ATOMIC_RELAXED, __HIP_MEMORY_SCOPE_AGENT)) < need) {
                    __builtin_amdgcn_s_sleep(2);
                    if ((++sp & 255u) == 0u) { if (__builtin_amdgcn_readfirstlane(__hip_atomic_load(tmo, __ATOMIC_RELAXED, __HIP_MEMORY_SCOPE_AGENT)) != 0u) break;
                        if (sp > (1u << 18)) { __hip_atomic_store(tmo, 1u, __ATOMIC_RELAXED, __HIP_MEMORY_SCOPE_AGENT); break; } } }
                asm volatile("buffer_inv sc0\n\ts_waitcnt vmcnt(0)" ::: "memory");
            }
            asm volatile("" ::: "memory"); __builtin_amdgcn_s_barrier(); asm volatile("" ::: "memory");
        }
    }
    __device__ __forceinline__ void done(const Unit& u, int lane) const {
        if (done_cnt != nullptr) { asm volatile("s_waitcnt vmcnt(0)" ::: "memory");
            if (lane == 0) (void)__hip_atomic_fetch_add(done_cnt + 16 * u.pm, 1u, __ATOMIC_RELAXED, __HIP_MEMORY_SCOPE_AGENT); }
    }
};
template <class T> struct is_chain { static constexpr bool v = false; };
template <> struct is_chain<ChainOrder> { static constexpr bool v = true; };
template <class Epi, class Sched, bool ALIGN_EPI>
__device__ __forceinline__ void gemm_phase(LAS unsigned char* lds, const Gemm g, const Sched& S, const Epi& E, const int tid) {
    const int wid = __builtin_amdgcn_readfirstlane(tid >> 6), lane = tid & 63, wr = wid >> 2, wc = wid & 3, fr = lane & 15, fq = lane >> 4;
    const int K = g.K, nt = K / BK, lda = g.lda;
    unsigned voffA[2], voffB[2];
#pragma unroll
    for (int i = 0; i < 2; ++i) { int R, C; stage_rc(tid * 16 + i * 8192, R, C); const int Rb = Epi::PERM ? ((R & ~31) + perm32(R & 31)) : R;
        voffA[i] = (unsigned)(R * lda + C) * 2u; voffB[i] = (unsigned)(Rb * K + C) * 2u; }
    const size_t kstep = (size_t)(BK * 2);
    const size_t hsA = (size_t)HALF * lda * 2, hsB = (size_t)HALF * K * 2;
    const size_t tsA = 2 * hsA, tsB = 2 * hsB;
    const unsigned ldsw = (unsigned)wid * 1024u;
    const int aoff = lds_byte(wr * 64 + fr, fq * 8), boff = lds_byte(wc * 32 + fr, fq * 8);
#define PG8_SA(b, h) (((b) * 2 + (h)) * HTB)
#define PG8_SB(b, h) ((4 + (b) * 2 + (h)) * HTB)
#define PG8_STAGE(bufoff, gbase, voff) do { _Pragma("unroll") for (int _i = 0; _i < 2; ++_i) \
        __builtin_amdgcn_global_load_lds((const unsigned*)((const char*)(gbase) + (voff)[_i]), (LAS unsigned*)(lds + (bufoff) + ldsw + _i * 8192), 16, 0, 0); } while (0)
#define PG8_LDA(dst, b, h) do { _Pragma("unroll") for (int m = 0; m < 4; ++m) _Pragma("unroll") for (int k = 0; k < 2; ++k) dst[m][k] = *(const LAS bf16x8*)(lds + PG8_SA(b, h) + aoff + m * 2048 + k * 1024); } while (0)
#define PG8_LDB(dst, b, h) do { _Pragma("unroll") for (int n = 0; n < 2; ++n) _Pragma("unroll") for (int k = 0; k < 2; ++k) dst[n][k] = *(const LAS bf16x8*)(lds + PG8_SB(b, h) + boff + n * 2048 + k * 1024); } while (0)
#define PG8_MMA(ai, bj, At, Bt) do { __builtin_amdgcn_s_setprio(1); _Pragma("unroll") for (int m = 0; m < 4; ++m) _Pragma("unroll") for (int n = 0; n < 2; ++n) _Pragma("unroll") for (int k = 0; k < 2; ++k) \
        acc[ai][bj][m][n] = __builtin_amdgcn_mfma_f32_16x16x32_bf16(Bt[n][k], At[m][k], acc[ai][bj][m][n], 0, 0, 0); __builtin_amdgcn_s_setprio(0); } while (0)
#define PG8_WAIT_V(n) asm volatile("s_waitcnt vmcnt(" #n ")" ::: "memory")
#define PG8_WAIT_L(n) asm volatile("s_waitcnt lgkmcnt(" #n ")" ::: "memory")
#define PG8_BAR __builtin_amdgcn_s_barrier()
#define PG8_SCHED __builtin_amdgcn_sched_barrier(0)
    Unit cur, nxt; int ui = 0;
    if (!S.next(0, cur)) return;
    if constexpr (is_chain<Sched>::v) { S.a_ready(cur, true, wid); Unit u1_; const bool h1_ = S.next(1, u1_); S.a_ready(u1_, h1_, wid); }
    f32x4 acc[2][2][4][2];
#pragma unroll
    for (int a = 0; a < 2; ++a)
#pragma unroll
        for (int b = 0; b < 2; ++b)
#pragma unroll
            for (int m = 0; m < 4; ++m)
#pragma unroll
                for (int n = 0; n < 2; ++n) acc[a][b][m][n] = (f32x4){0.f, 0.f, 0.f, 0.f};
    bf16x8 At[4][2], B0[2][2], B1[2][2];
    const char* cA = (const char*)g.A + (size_t)cur.pm * tsA + (size_t)S.acol(cur) * 2; const char* cB = (const char*)g.Bt + (size_t)cur.pn * tsB;
    PG8_STAGE(PG8_SB(0, 0), cB, voffB); PG8_STAGE(PG8_SB(0, 1), cB + hsB, voffB); PG8_STAGE(PG8_SA(0, 0), cA, voffA); PG8_STAGE(PG8_SA(0, 1), cA + hsA, voffA);
    if (wr == 1) PG8_BAR;
    PG8_WAIT_V(2); PG8_BAR;
    PG8_STAGE(PG8_SB(1, 0), cB + kstep, voffB); PG8_STAGE(PG8_SA(1, 0), cA + kstep, voffA); PG8_STAGE(PG8_SB(1, 1), cB + hsB + kstep, voffB);
    PG8_WAIT_V(6); PG8_BAR;
    for (;;) {
        const bool has_next = S.next(ui + 1, nxt);
        const char* nA = has_next ? (const char*)g.A + (size_t)nxt.pm * tsA + (size_t)S.acol(nxt) * 2 : cA; const char* nB = has_next ? (const char*)g.Bt + (size_t)nxt.pn * tsB : cB;
        for (int t = 0; t < nt; t += 2) {
            const bool last = (t == nt - 2);
            const char* a1 = cA + (size_t)(t + 1) * kstep;
            const char* a2 = last ? nA : cA + (size_t)(t + 2) * kstep; const char* b2 = last ? nB : cB + (size_t)(t + 2) * kstep;
            const char* a3 = a2 + kstep; const char* b3 = b2 + kstep;
            PG8_LDB(B0, 0, 0); PG8_LDB(B1, 0, 1); PG8_SCHED; PG8_LDA(At, 0, 0); PG8_STAGE(PG8_SA(1, 1), a1 + hsA, voffA);
            PG8_WAIT_V(8); PG8_WAIT_L(0); PG8_BAR; PG8_MMA(0, 0, At, B0); PG8_MMA(0, 1, At, B1); PG8_BAR; PG8_SCHED;
            PG8_LDA(At, 0, 1); PG8_STAGE(PG8_SB(0, 0), b2, voffB); PG8_STAGE(PG8_SB(0, 1), b2 + hsB, voffB); PG8_STAGE(PG8_SA(0, 0), a2, voffA);
            PG8_WAIT_V(8); PG8_WAIT_L(0); PG8_BAR; PG8_MMA(1, 0, At, B0); PG8_MMA(1, 1, At, B1); PG8_BAR; PG8_SCHED;
            PG8_LDB(B0, 1, 0); PG8_LDB(B1, 1, 1); PG8_SCHED; PG8_LDA(At, 1, 0); PG8_STAGE(PG8_SA(0, 1), a2 + hsA, voffA);
            PG8_WAIT_V(8); PG8_WAIT_L(0); PG8_BAR; PG8_MMA(0, 0, At, B0); PG8_MMA(0, 1, At, B1); PG8_BAR; PG8_SCHED;
            PG8_LDA(At, 1, 1); PG8_STAGE(PG8_SB(1, 0), b3, voffB); PG8_STAGE(PG8_SB(1, 1), b3 + hsB, voffB); PG8_STAGE(PG8_SA(1, 0), a3, voffA);
            PG8_WAIT_V(8); PG8_WAIT_L(0); PG8_BAR; PG8_MMA(1, 0, At, B0); PG8_MMA(1, 1, At, B1); PG8_BAR; PG8_SCHED;
        }
        if constexpr (ALIGN_EPI) { if (wr == 0) PG8_BAR; }
        Unit u2_; bool h2_ = false; unsigned pk_ = 0u;
        if constexpr (is_chain<Sched>::v) { h2_ = has_next && S.next(ui + 2, u2_); pk_ = S.peek(u2_, h2_, wid); }
        E(acc, cur, wr, wc, fr, fq);
        if constexpr (is_chain<Sched>::v) S.done(cur, lane);
        if (!has_next) break;
        if constexpr (is_chain<Sched>::v) S.a_ready(u2_, h2_, wid, pk_);
#pragma unroll
        for (int a = 0; a < 2; ++a)
#pragma unroll
            for (int b = 0; b < 2; ++b)
#pragma unroll
                for (int m = 0; m < 4; ++m)
#pragma unroll
                    for (int n = 0; n < 2; ++n) acc[a][b][m][n] = (f32x4){0.f, 0.f, 0.f, 0.f};
        cur = nxt; cA = nA; cB = nB; ++ui;
        if constexpr (ALIGN_EPI) { if (wr == 1) PG8_BAR; }
    }
    PG8_WAIT_V(0);
    if constexpr (!ALIGN_EPI) { if (wr == 0) PG8_BAR; }
    PG8_BAR;
#undef PG8_SA
#undef PG8_SB
#undef PG8_STAGE
#undef PG8_LDA
#undef PG8_LDB
#undef PG8_MMA
#undef PG8_WAIT_V
#undef PG8_WAIT_L
#undef PG8_BAR
#undef PG8_SCHED
}

template <int NS>
__device__ __forceinline__ void load_rstd8(const float* SS, int row0, int fq, int lane, float inv_n, float (&rs)[2][4]) {
#pragma unroll
    for (int ai = 0; ai < 2; ++ai)
#pragma unroll
        for (int m = 0; m < 4; ++m) { const float* p = SS + (size_t)(row0 + ai * HALF + m * 16) * NS + fq * (NS / 4); float s = 0.f;
#pragma unroll
            for (int j = 0; j < NS / 4; ++j) s += p[j];
            s += shx(s, 16, lane); s += shx(s, 32, lane); rs[ai][m] = rsqrtf(s * inv_n + RMS_EPS); }
}
constexpr int RC_OFF = 133120, RC_WAVE = 1024;
__device__ __forceinline__ void rstd8_cached(LAS float* rc, const float* SS, int pm, int row0, int fr, int fq, float (&rs)[2][4]) {
    const int tag = __builtin_amdgcn_readfirstlane(((LAS const int*)rc)[128]);
    if (tag == pm) {
#pragma unroll
        for (int ai = 0; ai < 2; ++ai)
#pragma unroll
            for (int m = 0; m < 4; ++m) rs[ai][m] = rc[ai * 64 + m * 16 + fr];
    } else {
        load_rstd8<32>(SS, row0, fq, fq * 16 + fr, 1.0f / DM, rs);
        if (fq == 0) {
#pragma unroll
            for (int ai = 0; ai < 2; ++ai)
#pragma unroll
                for (int m = 0; m < 4; ++m) rc[ai * 64 + m * 16 + fr] = rs[ai][m]; }
        if (fq * 16 + fr == 0) ((LAS int*)rc)[128] = pm;
    }
}
__device__ __forceinline__ float silu_mul(float g, float u) { return g * __builtin_amdgcn_rcpf(1.0f + __builtin_amdgcn_exp2f(-1.4426950408889634f * g)) * u; }

struct EpiSwiGLU {
    static constexpr bool PERM = true;
    bf16_t* H; const float* SS; LAS float* rc;
    __device__ __forceinline__ void operator()(const f32x4 (&acc)[2][2][4][2], const Unit& u, int wr, int wc, int fr, int fq) const {
        const int row0 = u.pm * BM + wr * 64 + fr, col0 = u.pn * HALF + wc * 32 + 8 * fq;
        float rs[2][4]; rstd8_cached(rc, SS, u.pm, row0, fr, fq, rs);
#pragma unroll
        for (int ai = 0; ai < 2; ++ai)
#pragma unroll
            for (int m = 0; m < 4; ++m) { const float r = rs[ai][m]; bf16_t* rowp = H + (size_t)(row0 + ai * HALF + m * 16) * FF + col0;
                const f32x4 g0 = acc[ai][0][m][0] * r, g1 = acc[ai][0][m][1] * r, u0 = acc[ai][1][m][0] * r, u1 = acc[ai][1][m][1] * r;
                u32x4 w; w.x = cvt_pk_bf16(silu_mul(g0[0], u0[0]), silu_mul(g0[1], u0[1])); w.y = cvt_pk_bf16(silu_mul(g0[2], u0[2]), silu_mul(g0[3], u0[3]));
                w.z = cvt_pk_bf16(silu_mul(g1[0], u1[0]), silu_mul(g1[1], u1[1])); w.w = cvt_pk_bf16(silu_mul(g1[2], u1[2]), silu_mul(g1[3], u1[3]));
                *(u32x4*)rowp = w; }
    }
};
struct EpiResid {
    static constexpr bool PERM = false;
    const float* Xin32; float* Xout32; bf16_t* XB; float* SS; float scale;
    __device__ __forceinline__ void operator()(const f32x4 (&acc)[2][2][4][2], const Unit& u, int wr, int wc, int fr, int fq) const {
        const int row0 = u.pm * BM + wr * 64 + fr, col0 = u.pn * BM + wc * 32 + 4 * fq;
#pragma unroll
        for (int ai = 0; ai < 2; ++ai) {
            f32x4 xo[4][2][2];
            if (Xin32 != nullptr) {
#pragma unroll
                for (int m = 0; m < 4; ++m)
#pragma unroll
                    for (int bj = 0; bj < 2; ++bj)
#pragma unroll
                        for (int n = 0; n < 2; ++n) xo[m][bj][n] = *(const f32x4*)(Xin32 + (size_t)(row0 + ai * HALF + m * 16) * DM + col0 + bj * HALF + n * 16);
            } else {
                u32x2 xr[4][2][2];
#pragma unroll
                for (int m = 0; m < 4; ++m)
#pragma unroll
                    for (int bj = 0; bj < 2; ++bj)
#pragma unroll
                        for (int n = 0; n < 2; ++n) xr[m][bj][n] = *(const u32x2*)(XB + (size_t)(row0 + ai * HALF + m * 16) * DM + col0 + bj * HALF + n * 16);
#pragma unroll
                for (int m = 0; m < 4; ++m)
#pragma unroll
                    for (int bj = 0; bj < 2; ++bj)
#pragma unroll
                        for (int n = 0; n < 2; ++n) { const u32x2 w = xr[m][bj][n];
                            xo[m][bj][n] = (f32x4){__uint_as_float(w.x << 16), __uint_as_float(w.x & 0xffff0000u), __uint_as_float(w.y << 16), __uint_as_float(w.y & 0xffff0000u)}; }
            }
            asm volatile("" ::: "memory");
#pragma unroll
            for (int m = 0; m < 4; ++m) { const int row = row0 + ai * HALF + m * 16; const size_t off = (size_t)row * DM + col0; float ss = 0.f;
#pragma unroll
                for (int bj = 0; bj < 2; ++bj)
#pragma unroll
                    for (int n = 0; n < 2; ++n) { const size_t o = off + bj * HALF + n * 16; const f32x4 xn = xo[m][bj][n] + acc[ai][bj][m][n] * scale;
                        if (Xout32 != nullptr) *(f32x4*)(Xout32 + o) = xn;
                        else { u32x2 w; w.x = cvt_pk_bf16(xn[0], xn[1]); w.y = cvt_pk_bf16(xn[2], xn[3]); *(u32x2*)(XB + o) = w; }
                        ss += (xn[0] * xn[0] + xn[1] * xn[1]) + (xn[2] * xn[2] + xn[3] * xn[3]); }
                ss += shx(ss, 16, fq * 16 + fr); ss += shx(ss, 32, fq * 16 + fr);
                if (fq == 0) SS[(size_t)row * 32 + u.pn * 4 + wc] = ss; }
        }
    }
};

constexpr float QSCALE_D = 0.08838834764831845f * 1.4426950408889634f;
constexpr float QSCALE_M = 0.07216878364870322f * 1.4426950408889634f;
template <int NS>
__device__ __forceinline__ void load_rstd8_lat(const float* SS16, int slot0, int row0, int fq, int lane, float inv_n, float (&rs)[2][4]) {
#pragma unroll
    for (int ai = 0; ai < 2; ++ai)
#pragma unroll
        for (int m = 0; m < 4; ++m) { const float* p = SS16 + (size_t)(row0 + ai * HALF + m * 16) * 16 + slot0 + fq * (NS / 4); float s = 0.f;
#pragma unroll
            for (int j = 0; j < NS / 4; ++j) s += p[j];
            s += shx(s, 16, lane); s += shx(s, 32, lane); rs[ai][m] = rsqrtf(s * inv_n + RMS_EPS); }
}
__device__ __forceinline__ u32x4 pack8f(const f32x4 a, const f32x4 b) { u32x4 w; w.x = cvt_pk_bf16(a[0], a[1]); w.y = cvt_pk_bf16(a[2], a[3]); w.z = cvt_pk_bf16(b[0], b[1]); w.w = cvt_pk_bf16(b[2], b[3]); return w; }
__device__ __forceinline__ void rope8(f32x4& a, f32x4& b, const float* cs, int pos, int i0) {
    const f32x4 t0 = *(const f32x4*)(cs + ((size_t)pos * 32 + i0) * 2), t1 = *(const f32x4*)(cs + ((size_t)pos * 32 + i0 + 2) * 2);
    const f32x4 x = a, y = b;
    a[0] = x[0] * t0[0] - x[1] * t0[1]; a[1] = x[1] * t0[0] + x[0] * t0[1]; a[2] = x[2] * t0[2] - x[3] * t0[3]; a[3] = x[3] * t0[2] + x[2] * t0[3];
    b[0] = y[0] * t1[0] - y[1] * t1[1]; b[1] = y[1] * t1[0] + y[0] * t1[1]; b[2] = y[2] * t1[2] - y[3] * t1[3]; b[3] = y[3] * t1[2] + y[2] * t1[3];
}
struct MixBufs { bf16_t *LAT, *DQ, *DK, *DV, *NQ, *NKV  , *MK; float *LATSS, *GATES; const float* ROPE; };
struct EpiMixIn {
    static constexpr bool PERM = true;
    MixBufs B; const float* SS; LAS float* rc;
    __device__ __forceinline__ void operator()(const f32x4 (&acc)[2][2][4][2], const Unit& u, int wr, int wc, int fr, int fq) const {
        const int row0 = u.pm * BM + wr * 64 + fr, cw = wc * 32 + 8 * fq, pn = u.pn;
        float rs[2][4]; rstd8_cached(rc, SS, u.pm, row0, fr, fq, rs);
#pragma unroll
        for (int ai = 0; ai < 2; ++ai)
#pragma unroll
            for (int m = 0; m < 4; ++m) { const float r = rs[ai][m]; const int row = row0 + ai * HALF + m * 16;
                f32x4 v00 = acc[ai][0][m][0] * r, v01 = acc[ai][0][m][1] * r, v10 = acc[ai][1][m][0] * r, v11 = acc[ai][1][m][1] * r;
                if (pn < 4) {
                    bf16_t* p = B.LAT + (size_t)row * LATW + pn * 256 + cw; *(u32x4*)p = pack8f(v00, v01); *(u32x4*)(p + HALF) = pack8f(v10, v11);
                    float ss = 0.f;
#pragma unroll
                    for (int e = 0; e < 4; ++e) ss += v00[e] * v00[e] + v01[e] * v01[e] + v10[e] * v10[e] + v11[e] * v11[e];
                    ss += shx(ss, 16, fq * 16 + fr); ss += shx(ss, 32, fq * 16 + fr);
                    if (fq == 0) B.LATSS[(size_t)row * 16 + pn * 4 + wc] = ss;
                } else if (pn < 13) {
                    const int t = pn - 4, seg = t / 3, c = (t - seg * 3) * 256 + cw; bf16_t* base = B.DQ + (size_t)seg * ((size_t)M * 768);
                    const float sc = seg == 0 ? QSCALE_D : 1.0f;
                    bf16_t* p = base + (size_t)row * 768 + c; *(u32x4*)p = pack8f(v00 * sc, v01 * sc); *(u32x4*)(p + HALF) = pack8f(v10 * sc, v11 * sc);
                } else if (pn < 15) {
                    bf16_t* p = B.NQ + (size_t)row * 512 + (pn - 13) * 256 + cw; *(u32x4*)p = pack8f(v00 * QSCALE_D, v01 * QSCALE_D); *(u32x4*)(p + HALF) = pack8f(v10 * QSCALE_D, v11 * QSCALE_D);
                } else if (pn < 18) {
                    bf16_t* p0 = B.NKV + (size_t)(2 * (pn - 15)) * ((size_t)M * 128) + (size_t)row * 128 + cw; *(u32x4*)p0 = pack8f(v00, v01);
                    *(u32x4*)(p0 + (size_t)M * 128) = pack8f(v10, v11);
                } else {
                    if (wc < 2) { rope8(v00, v01, B.ROPE, row & (SEQ - 1), cw >> 1); const u32x4 w = pack8f(v00, v01);
#pragma unroll
                        for (int h = 0; h < 6; ++h) *(u32x4*)(B.MK + (size_t)row * 1152 + h * 192 + 128 + cw) = w;
                    } else if (wc == 2 && fq < 2) {
                        float* gp = B.GATES + (size_t)row * 16 + 8 * fq; f32x4 s0, s1;
#pragma unroll
                        for (int e = 0; e < 4; ++e) { s0[e] = __builtin_amdgcn_rcpf(1.0f + __builtin_amdgcn_exp2f(-1.4426950408889634f * v00[e])); s1[e] = __builtin_amdgcn_rcpf(1.0f + __builtin_amdgcn_exp2f(-1.4426950408889634f * v01[e])); }
                        *(f32x4*)gp = s0; *(f32x4*)(gp + 4) = s1;
                    }
                }
            }
    }
};
struct EpiUp {
    static constexpr bool PERM = true;
    bf16_t *MQ, *MK, *MV; const float* LATSS; const float* ROPE;
    __device__ __forceinline__ void operator()(const f32x4 (&acc)[2][2][4][2], const Unit& u, int wr, int wc, int fr, int fq) const {
        const int row0 = u.pm * BM + wr * 64 + fr, cw = wc * 32 + 8 * fq, pn = u.pn;
        float rs[2][4]; load_rstd8_lat<8>(LATSS, pn < 5 ? 0 : 8, row0, fq, fq * 16 + fr, 1.0f / 512.0f, rs);
#pragma unroll
        for (int ai = 0; ai < 2; ++ai)
#pragma unroll
            for (int m = 0; m < 4; ++m) { const int row = row0 + ai * HALF + m * 16;
                if (pn < 5) { const float r = rs[ai][m] * QSCALE_M;
#pragma unroll
                    for (int bj = 0; bj < 2; ++bj) { const int c = pn * 256 + bj * HALF + cw; if (c < 1152) { f32x4 a = acc[ai][bj][m][0] * r, b = acc[ai][bj][m][1] * r; const int w = c % 192;
                        if (w >= 128) rope8(a, b, ROPE, row & (SEQ - 1), (w - 128) >> 1);
                        *(u32x4*)(MQ + (size_t)row * 1152 + c) = pack8f(a, b); } }
                } else { const float r = rs[ai][m]; const int h = pn - 5;
                    *(u32x4*)(MK + (size_t)row * 1152 + h * 192 + cw) = pack8f(acc[ai][0][m][0] * r, acc[ai][0][m][1] * r);
                    *(u32x4*)(MV + (size_t)row * 768 + h * 128 + cw) = pack8f(acc[ai][1][m][0] * r, acc[ai][1][m][1] * r); }
            }
    }
};
struct EpiCmp {
    static constexpr bool PERM = true;
    bf16_t* H1; const float* CB;
    __device__ __forceinline__ void operator()(const f32x4 (&acc)[2][2][4][2], const Unit& u, int wr, int wc, int fr, int fq) const {
        const int row0 = u.pm * BM + wr * 64 + fr, cw = wc * 32 + 8 * fq;
        const f32x4 b0 = *(const f32x4*)(CB + cw), b1 = *(const f32x4*)(CB + cw + 4);
#pragma unroll
        for (int ai = 0; ai < 2; ++ai)
#pragma unroll
            for (int m = 0; m < 4; ++m) { const int row = row0 + ai * HALF + m * 16; f32x4 a = acc[ai][0][m][0] + b0, b = acc[ai][0][m][1] + b1;
#pragma unroll
                for (int e = 0; e < 4; ++e) { a[e] = silu_mul(a[e], 1.0f); b[e] = silu_mul(b[e], 1.0f); }
                *(u32x4*)(H1 + (size_t)row * 128 + cw) = pack8f(a, b); }
    }
};
}


namespace att {
#ifndef DIL_DMA
#define DIL_DMA true
#endif
constexpr int SHM_V = 16384;
constexpr float THR2 = 11.5f;
#define SBAR() __builtin_amdgcn_sched_barrier(0)
__device__ __forceinline__ int v_st(int k, int c) { const int kk = (k & ~0xC) | ((k & 4) << 1) | ((k & 8) >> 1); return ((kk >> 3) * 4 + (c >> 5)) * 512 + ((kk & 7) * 32 + (c & 31)) * 2; }
__device__ __forceinline__ int v_rd_base(int lane) { return ((lane & 3) << 3) | (((lane >> 2) & 3) << 6) | (((lane >> 4) & 1) << 5) | (((lane >> 5) & 1) << 8); }
constexpr int v_rd_off(int d0, int ks, int half) { return d0 * 512 + ks * 4096 + half * 2048; }
__device__ __forceinline__ int crow(int r, int hi) { return (r & 3) + 8 * (r >> 2) + 4 * hi; }
__device__ __forceinline__ void mask_tile(f32x16& p0, f32x16& p1, int dq, unsigned W) {
    const float NEG = -__builtin_inff();
#pragma unroll
    for (int r = 0; r < 16; ++r) { const int c = (r & 3) + 8 * (r >> 2);
        if ((unsigned)(dq - c) >= W) p0[r] = NEG;
        if ((unsigned)(dq - c - 32) >= W) p1[r] = NEG; }
}
__device__ __forceinline__ void bias_tile(f32x16& p0, f32x16& p1, int dq, float sl2) {
    const float base = -sl2 * (float)dq;
#pragma unroll
    for (int r = 0; r < 16; ++r) { const int c = (r & 3) + 8 * (r >> 2); p0[r] += fmaf(sl2, (float)c, base); p1[r] += fmaf(sl2, (float)(c + 32), base); }
}
template <bool FIXEDM>
__device__ __forceinline__ void partialSM(f32x16& p0, f32x16& p1, float& m_reg, float& mn, float& alpha) {
    if constexpr (FIXEDM) { mn = m_reg; alpha = 1.f; }
    else {
        float pmax = p0[0];
#pragma unroll
        for (int r = 1; r < 16; ++r) pmax = fmaxf(pmax, p0[r]);
#pragma unroll
        for (int r = 0; r < 16; ++r) pmax = fmaxf(pmax, p1[r]);
        { auto rr = __builtin_amdgcn_permlane32_swap(__float_as_uint(pmax), __float_as_uint(pmax), false, false); pmax = fmaxf(__uint_as_float(rr[0]), __uint_as_float(rr[1])); }
        if (__builtin_expect(__all(pmax - m_reg <= THR2), 1)) { mn = m_reg; alpha = 1.f; }
        else { mn = fmaxf(m_reg, pmax); alpha = __builtin_amdgcn_exp2f(m_reg - mn); m_reg = mn; }
    }
#pragma unroll
    for (int r = 0; r < 16; ++r) { p0[r] -= mn; p1[r] -= mn; }
#pragma unroll
    for (int r = 0; r < 16; ++r) p0[r] = __builtin_amdgcn_exp2f(p0[r]);
}
__device__ __forceinline__ void finishSM_exp(f32x16& p0, f32x16& p1, float alpha, float& l_reg) {
#pragma unroll
    for (int r = 0; r < 16; ++r) p1[r] = __builtin_amdgcn_exp2f(p1[r]);
    float ps = 0;
#pragma unroll
    for (int r = 0; r < 16; ++r) ps += p0[r];
#pragma unroll
    for (int r = 0; r < 16; ++r) ps += p1[r];
    { auto rr = __builtin_amdgcn_permlane32_swap(__float_as_uint(ps), __float_as_uint(ps), false, false); ps = __uint_as_float(rr[0]) + __uint_as_float(rr[1]); }
    l_reg = l_reg * alpha + ps;
}
__device__ __forceinline__ void finishSM_pack(const f32x16& p0, const f32x16& p1, bf16x8& pa0, bf16x8& pa1, bf16x8& pa2, bf16x8& pa3) {
#define PK4(P, B_, OUT) do { unsigned a0 = cvt_pk_bf16(P[B_+0], P[B_+1]), a1 = cvt_pk_bf16(P[B_+2], P[B_+3]); unsigned b0 = cvt_pk_bf16(P[B_+4], P[B_+5]), b1 = cvt_pk_bf16(P[B_+6], P[B_+7]); \
        auto r0 = __builtin_amdgcn_permlane32_swap(a0, b0, false, false); auto r1 = __builtin_amdgcn_permlane32_swap(a1, b1, false, false); \
        u32x4 w = {r0[0], r1[0], r0[1], r1[1]}; OUT = *reinterpret_cast<bf16x8*>(&w); } while (0)
    PK4(p0, 0, pa0); PK4(p0, 8, pa1); PK4(p1, 0, pa2); PK4(p1, 8, pa3);
#undef PK4
}
template <int DQK> __device__ __forceinline__ int kswz(int r) { return DQK == 192 ? ((r >> 1) & 7) : (r & 7); }
template <int KB, int DQK, int NQR>
__device__ __forceinline__ void qkt(f32x16& p0, f32x16& p1, LAS const unsigned char* K_lds, int r32, int hi, const bf16x8* qr, LAS const unsigned char* qlds, bool act) {
    constexpr int KROWB = DQK * 2, SHM_K = 64 * KROWB;
    if (!act) { const float NEG = -__builtin_inff();
#pragma unroll
        for (int r = 0; r < 16; ++r) { p0[r] = NEG; p1[r] = NEG; } return; }
    p0 = f32x16{}; p1 = f32x16{};
    if constexpr (NQR == DQK / 16) {
        constexpr int NF = DQK / 8;
        int r_ = r32; asm volatile("" : "+v"(r_));
        const int rowa = (int)(uintptr_t)(K_lds + KB * SHM_K) + r_ * KROWB, xr = kswz<DQK>(r_) << 4;
        int kbA[4];
#pragma unroll
        for (int dd = 0; dd < 4; ++dd) kbA[dd] = rowa + (((dd * 16 + hi * 8) * 2) ^ xr);
#define KADDR(f) "v"(kbA[((f) >> 1) & 3]), "i"((((f) >> 1) >> 2) * 128 + ((f) & 1) * 32 * KROWB)
#define KRD0(dst, f) asm volatile("ds_read_b128 %0, %1 offset:%2" : "=&v"(dst) : KADDR(f) : "memory")
#define KRDP(dst, f, P) asm volatile("ds_read_b128 %0, %2 offset:%3" : "=&v"(dst), "+v"(P) : KADDR(f) : "memory")
#define KWAIT(n, F) asm volatile("s_waitcnt lgkmcnt(%1)" : "+v"(F) : "i"(n) : "memory")
        bf16x8 F0, F1, F2, F3;
        KRD0(F0, 0); KRD0(F1, 1); KRD0(F2, 2); KRD0(F3, 3);
    if constexpr (0 < NF) { KWAIT((NF - 1 - 0) < 3 ? (NF - 1 - 0) : 3, F0); p0 = __builtin_amdgcn_mfma_f32_32x32x16_bf16(F0, qr[0], p0, 0, 0, 0); if constexpr (0 + 4 < NF) KRDP(F0, 0 + 4, p0); }
    if constexpr (1 < NF) { KWAIT((NF - 1 - 1) < 3 ? (NF - 1 - 1) : 3, F1); p1 = __builtin_amdgcn_mfma_f32_32x32x16_bf16(F1, qr[0], p1, 0, 0, 0); if constexpr (1 + 4 < NF) KRDP(F1, 1 + 4, p1); }
    if constexpr (2 < NF) { KWAIT((NF - 1 - 2) < 3 ? (NF - 1 - 2) : 3, F2); p0 = __builtin_amdgcn_mfma_f32_32x32x16_bf16(F2, qr[1], p0, 0, 0, 0); if constexpr (2 + 4 < NF) KRDP(F2, 2 + 4, p0); }
    if constexpr (3 < NF) { KWAIT((NF - 1 - 3) < 3 ? (NF - 1 - 3) : 3, F3); p1 = __builtin_amdgcn_mfma_f32_32x32x16_bf16(F3, qr[1], p1, 0, 0, 0); if constexpr (3 + 4 < NF) KRDP(F3, 3 + 4, p1); }
    if constexpr (4 < NF) { KWAIT((NF - 1 - 4) < 3 ? (NF - 1 - 4) : 3, F0); p0 = __builtin_amdgcn_mfma_f32_32x32x16_bf16(F0, qr[2], p0, 0, 0, 0); if constexpr (4 + 4 < NF) KRDP(F0, 4 + 4, p0); }
    if constexpr (5 < NF) { KWAIT((NF - 1 - 5) < 3 ? (NF - 1 - 5) : 3, F1); p1 = __builtin_amdgcn_mfma_f32_32x32x16_bf16(F1, qr[2], p1, 0, 0, 0); if constexpr (5 + 4 < NF) KRDP(F1, 5 + 4, p1); }
    if constexpr (6 < NF) { KWAIT((NF - 1 - 6) < 3 ? (NF - 1 - 6) : 3, F2); p0 = __builtin_amdgcn_mfma_f32_32x32x16_bf16(F2, qr[3], p0, 0, 0, 0); if constexpr (6 + 4 < NF) KRDP(F2, 6 + 4, p0); }
    if constexpr (7 < NF) { KWAIT((NF - 1 - 7) < 3 ? (NF - 1 - 7) : 3, F3); p1 = __builtin_amdgcn_mfma_f32_32x32x16_bf16(F3, qr[3], p1, 0, 0, 0); if constexpr (7 + 4 < NF) KRDP(F3, 7 + 4, p1); }
    if constexpr (8 < NF) { KWAIT((NF - 1 - 8) < 3 ? (NF - 1 - 8) : 3, F0); p0 = __builtin_amdgcn_mfma_f32_32x32x16_bf16(F0, qr[4], p0, 0, 0, 0); if constexpr (8 + 4 < NF) KRDP(F0, 8 + 4, p0); }
    if constexpr (9 < NF) { KWAIT((NF - 1 - 9) < 3 ? (NF - 1 - 9) : 3, F1); p1 = __builtin_amdgcn_mfma_f32_32x32x16_bf16(F1, qr[4], p1, 0, 0, 0); if constexpr (9 + 4 < NF) KRDP(F1, 9 + 4, p1); }
    if constexpr (10 < NF) { KWAIT((NF - 1 - 10) < 3 ? (NF - 1 - 10) : 3, F2); p0 = __builtin_amdgcn_mfma_f32_32x32x16_bf16(F2, qr[5], p0, 0, 0, 0); if constexpr (10 + 4 < NF) KRDP(F2, 10 + 4, p0); }
    if constexpr (11 < NF) { KWAIT((NF - 1 - 11) < 3 ? (NF - 1 - 11) : 3, F3); p1 = __builtin_amdgcn_mfma_f32_32x32x16_bf16(F3, qr[5], p1, 0, 0, 0); if constexpr (11 + 4 < NF) KRDP(F3, 11 + 4, p1); }
    if constexpr (12 < NF) { KWAIT((NF - 1 - 12) < 3 ? (NF - 1 - 12) : 3, F0); p0 = __builtin_amdgcn_mfma_f32_32x32x16_bf16(F0, qr[6], p0, 0, 0, 0); if constexpr (12 + 4 < NF) KRDP(F0, 12 + 4, p0); }
    if constexpr (13 < NF) { KWAIT((NF - 1 - 13) < 3 ? (NF - 1 - 13) : 3, F1); p1 = __builtin_amdgcn_mfma_f32_32x32x16_bf16(F1, qr[6], p1, 0, 0, 0); if constexpr (13 + 4 < NF) KRDP(F1, 13 + 4, p1); }
    if constexpr (14 < NF) { KWAIT((NF - 1 - 14) < 3 ? (NF - 1 - 14) : 3, F2); p0 = __builtin_amdgcn_mfma_f32_32x32x16_bf16(F2, qr[7], p0, 0, 0, 0); if constexpr (14 + 4 < NF) KRDP(F2, 14 + 4, p0); }
    if constexpr (15 < NF) { KWAIT((NF - 1 - 15) < 3 ? (NF - 1 - 15) : 3, F3); p1 = __builtin_amdgcn_mfma_f32_32x32x16_bf16(F3, qr[7], p1, 0, 0, 0); if constexpr (15 + 4 < NF) KRDP(F3, 15 + 4, p1); }
    if constexpr (16 < NF) { KWAIT((NF - 1 - 16) < 3 ? (NF - 1 - 16) : 3, F0); p0 = __builtin_amdgcn_mfma_f32_32x32x16_bf16(F0, qr[8], p0, 0, 0, 0); if constexpr (16 + 4 < NF) KRDP(F0, 16 + 4, p0); }
    if constexpr (17 < NF) { KWAIT((NF - 1 - 17) < 3 ? (NF - 1 - 17) : 3, F1); p1 = __builtin_amdgcn_mfma_f32_32x32x16_bf16(F1, qr[8], p1, 0, 0, 0); if constexpr (17 + 4 < NF) KRDP(F1, 17 + 4, p1); }
    if constexpr (18 < NF) { KWAIT((NF - 1 - 18) < 3 ? (NF - 1 - 18) : 3, F2); p0 = __builtin_amdgcn_mfma_f32_32x32x16_bf16(F2, qr[9], p0, 0, 0, 0); if constexpr (18 + 4 < NF) KRDP(F2, 18 + 4, p0); }
    if constexpr (19 < NF) { KWAIT((NF - 1 - 19) < 3 ? (NF - 1 - 19) : 3, F3); p1 = __builtin_amdgcn_mfma_f32_32x32x16_bf16(F3, qr[9], p1, 0, 0, 0); if constexpr (19 + 4 < NF) KRDP(F3, 19 + 4, p1); }
    if constexpr (20 < NF) { KWAIT((NF - 1 - 20) < 3 ? (NF - 1 - 20) : 3, F0); p0 = __builtin_amdgcn_mfma_f32_32x32x16_bf16(F0, qr[10], p0, 0, 0, 0); if constexpr (20 + 4 < NF) KRDP(F0, 20 + 4, p0); }
    if constexpr (21 < NF) { KWAIT((NF - 1 - 21) < 3 ? (NF - 1 - 21) : 3, F1); p1 = __builtin_amdgcn_mfma_f32_32x32x16_bf16(F1, qr[10], p1, 0, 0, 0); if constexpr (21 + 4 < NF) KRDP(F1, 21 + 4, p1); }
    if constexpr (22 < NF) { KWAIT((NF - 1 - 22) < 3 ? (NF - 1 - 22) : 3, F2); p0 = __builtin_amdgcn_mfma_f32_32x32x16_bf16(F2, qr[11], p0, 0, 0, 0); if constexpr (22 + 4 < NF) KRDP(F2, 22 + 4, p0); }
    if constexpr (23 < NF) { KWAIT((NF - 1 - 23) < 3 ? (NF - 1 - 23) : 3, F3); p1 = __builtin_amdgcn_mfma_f32_32x32x16_bf16(F3, qr[11], p1, 0, 0, 0); if constexpr (23 + 4 < NF) KRDP(F3, 23 + 4, p1); }
#undef KRD0
#undef KRDP
#undef KADDR
#undef KWAIT
    } else {
    LAS const unsigned char* kb[4];
#pragma unroll
    for (int dd = 0; dd < 4; ++dd) kb[dd] = K_lds + KB * SHM_K + r32 * KROWB + (((dd * 16 + hi * 8) * 2) ^ (kswz<DQK>(r32) << 4));
#pragma unroll
    for (int d0 = 0; d0 < DQK / 16; ++d0) { LAS const unsigned char* a = kb[d0 & 3] + (d0 >> 2) * 128;
        bf16x8 b0 = *reinterpret_cast<LAS const bf16x8*>(a);
        bf16x8 b1 = *reinterpret_cast<LAS const bf16x8*>(a + 32 * KROWB);
        bf16x8 q; if (d0 < NQR) q = qr[d0]; else q = *reinterpret_cast<LAS const bf16x8*>(qlds + (d0 - NQR) * 1024);
        p0 = __builtin_amdgcn_mfma_f32_32x32x16_bf16(b0, q, p0, 0, 0, 0);
        p1 = __builtin_amdgcn_mfma_f32_32x32x16_bf16(b1, q, p1, 0, 0, 0); }
    }
}
template <int C>
__device__ __forceinline__ void fin_item(f32x16& y0, f32x16& y1, float& ps0, float& ps1, unsigned (&wv)[16]) {
    if constexpr (C < 16) { const float e = __builtin_amdgcn_exp2f(y1[C]); y1[C] = e; ps0 += y0[C]; ps1 += e; }
    else { constexpr int j = C - 16, q = j >> 1, h = j & 1, B_ = (q & 1) * 8 + 2 * h; unsigned a, b;
        if constexpr (q < 2) { a = cvt_pk_bf16(y0[B_], y0[B_ + 1]); b = cvt_pk_bf16(y0[B_ + 4], y0[B_ + 5]); } else { a = cvt_pk_bf16(y1[B_], y1[B_ + 1]); b = cvt_pk_bf16(y1[B_ + 4], y1[B_ + 5]); }
        auto r = __builtin_amdgcn_permlane32_swap(a, b, false, false); wv[q * 4 + h] = r[0]; wv[q * 4 + 2 + h] = r[1];
        asm volatile("" : "+v"(wv[q * 4 + h]), "+v"(wv[q * 4 + 2 + h])); }
}
template <int A, int B>
__device__ __forceinline__ void fin_range(f32x16& y0, f32x16& y1, float& ps0, float& ps1, unsigned (&wv)[16]) { if constexpr (A < B) { fin_item<A>(y0, y1, ps0, ps1, wv); fin_range<A + 1, B>(y0, y1, ps0, ps1, wv); } }
template <int KB, int DQK, class DMF>
__device__ __forceinline__ void qkt_fin(f32x16& p0, f32x16& p1, LAS const unsigned char* K_lds, int r32, int hi, const bf16x8* qr, bool act,
                                        f32x16& y0, f32x16& y1, float alpha, float& l_reg, bf16x8& pa0, bf16x8& pa1, bf16x8& pa2, bf16x8& pa3, const DMF& dm) {
    if (!act) { _Pragma("unroll") for (int f_ = 0; f_ < DQK / 8; ++f_) dm(f_); qkt<KB, DQK, DQK / 16>(p0, p1, K_lds, r32, hi, qr, nullptr, false); finishSM_exp(y0, y1, alpha, l_reg); finishSM_pack(y0, y1, pa0, pa1, pa2, pa3); return; }
    constexpr int KROWB = DQK * 2, SHM_K = 64 * KROWB, NF = DQK / 8;
    p0 = f32x16{}; p1 = f32x16{};
    int r_ = r32; asm volatile("" : "+v"(r_));
    const int rowa = (int)(uintptr_t)(K_lds + KB * SHM_K) + r_ * KROWB, xr = kswz<DQK>(r_) << 4;
    int kbA[4];
#pragma unroll
    for (int dd = 0; dd < 4; ++dd) kbA[dd] = rowa + (((dd * 16 + hi * 8) * 2) ^ xr);
    float ps0 = 0.f, ps1 = 0.f; unsigned wv[16];
#define KADDR(f) "v"(kbA[((f) >> 1) & 3]), "i"((((f) >> 1) >> 2) * 128 + ((f) & 1) * 32 * KROWB)
#define KRD0(dst, f) asm volatile("ds_read_b128 %0, %1 offset:%2" : "=&v"(dst) : KADDR(f) : "memory")
#define KRDP(dst, f, P) asm volatile("ds_read_b128 %0, %2 offset:%3" : "=&v"(dst), "+v"(P) : KADDR(f) : "memory")
#define KWAIT(n, F) asm volatile("s_waitcnt lgkmcnt(%1)" : "+v"(F) : "i"(n) : "memory")
#define FTIE(P) asm volatile("" : "+v"(y0), "+v"(y1), "+v"(ps0), "+v"(ps1), "+v"(P))
    bf16x8 F0, F1, F2, F3;
    KRD0(F0, 0); KRD0(F1, 1); KRD0(F2, 2); KRD0(F3, 3);
    if constexpr (0 < NF) { KWAIT((NF - 1 - 0) < 3 ? (NF - 1 - 0) : 3, F0); p0 = __builtin_amdgcn_mfma_f32_32x32x16_bf16(F0, qr[0], p0, 0, 0, 0); if constexpr (0 + 4 < NF) KRDP(F0, 0 + 4, p0); fin_range<(0 * 24) / NF, ((0 + 1) * 24) / NF>(y0, y1, ps0, ps1, wv); FTIE(p0); dm(0); }
    if constexpr (1 < NF) { KWAIT((NF - 1 - 1) < 3 ? (NF - 1 - 1) : 3, F1); p1 = __builtin_amdgcn_mfma_f32_32x32x16_bf16(F1, qr[0], p1, 0, 0, 0); if constexpr (1 + 4 < NF) KRDP(F1, 1 + 4, p1); fin_range<(1 * 24) / NF, ((1 + 1) * 24) / NF>(y0, y1, ps0, ps1, wv); FTIE(p1); dm(1); }
    if constexpr (2 < NF) { KWAIT((NF - 1 - 2) < 3 ? (NF - 1 - 2) : 3, F2); p0 = __builtin_amdgcn_mfma_f32_32x32x16_bf16(F2, qr[1], p0, 0, 0, 0); if constexpr (2 + 4 < NF) KRDP(F2, 2 + 4, p0); fin_range<(2 * 24) / NF, ((2 + 1) * 24) / NF>(y0, y1, ps0, ps1, wv); FTIE(p0); dm(2); }
    if constexpr (3 < NF) { KWAIT((NF - 1 - 3) < 3 ? (NF - 1 - 3) : 3, F3); p1 = __builtin_amdgcn_mfma_f32_32x32x16_bf16(F3, qr[1], p1, 0, 0, 0); if constexpr (3 + 4 < NF) KRDP(F3, 3 + 4, p1); fin_range<(3 * 24) / NF, ((3 + 1) * 24) / NF>(y0, y1, ps0, ps1, wv); FTIE(p1); dm(3); }
    if constexpr (4 < NF) { KWAIT((NF - 1 - 4) < 3 ? (NF - 1 - 4) : 3, F0); p0 = __builtin_amdgcn_mfma_f32_32x32x16_bf16(F0, qr[2], p0, 0, 0, 0); if constexpr (4 + 4 < NF) KRDP(F0, 4 + 4, p0); fin_range<(4 * 24) / NF, ((4 + 1) * 24) / NF>(y0, y1, ps0, ps1, wv); FTIE(p0); dm(4); }
    if constexpr (5 < NF) { KWAIT((NF - 1 - 5) < 3 ? (NF - 1 - 5) : 3, F1); p1 = __builtin_amdgcn_mfma_f32_32x32x16_bf16(F1, qr[2], p1, 0, 0, 0); if constexpr (5 + 4 < NF) KRDP(F1, 5 + 4, p1); fin_range<(5 * 24) / NF, ((5 + 1) * 24) / NF>(y0, y1, ps0, ps1, wv); FTIE(p1); dm(5); }
    if constexpr (6 < NF) { KWAIT((NF - 1 - 6) < 3 ? (NF - 1 - 6) : 3, F2); p0 = __builtin_amdgcn_mfma_f32_32x32x16_bf16(F2, qr[3], p0, 0, 0, 0); if constexpr (6 + 4 < NF) KRDP(F2, 6 + 4, p0); fin_range<(6 * 24) / NF, ((6 + 1) * 24) / NF>(y0, y1, ps0, ps1, wv); FTIE(p0); dm(6); }
    if constexpr (7 < NF) { KWAIT((NF - 1 - 7) < 3 ? (NF - 1 - 7) : 3, F3); p1 = __builtin_amdgcn_mfma_f32_32x32x16_bf16(F3, qr[3], p1, 0, 0, 0); if constexpr (7 + 4 < NF) KRDP(F3, 7 + 4, p1); fin_range<(7 * 24) / NF, ((7 + 1) * 24) / NF>(y0, y1, ps0, ps1, wv); FTIE(p1); dm(7); }
    if constexpr (8 < NF) { KWAIT((NF - 1 - 8) < 3 ? (NF - 1 - 8) : 3, F0); p0 = __builtin_amdgcn_mfma_f32_32x32x16_bf16(F0, qr[4], p0, 0, 0, 0); if constexpr (8 + 4 < NF) KRDP(F0, 8 + 4, p0); fin_range<(8 * 24) / NF, ((8 + 1) * 24) / NF>(y0, y1, ps0, ps1, wv); FTIE(p0); dm(8); }
    if constexpr (9 < NF) { KWAIT((NF - 1 - 9) < 3 ? (NF - 1 - 9) : 3, F1); p1 = __builtin_amdgcn_mfma_f32_32x32x16_bf16(F1, qr[4], p1, 0, 0, 0); if constexpr (9 + 4 < NF) KRDP(F1, 9 + 4, p1); fin_range<(9 * 24) / NF, ((9 + 1) * 24) / NF>(y0, y1, ps0, ps1, wv); FTIE(p1); dm(9); }
    if constexpr (10 < NF) { KWAIT((NF - 1 - 10) < 3 ? (NF - 1 - 10) : 3, F2); p0 = __builtin_amdgcn_mfma_f32_32x32x16_bf16(F2, qr[5], p0, 0, 0, 0); if constexpr (10 + 4 < NF) KRDP(F2, 10 + 4, p0); fin_range<(10 * 24) / NF, ((10 + 1) * 24) / NF>(y0, y1, ps0, ps1, wv); FTIE(p0); dm(10); }
    if constexpr (11 < NF) { KWAIT((NF - 1 - 11) < 3 ? (NF - 1 - 11) : 3, F3); p1 = __builtin_amdgcn_mfma_f32_32x32x16_bf16(F3, qr[5], p1, 0, 0, 0); if constexpr (11 + 4 < NF) KRDP(F3, 11 + 4, p1); fin_range<(11 * 24) / NF, ((11 + 1) * 24) / NF>(y0, y1, ps0, ps1, wv); FTIE(p1); dm(11); }
    if constexpr (12 < NF) { KWAIT((NF - 1 - 12) < 3 ? (NF - 1 - 12) : 3, F0); p0 = __builtin_amdgcn_mfma_f32_32x32x16_bf16(F0, qr[6], p0, 0, 0, 0); if constexpr (12 + 4 < NF) KRDP(F0, 12 + 4, p0); fin_range<(12 * 24) / NF, ((12 + 1) * 24) / NF>(y0, y1, ps0, ps1, wv); FTIE(p0); dm(12); }
    if constexpr (13 < NF) { KWAIT((NF - 1 - 13) < 3 ? (NF - 1 - 13) : 3, F1); p1 = __builtin_amdgcn_mfma_f32_32x32x16_bf16(F1, qr[6], p1, 0, 0, 0); if constexpr (13 + 4 < NF) KRDP(F1, 13 + 4, p1); fin_range<(13 * 24) / NF, ((13 + 1) * 24) / NF>(y0, y1, ps0, ps1, wv); FTIE(p1); dm(13); }
    if constexpr (14 < NF) { KWAIT((NF - 1 - 14) < 3 ? (NF - 1 - 14) : 3, F2); p0 = __builtin_amdgcn_mfma_f32_32x32x16_bf16(F2, qr[7], p0, 0, 0, 0); if constexpr (14 + 4 < NF) KRDP(F2, 14 + 4, p0); fin_range<(14 * 24) / NF, ((14 + 1) * 24) / NF>(y0, y1, ps0, ps1, wv); FTIE(p0); dm(14); }
    if constexpr (15 < NF) { KWAIT((NF - 1 - 15) < 3 ? (NF - 1 - 15) : 3, F3); p1 = __builtin_amdgcn_mfma_f32_32x32x16_bf16(F3, qr[7], p1, 0, 0, 0); if constexpr (15 + 4 < NF) KRDP(F3, 15 + 4, p1); fin_range<(15 * 24) / NF, ((15 + 1) * 24) / NF>(y0, y1, ps0, ps1, wv); FTIE(p1); dm(15); }
    if constexpr (16 < NF) { KWAIT((NF - 1 - 16) < 3 ? (NF - 1 - 16) : 3, F0); p0 = __builtin_amdgcn_mfma_f32_32x32x16_bf16(F0, qr[8], p0, 0, 0, 0); if constexpr (16 + 4 < NF) KRDP(F0, 16 + 4, p0); fin_range<(16 * 24) / NF, ((16 + 1) * 24) / NF>(y0, y1, ps0, ps1, wv); FTIE(p0); dm(16); }
    if constexpr (17 < NF) { KWAIT((NF - 1 - 17) < 3 ? (NF - 1 - 17) : 3, F1); p1 = __builtin_amdgcn_mfma_f32_32x32x16_bf16(F1, qr[8], p1, 0, 0, 0); if constexpr (17 + 4 < NF) KRDP(F1, 17 + 4, p1); fin_range<(17 * 24) / NF, ((17 + 1) * 24) / NF>(y0, y1, ps0, ps1, wv); FTIE(p1); dm(17); }
    if constexpr (18 < NF) { KWAIT((NF - 1 - 18) < 3 ? (NF - 1 - 18) : 3, F2); p0 = __builtin_amdgcn_mfma_f32_32x32x16_bf16(F2, qr[9], p0, 0, 0, 0); if constexpr (18 + 4 < NF) KRDP(F2, 18 + 4, p0); fin_range<(18 * 24) / NF, ((18 + 1) * 24) / NF>(y0, y1, ps0, ps1, wv); FTIE(p0); dm(18); }
    if constexpr (19 < NF) { KWAIT((NF - 1 - 19) < 3 ? (NF - 1 - 19) : 3, F3); p1 = __builtin_amdgcn_mfma_f32_32x32x16_bf16(F3, qr[9], p1, 0, 0, 0); if constexpr (19 + 4 < NF) KRDP(F3, 19 + 4, p1); fin_range<(19 * 24) / NF, ((19 + 1) * 24) / NF>(y0, y1, ps0, ps1, wv); FTIE(p1); dm(19); }
    if constexpr (20 < NF) { KWAIT((NF - 1 - 20) < 3 ? (NF - 1 - 20) : 3, F0); p0 = __builtin_amdgcn_mfma_f32_32x32x16_bf16(F0, qr[10], p0, 0, 0, 0); if constexpr (20 + 4 < NF) KRDP(F0, 20 + 4, p0); fin_range<(20 * 24) / NF, ((20 + 1) * 24) / NF>(y0, y1, ps0, ps1, wv); FTIE(p0); dm(20); }
    if constexpr (21 < NF) { KWAIT((NF - 1 - 21) < 3 ? (NF - 1 - 21) : 3, F1); p1 = __builtin_amdgcn_mfma_f32_32x32x16_bf16(F1, qr[10], p1, 0, 0, 0); if constexpr (21 + 4 < NF) KRDP(F1, 21 + 4, p1); fin_range<(21 * 24) / NF, ((21 + 1) * 24) / NF>(y0, y1, ps0, ps1, wv); FTIE(p1); dm(21); }
    if constexpr (22 < NF) { KWAIT((NF - 1 - 22) < 3 ? (NF - 1 - 22) : 3, F2); p0 = __builtin_amdgcn_mfma_f32_32x32x16_bf16(F2, qr[11], p0, 0, 0, 0); if constexpr (22 + 4 < NF) KRDP(F2, 22 + 4, p0); fin_range<(22 * 24) / NF, ((22 + 1) * 24) / NF>(y0, y1, ps0, ps1, wv); FTIE(p0); dm(22); }
    if constexpr (23 < NF) { KWAIT((NF - 1 - 23) < 3 ? (NF - 1 - 23) : 3, F3); p1 = __builtin_amdgcn_mfma_f32_32x32x16_bf16(F3, qr[11], p1, 0, 0, 0); if constexpr (23 + 4 < NF) KRDP(F3, 23 + 4, p1); fin_range<(23 * 24) / NF, ((23 + 1) * 24) / NF>(y0, y1, ps0, ps1, wv); FTIE(p1); dm(23); }
#undef KADDR
#undef KRD0
#undef KRDP
#undef KWAIT
#undef FTIE
    float ps = ps0 + ps1;
    { auto rr = __builtin_amdgcn_permlane32_swap(__float_as_uint(ps), __float_as_uint(ps), false, false); ps = __uint_as_float(rr[0]) + __uint_as_float(rr[1]); }
    l_reg = l_reg * alpha + ps;
    { u32x4 w = {wv[0], wv[1], wv[2], wv[3]}; pa0 = *reinterpret_cast<bf16x8*>(&w); } { u32x4 w = {wv[4], wv[5], wv[6], wv[7]}; pa1 = *reinterpret_cast<bf16x8*>(&w); }
    { u32x4 w = {wv[8], wv[9], wv[10], wv[11]}; pa2 = *reinterpret_cast<bf16x8*>(&w); } { u32x4 w = {wv[12], wv[13], wv[14], wv[15]}; pa3 = *reinterpret_cast<bf16x8*>(&w); }
}
template <int VB>
__device__ __forceinline__ void pv_tile(f32x16* o, int vb0, bf16x8 pa0, bf16x8 pa1, bf16x8 pa2, bf16x8 pa3, bool act) {
    if (!act) return;
#define TRRD(dst, off) asm volatile("ds_read_b64_tr_b16 %0, %1 offset:%2" : "=&v"(dst) : "v"(vb0), "i"(off) : "memory")
#define PV_D0(d0) do { s16x4 l0, l1, l2, l3, h0, h1, h2, h3; constexpr int b_ = VB * SHM_V + v_rd_off(d0, 0, 0); \
        TRRD(l0, b_); TRRD(h0, b_ + 2048); TRRD(l1, b_ + 4096); TRRD(h1, b_ + 6144); TRRD(l2, b_ + 8192); TRRD(h2, b_ + 10240); TRRD(l3, b_ + 12288); TRRD(h3, b_ + 14336); \
        asm volatile("s_waitcnt lgkmcnt(0)" ::: "memory"); SBAR(); \
        o[d0] = __builtin_amdgcn_mfma_f32_32x32x16_bf16(pa0, (bf16x8){l0[0], l0[1], l0[2], l0[3], h0[0], h0[1], h0[2], h0[3]}, o[d0], 0, 0, 0); \
        o[d0] = __builtin_amdgcn_mfma_f32_32x32x16_bf16(pa1, (bf16x8){l1[0], l1[1], l1[2], l1[3], h1[0], h1[1], h1[2], h1[3]}, o[d0], 0, 0, 0); \
        o[d0] = __builtin_amdgcn_mfma_f32_32x32x16_bf16(pa2, (bf16x8){l2[0], l2[1], l2[2], l2[3], h2[0], h2[1], h2[2], h2[3]}, o[d0], 0, 0, 0); \
        o[d0] = __builtin_amdgcn_mfma_f32_32x32x16_bf16(pa3, (bf16x8){l3[0], l3[1], l3[2], l3[3], h3[0], h3[1], h3[2], h3[3]}, o[d0], 0, 0, 0); } while (0)
    PV_D0(0); PV_D0(1); PV_D0(2); PV_D0(3);
#undef PV_D0
#undef TRRD
}

__device__ __forceinline__ void pv_sm(f32x16* o, int vb, bf16x8 pa0, bf16x8 pa1, bf16x8 pa2, bf16x8 pa3, bool act, f32x16& x0, f32x16& x1, float& m_reg, float& mn, float& alpha) {
    if (!act) { partialSM<false>(x0, x1, m_reg, mn, alpha); return; }
    s16x4 S0, S1, S2, S3, S4, S5, S6, S7; float pm = -__builtin_inff();
#define TRRD(dst, off) asm volatile("ds_read_b64_tr_b16 %0, %1 offset:%2" : "=&v"(dst) : "v"(vb), "i"(off) : "memory")
#define TRRDT(dst, off, O) asm volatile("ds_read_b64_tr_b16 %0, %2 offset:%3" : "=&v"(dst), "+v"(O) : "v"(vb), "i"(off) : "memory")
#define VWAIT(n, A, B) asm volatile("s_waitcnt lgkmcnt(%2)" : "+v"(A), "+v"(B) : "i"(n) : "memory")
#define PTIE(O) asm volatile("" : "+v"(x0), "+v"(x1), "+v"(pm), "+v"(O))
#define XV(j) ((j) < 16 ? x0[(j) & 15] : x1[(j) & 15])
    TRRD(S0, 0); TRRD(S1, 2048); TRRD(S2, 4096); TRRD(S3, 6144); TRRD(S4, 8192); TRRD(S5, 10240); TRRD(S6, 12288); TRRD(S7, 14336);
    VWAIT(6, S0, S1); o[0] = __builtin_amdgcn_mfma_f32_32x32x16_bf16(pa0, (bf16x8){S0[0], S0[1], S0[2], S0[3], S1[0], S1[1], S1[2], S1[3]}, o[0], 0, 0, 0); TRRDT(S0, 512, o[0]); TRRD(S1, 2560); pm = fmaxf(fmaxf(pm, XV(0)), XV(1)); pm = fmaxf(fmaxf(pm, XV(2)), XV(3)); pm = fmaxf(fmaxf(pm, XV(4)), XV(5)); pm = fmaxf(fmaxf(pm, XV(6)), XV(7)); PTIE(o[0]);
    VWAIT(6, S2, S3); o[0] = __builtin_amdgcn_mfma_f32_32x32x16_bf16(pa1, (bf16x8){S2[0], S2[1], S2[2], S2[3], S3[0], S3[1], S3[2], S3[3]}, o[0], 0, 0, 0); TRRDT(S2, 4608, o[0]); TRRD(S3, 6656); pm = fmaxf(fmaxf(pm, XV(8)), XV(9)); pm = fmaxf(fmaxf(pm, XV(10)), XV(11)); pm = fmaxf(fmaxf(pm, XV(12)), XV(13)); pm = fmaxf(fmaxf(pm, XV(14)), XV(15)); PTIE(o[0]);
    VWAIT(6, S4, S5); o[0] = __builtin_amdgcn_mfma_f32_32x32x16_bf16(pa2, (bf16x8){S4[0], S4[1], S4[2], S4[3], S5[0], S5[1], S5[2], S5[3]}, o[0], 0, 0, 0); TRRDT(S4, 8704, o[0]); TRRD(S5, 10752); pm = fmaxf(fmaxf(pm, XV(16)), XV(17)); pm = fmaxf(fmaxf(pm, XV(18)), XV(19)); pm = fmaxf(fmaxf(pm, XV(20)), XV(21)); pm = fmaxf(fmaxf(pm, XV(22)), XV(23)); PTIE(o[0]);
    VWAIT(6, S6, S7); o[0] = __builtin_amdgcn_mfma_f32_32x32x16_bf16(pa3, (bf16x8){S6[0], S6[1], S6[2], S6[3], S7[0], S7[1], S7[2], S7[3]}, o[0], 0, 0, 0); TRRDT(S6, 12800, o[0]); TRRD(S7, 14848); pm = fmaxf(fmaxf(pm, XV(24)), XV(25)); pm = fmaxf(fmaxf(pm, XV(26)), XV(27)); pm = fmaxf(fmaxf(pm, XV(28)), XV(29)); pm = fmaxf(fmaxf(pm, XV(30)), XV(31)); PTIE(o[0]);
    VWAIT(6, S0, S1); o[1] = __builtin_amdgcn_mfma_f32_32x32x16_bf16(pa0, (bf16x8){S0[0], S0[1], S0[2], S0[3], S1[0], S1[1], S1[2], S1[3]}, o[1], 0, 0, 0); TRRDT(S0, 1024, o[1]); TRRD(S1, 3072); { auto rr = __builtin_amdgcn_permlane32_swap(__float_as_uint(pm), __float_as_uint(pm), false, false); pm = fmaxf(__uint_as_float(rr[0]), __uint_as_float(rr[1])); } { const bool ok_ = __all(pm - m_reg <= THR2); const float mx_ = fmaxf(m_reg, pm); mn = ok_ ? m_reg : mx_; alpha = __builtin_amdgcn_exp2f(m_reg - mn); m_reg = mn; asm volatile("" : "+v"(mn), "+v"(alpha)); } PTIE(o[1]);
    VWAIT(6, S2, S3); o[1] = __builtin_amdgcn_mfma_f32_32x32x16_bf16(pa1, (bf16x8){S2[0], S2[1], S2[2], S2[3], S3[0], S3[1], S3[2], S3[3]}, o[1], 0, 0, 0); TRRDT(S2, 5120, o[1]); TRRD(S3, 7168); x0[0] = __builtin_amdgcn_exp2f(x0[0] - mn); x1[0] -= mn; PTIE(o[1]);
    VWAIT(6, S4, S5); o[1] = __builtin_amdgcn_mfma_f32_32x32x16_bf16(pa2, (bf16x8){S4[0], S4[1], S4[2], S4[3], S5[0], S5[1], S5[2], S5[3]}, o[1], 0, 0, 0); TRRDT(S4, 9216, o[1]); TRRD(S5, 11264); x0[1] = __builtin_amdgcn_exp2f(x0[1] - mn); x1[1] -= mn; PTIE(o[1]);
    VWAIT(6, S6, S7); o[1] = __builtin_amdgcn_mfma_f32_32x32x16_bf16(pa3, (bf16x8){S6[0], S6[1], S6[2], S6[3], S7[0], S7[1], S7[2], S7[3]}, o[1], 0, 0, 0); TRRDT(S6, 13312, o[1]); TRRD(S7, 15360); x0[2] = __builtin_amdgcn_exp2f(x0[2] - mn); x1[2] -= mn; x0[3] = __builtin_amdgcn_exp2f(x0[3] - mn); x1[3] -= mn; PTIE(o[1]);
    VWAIT(6, S0, S1); o[2] = __builtin_amdgcn_mfma_f32_32x32x16_bf16(pa0, (bf16x8){S0[0], S0[1], S0[2], S0[3], S1[0], S1[1], S1[2], S1[3]}, o[2], 0, 0, 0); TRRDT(S0, 1536, o[2]); TRRD(S1, 3584); x0[4] = __builtin_amdgcn_exp2f(x0[4] - mn); x1[4] -= mn; PTIE(o[2]);
    VWAIT(6, S2, S3); o[2] = __builtin_amdgcn_mfma_f32_32x32x16_bf16(pa1, (bf16x8){S2[0], S2[1], S2[2], S2[3], S3[0], S3[1], S3[2], S3[3]}, o[2], 0, 0, 0); TRRDT(S2, 5632, o[2]); TRRD(S3, 7680); x0[5] = __builtin_amdgcn_exp2f(x0[5] - mn); x1[5] -= mn; x0[6] = __builtin_amdgcn_exp2f(x0[6] - mn); x1[6] -= mn; PTIE(o[2]);
    VWAIT(6, S4, S5); o[2] = __builtin_amdgcn_mfma_f32_32x32x16_bf16(pa2, (bf16x8){S4[0], S4[1], S4[2], S4[3], S5[0], S5[1], S5[2], S5[3]}, o[2], 0, 0, 0); TRRDT(S4, 9728, o[2]); TRRD(S5, 11776); x0[7] = __builtin_amdgcn_exp2f(x0[7] - mn); x1[7] -= mn; PTIE(o[2]);
    VWAIT(6, S6, S7); o[2] = __builtin_amdgcn_mfma_f32_32x32x16_bf16(pa3, (bf16x8){S6[0], S6[1], S6[2], S6[3], S7[0], S7[1], S7[2], S7[3]}, o[2], 0, 0, 0); TRRDT(S6, 13824, o[2]); TRRD(S7, 15872); x0[8] = __builtin_amdgcn_exp2f(x0[8] - mn); x1[8] -= mn; x0[9] = __builtin_amdgcn_exp2f(x0[9] - mn); x1[9] -= mn; PTIE(o[2]);
    VWAIT(6, S0, S1); o[3] = __builtin_amdgcn_mfma_f32_32x32x16_bf16(pa0, (bf16x8){S0[0], S0[1], S0[2], S0[3], S1[0], S1[1], S1[2], S1[3]}, o[3], 0, 0, 0); x0[10] = __builtin_amdgcn_exp2f(x0[10] - mn); x1[10] -= mn; PTIE(o[3]);
    VWAIT(4, S2, S3); o[3] = __builtin_amdgcn_mfma_f32_32x32x16_bf16(pa1, (bf16x8){S2[0], S2[1], S2[2], S2[3], S3[0], S3[1], S3[2], S3[3]}, o[3], 0, 0, 0); x0[11] = __builtin_amdgcn_exp2f(x0[11] - mn); x1[11] -= mn; x0[12] = __builtin_amdgcn_exp2f(x0[12] - mn); x1[12] -= mn; PTIE(o[3]);
    VWAIT(2, S4, S5); o[3] = __builtin_amdgcn_mfma_f32_32x32x16_bf16(pa2, (bf16x8){S4[0], S4[1], S4[2], S4[3], S5[0], S5[1], S5[2], S5[3]}, o[3], 0, 0, 0); x0[13] = __builtin_amdgcn_exp2f(x0[13] - mn); x1[13] -= mn; PTIE(o[3]);
    VWAIT(0, S6, S7); o[3] = __builtin_amdgcn_mfma_f32_32x32x16_bf16(pa3, (bf16x8){S6[0], S6[1], S6[2], S6[3], S7[0], S7[1], S7[2], S7[3]}, o[3], 0, 0, 0); x0[14] = __builtin_amdgcn_exp2f(x0[14] - mn); x1[14] -= mn; x0[15] = __builtin_amdgcn_exp2f(x0[15] - mn); x1[15] -= mn; PTIE(o[3]);
#undef TRRD
#undef TRRDT
#undef VWAIT
#undef PTIE
#undef XV
}

template <class P>
__device__ __forceinline__ void attn_block(const P& p, LAS unsigned char* lds, const int tid_in, float& m_out, float& l_out) {
    int tid = tid_in; asm volatile("" : "+v"(tid));
    constexpr int DQK = P::DQK, NQF = DQK / 16, KROWB = DQK * 2, SHM_K = 64 * KROWB, KCH = DQK / 8, NKL = KCH * 64 / 512;
    const int wid = __builtin_amdgcn_readfirstlane(tid >> 6), lane = tid & 63, r32 = lane & 31, hi = lane >> 5;
    constexpr int NVB = P::DMA ? 3 : 2;
    LAS unsigned char* V_lds = lds; LAS unsigned char* K_lds = lds + NVB * SHM_V;
    LAS float* wsf = (LAS float*)(lds + NVB * SHM_V + 2 * SHM_K) + wid * 64; LAS float* li_l = wsf; LAS float* al_l = wsf + 32;
    const int NT = p.nt, row = wid * 32 + r32;
    constexpr int NQR = P::NQR;
    LAS unsigned char* qlds = lds + NVB * SHM_V + 2 * SHM_K + 2048 + wid * ((NQF - NQR) * 1024) + lane * 16;
    bf16x8 qr[NQR];
    { const bf16_t* qp = p.Q + (size_t)row * p.q_pitch + hi * 8;
#pragma unroll
      for (int d0 = 0; d0 < NQF; ++d0) { const bf16x8 v = *(const bf16x8*)(qp + d0 * 16); if (d0 < NQR) qr[d0] = v; else *(LAS bf16x8*)(qlds + (d0 - NQR) * 1024) = v; } }
    const int qm = p.pos(row) - 4 * hi;
    const int wlo = __builtin_amdgcn_readfirstlane(p.pos(wid * 32)), whi = __builtin_amdgcn_readfirstlane(p.pos(wid * 32 + 31));
    const unsigned W = (unsigned)p.W;
    float sl2 = 0.f; if constexpr (P::ALIBI) sl2 = p.slope2(row);
    float m_reg = -1e30f, l_reg = 0.f; if constexpr (P::FIXEDM) m_reg = p.mfix;
    f32x16 o[4] = {};
    const int vb0 = (int)(uintptr_t)V_lds + v_rd_base(lane);
    bf16x8 st_k[NKL], st_v0, st_v1;
#define VMW() asm volatile("s_waitcnt vmcnt(0)" ::: "memory")
#define SLOAD(t) do { int t_ = tid; asm volatile("" : "+v"(t_)); const int kb_ = p.kbase(t); const bf16_t* kp_ = p.K + (size_t)kb_ * p.k_pitch; \
        if constexpr (P::SC1) { const __amdgpu_buffer_rsrc_t kr_s = mk_rsrc(kp_); \
            _Pragma("unroll") for (int i_ = 0; i_ < NKL; ++i_) { const int id_ = t_ + 512 * i_, kr_ = id_ / KCH, kc_ = id_ - kr_ * KCH; st_k[i_] = ld_sc1(kr_s, (kr_ * p.k_pitch + kc_ * 8) * 2); } \
            if constexpr (P::PV) { const __amdgpu_buffer_rsrc_t vr_s = mk_rsrc(p.V + (size_t)kb_ * p.v_pitch); const int sr_ = t_ >> 4, sc_ = (t_ & 15) * 8; st_v0 = ld_sc1(vr_s, (sr_ * p.v_pitch + sc_) * 2); st_v1 = ld_sc1(vr_s, ((32 + sr_) * p.v_pitch + sc_) * 2); } \
        } else { \
        _Pragma("unroll") for (int i_ = 0; i_ < NKL; ++i_) { const int id_ = t_ + 512 * i_, kr_ = id_ / KCH, kc_ = id_ - kr_ * KCH; st_k[i_] = *(const bf16x8*)(kp_ + kr_ * p.k_pitch + kc_ * 8); } \
        if constexpr (P::PV) { const bf16_t* vp_ = p.V + (size_t)kb_ * p.v_pitch; const int sr_ = t_ >> 4, sc_ = (t_ & 15) * 8; st_v0 = *(const bf16x8*)(vp_ + sr_ * p.v_pitch + sc_); st_v1 = *(const bf16x8*)(vp_ + (32 + sr_) * p.v_pitch + sc_); } } } while (0)
#define SWRITE(bf) do { int t_ = tid; asm volatile("" : "+v"(t_)); \
        _Pragma("unroll") for (int i_ = 0; i_ < NKL; ++i_) { const int id_ = t_ + 512 * i_, kr_ = id_ / KCH, kc_ = id_ - kr_ * KCH; *(LAS bf16x8*)(K_lds + (bf) * SHM_K + kr_ * KROWB + ((kc_ * 16) ^ (kswz<DQK>(kr_) << 4))) = st_k[i_]; } \
        if constexpr (P::PV) { const int sr_ = t_ >> 4, sc_ = (t_ & 15) * 8; *(LAS bf16x8*)(V_lds + (bf) * SHM_V + v_st(sr_, sc_)) = st_v0; *(LAS bf16x8*)(V_lds + (bf) * SHM_V + v_st(32 + sr_, sc_)) = st_v1; } } while (0)
#define RESC(a) do { if constexpr (P::PV && !P::FIXEDM) { if (__any((a) < 1.f)) { if (hi == 0) al_l[r32] = (a); asm volatile("s_waitcnt lgkmcnt(0)" ::: "memory"); \
        _Pragma("unroll") for (int d_ = 0; d_ < 4; ++d_) _Pragma("unroll") for (int r = 0; r < 16; ++r) o[d_][r] *= al_l[crow(r, hi)]; } } } while (0)
#define ACT(t) (!P::SK || (p.kbase(t) <= whi && p.kbase(t) + 63 >= wlo - (int)W + 1 && (!P::SEL || p.sel_wave(wid, (t)))))
#define MASKT(P0_, P1_, t) do { const int kb_ = p.kbase(t); if (ACT(t)) { if constexpr (P::ALIBI) bias_tile(P0_, P1_, qm - kb_, sl2); \
        if (kb_ + 63 > wlo || kb_ <= whi - (int)W) mask_tile(P0_, P1_, qm - kb_, W); \
        if constexpr (P::SEL) { if (!p.sel_row(row, (t))) { const float NEG_ = -__builtin_inff(); _Pragma("unroll") for (int r = 0; r < 16; ++r) { P0_[r] = NEG_; P1_[r] = NEG_; } } } } } while (0)
#define FINISH(PY0, PY1, alY, t) do { finishSM_exp(PY0, PY1, alY, l_reg); p.hook(PY0, PY1, p.kbase(t), lane, ACT(t)); if constexpr (P::PV) finishSM_pack(PY0, PY1, pa0, pa1, pa2, pa3); } while (0)
#define PVT(VB, t) do { if constexpr (P::PV) pv_tile<VB>(o, vb0, pa0, pa1, pa2, pa3, ACT(t)); } while (0)
    f32x16 pA0, pA1, pB0, pB1; float mnA, mnB, alA, alB; bf16x8 pa0, pa1, pa2, pa3;
    if constexpr (P::DMA) {
    unsigned kvo[NKL], vvo[2];
#pragma unroll
    for (int i_ = 0; i_ < NKL; ++i_) { const int ci = tid + 512 * i_, kr_ = ci / KCH, pc_ = ci - kr_ * KCH, kc_ = pc_ ^ kswz<DQK>(kr_); kvo[i_] = (unsigned)((kr_ * p.k_pitch + kc_ * 8) * 2); }
#pragma unroll
    for (int j_ = 0; j_ < 2; ++j_) { const int ci = tid + 512 * j_, kk = ((ci >> 7) << 3) | ((ci & 31) >> 2), k_ = (kk & ~0xC) | ((kk & 4) << 1) | ((kk & 8) >> 1), c_ = ((ci >> 5) & 3) * 32 + (ci & 3) * 8;
        vvo[j_] = (unsigned)((k_ * p.v_pitch + c_) * 2); }
#define DMAT(t, KS, VS) do { const int kb_ = p.kbase(t); const char* kp_ = (const char*)(p.K + (size_t)kb_ * p.k_pitch); const char* vp_ = (const char*)(p.V + (size_t)kb_ * p.v_pitch); \
        _Pragma("unroll") for (int i_ = 0; i_ < NKL; ++i_) __builtin_amdgcn_global_load_lds((const unsigned*)(kp_ + kvo[i_]), (LAS unsigned*)(K_lds + (KS) * SHM_K + (i_ * 8 + wid) * 1024), 16, 0, 0); \
        _Pragma("unroll") for (int j_ = 0; j_ < 2; ++j_) __builtin_amdgcn_global_load_lds((const unsigned*)(vp_ + vvo[j_]), (LAS unsigned*)(V_lds + (VS) * SHM_V + (j_ * 8 + wid) * 1024), 16, 0, 0); } while (0)
#define PVR(vs, t) do { pv_tile<0>(o, vb0 + (vs) * SHM_V, pa0, pa1, pa2, pa3, ACT(t)); } while (0)
    DMAT(0, 0, 0); VMW(); __syncthreads();
    if (NT > 1) DMAT(1, 1, 1);
    SBAR(); qkt<0, DQK, NQR>(pA0, pA1, K_lds, r32, hi, qr, qlds, ACT(0)); SBAR();
    MASKT(pA0, pA1, 0); partialSM<P::FIXEDM>(pA0, pA1, m_reg, mnA, alA);
    VMW(); __syncthreads();
    int vr = 0;
#define DSTEP(PX0, PX1, mnX, alX, PY0, PY1, alY, t, KB) do { \
        const int tn_ = (t) + 1 < NT ? (t) + 1 : NT - 1, kbn_ = p.kbase(tn_), vw_ = vr == 0 ? 2 : vr - 1;        \
        const char* kpn_ = (const char*)(p.K + (size_t)kbn_ * p.k_pitch); const char* vpn_ = (const char*)(p.V + (size_t)kbn_ * p.v_pitch); \
        auto dm_ = [&](int f_) { _Pragma("unroll") for (int k_ = 0; k_ < NKL + 2; ++k_) if (f_ == (k_ * (DQK / 8)) / (NKL + 2) + 1) { \
            if (k_ < NKL) __builtin_amdgcn_global_load_lds((const unsigned*)(kpn_ + kvo[k_ < NKL ? k_ : 0]), (LAS unsigned*)(K_lds + ((KB) ^ 1) * SHM_K + (k_ * 8 + wid) * 1024), 16, 0, 0); \
            else __builtin_amdgcn_global_load_lds((const unsigned*)(vpn_ + vvo[k_ < NKL ? 0 : k_ - NKL]), (LAS unsigned*)(V_lds + vw_ * SHM_V + ((k_ - NKL) * 8 + wid) * 1024), 16, 0, 0); } }; \
        qkt_fin<KB, DQK>(PX0, PX1, K_lds, r32, hi, qr, ACT(t), PY0, PY1, alY, l_reg, pa0, pa1, pa2, pa3, dm_); \
        MASKT(PX0, PX1, (t)); pv_sm(o, vb0 + vr * SHM_V, pa0, pa1, pa2, pa3, ACT((t) - 1), PX0, PX1, m_reg, mnX, alX); RESC(alX); \
        vr = vr == 2 ? 0 : vr + 1; \
        VMW(); __syncthreads(); } while (0)
    for (int t = 1; t + 1 < NT; t += 2) {
        DSTEP(pB0, pB1, mnB, alB, pA0, pA1, alA, t, 1);
        DSTEP(pA0, pA1, mnA, alA, pB0, pB1, alB, t + 1, 0);
    }
    const bool even = (NT & 1) == 0;
    if (even) { SBAR(); qkt<1, DQK, NQR>(pB0, pB1, K_lds, r32, hi, qr, qlds, ACT(NT - 1)); SBAR(); }
    FINISH(pA0, pA1, alA, even ? NT - 2 : NT - 1); SBAR();
    PVR(vr, even ? NT - 2 : NT - 1);
    if (even) { MASKT(pB0, pB1, NT - 1); partialSM<P::FIXEDM>(pB0, pB1, m_reg, mnB, alB); RESC(alB);
        FINISH(pB0, pB1, alB, NT - 1); SBAR(); PVR(vr == 2 ? 0 : vr + 1, NT - 1); }
#undef DMAT
#undef PVR
#undef DSTEP
    } else {
    SLOAD(0); VMW(); SWRITE(0);
    if (NT > 1) SLOAD(1);
    __syncthreads();
    SBAR(); qkt<0, DQK, NQR>(pA0, pA1, K_lds, r32, hi, qr, qlds, ACT(0));
    MASKT(pA0, pA1, 0); partialSM<P::FIXEDM>(pA0, pA1, m_reg, mnA, alA);
    if (NT > 1) { VMW(); SWRITE(1); }
    __syncthreads();
#define HALF_STEP(PX0, PX1, mnX, alX, PY0, PY1, alY, t, KB, VB, SB) do { \
        SBAR(); if constexpr (NQR == NQF && P::PV) { qkt_fin<KB, DQK>(PX0, PX1, K_lds, r32, hi, qr, ACT(t), PY0, PY1, alY, l_reg, pa0, pa1, pa2, pa3); } \
        else { qkt<KB, DQK, NQR>(PX0, PX1, K_lds, r32, hi, qr, qlds, ACT(t)); FINISH(PY0, PY1, alY, (t) - 1); } SBAR(); \
        if ((t) + 1 < NT) { SLOAD((t) + 1); SBAR(); } \
        PVT(VB, (t) - 1); MASKT(PX0, PX1, (t)); partialSM<P::FIXEDM>(PX0, PX1, m_reg, mnX, alX); \
        __syncthreads(); \
        if ((t) + 1 < NT) { VMW(); SWRITE(SB); } \
        RESC(alX); __syncthreads(); } while (0)
    for (int t = 1; t + 1 < NT; t += 2) {
        HALF_STEP(pB0, pB1, mnB, alB, pA0, pA1, alA, t, 1, 0, 0);
        HALF_STEP(pA0, pA1, mnA, alA, pB0, pB1, alB, t + 1, 0, 1, 1);
    }
    const bool even = (NT & 1) == 0;
    if (even) { SBAR(); qkt<1, DQK, NQR>(pB0, pB1, K_lds, r32, hi, qr, qlds, ACT(NT - 1)); SBAR(); }
    FINISH(pA0, pA1, alA, even ? NT - 2 : NT - 1); SBAR();
    PVT(0, even ? NT - 2 : NT - 1);
    if (even) { MASKT(pB0, pB1, NT - 1); partialSM<P::FIXEDM>(pB0, pB1, m_reg, mnB, alB); RESC(alB);
        FINISH(pB0, pB1, alB, NT - 1); SBAR(); PVT(1, NT - 1); }
    }
    m_out = m_reg; l_out = l_reg;
    p.store(o, l_reg, m_reg, li_l, wid, lane, r32, hi);
    __syncthreads();
#undef VMW
#undef SLOAD
#undef SWRITE
#undef RESC
#undef ACT
#undef MASKT
#undef FINISH
#undef PVT
#undef HALF_STEP
}

struct PolBase {
    static constexpr bool DMA = false;
    const bf16_t* Q; const bf16_t* K; const bf16_t* V; int q_pitch, k_pitch, v_pitch; int nt, j0, P0, W; float mfix;
    __device__ __forceinline__ int kbase(int t) const { return (j0 + t) * 64; }
    __device__ __forceinline__ void hook(const f32x16&, const f32x16&, int, int, bool) const {}
    __device__ __forceinline__ bool sel_row(int, int) const { return true; }
    __device__ __forceinline__ bool sel_wave(int, int) const { return true; }
};
struct PolMLA : PolBase {
    static constexpr int DQK = 192, NQR = 12; static constexpr bool ALIBI = false, SK = false, SEL = false, FIXEDM = false, PV = true, SC1 = false, DMA = true;
    bf16_t* O; int o_pitch;
    __device__ __forceinline__ int pos(int row) const { return P0 + row; }
    __device__ __forceinline__ float slope2(int) const { return 0.f; }
    __device__ __forceinline__ void store(const f32x16 (&o)[4], float l_reg, float, LAS float* li_l, int wid, int lane, int r32, int hi) const {
        asm volatile("" : "+v"(r32), "+v"(hi));
        if (hi == 0) li_l[r32] = l_reg; asm volatile("s_waitcnt lgkmcnt(0)" ::: "memory");
        bf16_t* Ow = O + (size_t)(wid * 32) * o_pitch;
#pragma unroll
        for (int r = 0; r < 16; ++r) { const int orow = crow(r, hi); const float rl = __builtin_amdgcn_rcpf(li_l[orow]);
#pragma unroll
            for (int d0 = 0; d0 < 4; ++d0) { const float v = o[d0][r] * rl; const float vn = shx(v, 1, hi * 32 + r32);
                if ((r32 & 1) == 0) *(unsigned*)(Ow + (size_t)orow * o_pitch + d0 * 32 + r32) = cvt_pk_bf16(v, vn); } }
    }
};

__device__ __forceinline__ float alibi_slope(int i) { return __builtin_amdgcn_exp2f(-0.8f * (float)i); }
__device__ __forceinline__ float dpp_xor1(float v) { return __int_as_float(__builtin_amdgcn_update_dpp(0, __float_as_int(v), 0xB1, 0xF, 0xF, true)); }
__device__ __forceinline__ float dpp_xor2(float v) { return __int_as_float(__builtin_amdgcn_update_dpp(0, __float_as_int(v), 0x4E, 0xF, 0xF, true)); }

struct PolDil : PolBase {
    static constexpr int DQK = 128, NQR = 8; static constexpr bool ALIBI = true, SK = true, SEL = false, FIXEDM = false, PV = true, SC1 = false, DMA = DIL_DMA;
    bf16_t* O; int o_pitch; float* LSE; int lse_pitch; float sl2;
    __device__ __forceinline__ int pos(int row) const { return P0 + row; }
    __device__ __forceinline__ float slope2(int) const { return sl2; }
    __device__ __forceinline__ void store(const f32x16 (&o)[4], float l_reg, float m_reg, LAS float* li_l, int wid, int lane, int r32, int hi) const {
        asm volatile("" : "+v"(r32), "+v"(hi));
        if (hi == 0) { li_l[r32] = l_reg; LSE[(size_t)(wid * 32 + r32) * lse_pitch] = (m_reg + __builtin_amdgcn_logf(l_reg)) * 0.6931471805599453f; }
        asm volatile("s_waitcnt lgkmcnt(0)" ::: "memory");
        bf16_t* Ow = O + (size_t)(wid * 32) * o_pitch;
#pragma unroll
        for (int r = 0; r < 16; ++r) { const int orow = crow(r, hi); const float rl = __builtin_amdgcn_rcpf(li_l[orow]);
#pragma unroll
            for (int d0 = 0; d0 < 4; ++d0) { const float v = o[d0][r] * rl; const float vn = shx(v, 1, hi * 32 + r32);
                if ((r32 & 1) == 0) *(unsigned*)(Ow + (size_t)orow * o_pitch + d0 * 32 + r32) = cvt_pk_bf16(v, vn); } }
    }
};
struct PolNsaBase : PolBase {
    static constexpr int DQK = 128, NQR = 6;
    int t0;
    __device__ __forceinline__ float slope2(int row) const { return alibi_slope(7 + (row & 3)) * 1.4426950408889634f; }
};
struct PolCmp1 : PolNsaBase {
    static constexpr bool ALIBI = true, SK = false, SEL = false, FIXEDM = false, PV = false, SC1 = false;
    __device__ __forceinline__ int pos(int row) const { return (t0 + (row >> 2) - 31) >> 4; }
    __device__ __forceinline__ float slope2(int row) const { return 16.0f * PolNsaBase::slope2(row); }
    __device__ __forceinline__ void store(const f32x16 (&)[4], float, float, LAS float*, int, int, int, int) const {}
};
template <int BR>
__device__ __forceinline__ void nsa_store(const f32x16 (&o)[4], float l_reg, LAS float* li_l, int wid, int r32, int hi, const float* gates  , float* nsaf  , bf16_t* ocat  ) {
    asm volatile("" : "+v"(r32), "+v"(hi));
    if (hi == 0) { const int row = wid * 32 + r32; const float g = gates[(size_t)(row >> 2) * 16 + (row & 3) * 3 + BR];
        li_l[r32] = BR == 0 ? g : (l_reg > 0.f ? g * __builtin_amdgcn_rcpf(l_reg) : 0.f); }
    asm volatile("s_waitcnt lgkmcnt(0)" ::: "memory");
#pragma unroll
    for (int r = 0; r < 16; ++r) { const int grow = wid * 32 + crow(r, hi); const float f = li_l[crow(r, hi)];
#pragma unroll
        for (int d0 = 0; d0 < 4; ++d0) { float v = o[d0][r] * f; float* np = nsaf + (size_t)grow * 128 + d0 * 32 + r32;
            if (BR == 0) *np = v;
            else if (BR == 1) *np += v;
            else { v += *np; const float vn = shx(v, 1, hi * 32 + r32);
                if ((r32 & 1) == 0) *(unsigned*)(ocat + (size_t)(grow >> 2) * DM + (grow & 3) * 128 + d0 * 32 + r32) = cvt_pk_bf16(v, vn); } } }
}
struct PolCmp2 : PolNsaBase {
    static constexpr bool ALIBI = true, SK = false, SEL = false, FIXEDM = true, PV = true, SC1 = false;
    LAS float* score; const float* gates; float* nsaf; int wid_;
    __device__ __forceinline__ int pos(int row) const { return (t0 + (row >> 2) - 31) >> 4; }
    __device__ __forceinline__ float slope2(int row) const { return 16.0f * PolNsaBase::slope2(row); }
    __device__ __forceinline__ void hook(const f32x16& p0, const f32x16& p1, int kb, int lane, bool) const {
        const int r32 = lane & 31, hi = lane >> 5; LAS float* sc = score + (wid_ * 8 + (r32 >> 2)) * 256 + (kb >> 2) + hi;
        asm volatile("s_waitcnt lgkmcnt(0)" ::: "memory");
#pragma unroll
        for (int g = 0; g < 4; ++g) {
            float a = (p0[4 * g] + p0[4 * g + 1]) + (p0[4 * g + 2] + p0[4 * g + 3]), b = (p1[4 * g] + p1[4 * g + 1]) + (p1[4 * g + 2] + p1[4 * g + 3]);
            a += dpp_xor1(a); a += dpp_xor2(a); b += dpp_xor1(b); b += dpp_xor2(b);
            if ((r32 & 3) == 0) { sc[2 * g] += a; sc[8 + 2 * g] += b; } }
        asm volatile("s_waitcnt lgkmcnt(0)" ::: "memory");
#pragma unroll
        for (int g = 0; g < 4; ++g) {
            float ea = p0[4 * g + 3], eb = p1[4 * g + 3];
            ea += dpp_xor1(ea); ea += dpp_xor2(ea); eb += dpp_xor1(eb); eb += dpp_xor2(eb);
            if ((r32 & 3) == 0) { sc[2 * g + 1] += ea; if ((kb >> 2) + hi + 8 + 2 * g + 1 < 256) sc[8 + 2 * g + 1] += eb; } }
    }
    __device__ __forceinline__ void store(const f32x16 (&o)[4], float l_reg, float, LAS float* li_l, int wid, int, int r32, int hi) const { nsa_store<0>(o, l_reg, li_l, wid, r32, hi, gates, nsaf, nullptr); }
};
struct PolSlc : PolNsaBase {
    static constexpr bool ALIBI = true, SK = true, SEL = true, FIXEDM = false, PV = true, SC1 = true;
    LAS const int* tlist; LAS const unsigned* selm  ; LAS const unsigned* wunion  ; const float* gates; float* nsaf;
    __device__ __forceinline__ int kbase(int t) const { return __builtin_amdgcn_readfirstlane(tlist[t]) * 64; }
    __device__ __forceinline__ int pos(int row) const { return t0 + (row >> 2); }
    __device__ __forceinline__ bool sel_wave(int wid, int t) const { const int j = __builtin_amdgcn_readfirstlane(tlist[t]); return (__builtin_amdgcn_readfirstlane(wunion[wid * 8 + (j >> 5)]) >> (j & 31)) & 1u; }
    __device__ __forceinline__ bool sel_row(int row, int t) const { const int j = __builtin_amdgcn_readfirstlane(tlist[t]); return (selm[(row >> 2) * 8 + (j >> 5)] >> (j & 31)) & 1u; }
    __device__ __forceinline__ void store(const f32x16 (&o)[4], float l_reg, float, LAS float* li_l, int wid, int, int r32, int hi) const { nsa_store<1>(o, l_reg, li_l, wid, r32, hi, gates, nsaf, nullptr); }
};
struct PolWin : PolNsaBase {
    static constexpr bool ALIBI = true, SK = true, SEL = false, FIXEDM = false, PV = true, SC1 = true;
    const float* gates; float* nsaf; bf16_t* ocat;
    __device__ __forceinline__ int pos(int row) const { return t0 + (row >> 2); }
    __device__ __forceinline__ void store(const f32x16 (&o)[4], float l_reg, float, LAS float* li_l, int wid, int, int r32, int hi) const { nsa_store<2>(o, l_reg, li_l, wid, r32, hi, gates, nsaf, ocat); }
};

constexpr int NSA_SCORE_OFF = 83968, NSA_SEL_OFF = NSA_SCORE_OFF + 65536, NSA_WUN_OFF = NSA_SEL_OFF + 2048, NSA_UNI_OFF = NSA_WUN_OFF + 256, NSA_TL_OFF = NSA_UNI_OFF + 64, NSA_END = NSA_TL_OFF + 1028;
static_assert(NSA_END <= 159744, "NSA LDS map");
struct NsaBufs { const bf16_t* NQ; const bf16_t* NKV; const bf16_t* KC; const bf16_t* VC; const float* GATES; float* NSAF; bf16_t* OCAT; };
__device__ __forceinline__ void nsa_unit(const NsaBufs& nb, int b, int t0, LAS unsigned char* lds, const int tid_in) {
    int tid = tid_in; asm volatile("" : "+v"(tid));
    const int wid = __builtin_amdgcn_readfirstlane(tid >> 6), lane = tid & 63;
    LAS float* score = (LAS float*)(lds + NSA_SCORE_OFF); LAS unsigned* selm = (LAS unsigned*)(lds + NSA_SEL_OFF); LAS unsigned* wun = (LAS unsigned*)(lds + NSA_WUN_OFF);
    LAS unsigned* uni = (LAS unsigned*)(lds + NSA_UNI_OFF); LAS int* tl = (LAS int*)(lds + NSA_TL_OFF);
    const size_t tok0 = (size_t)b * SEQ + t0;
    const float* gates = nb.GATES + tok0 * 16; float* nsaf = nb.NSAF + tok0 * 512; const bf16_t* Q = nb.NQ + tok0 * 512;
    for (int e = tid; e < 64 * 256; e += 512) score[e] = 0.f;
    __syncthreads();
    const int maxc = (t0 + 32) >> 4, ntc = (maxc >> 6) + 1;
    float m1, l1;
    { PolCmp1 p; p.Q = Q; p.q_pitch = 128; p.K = nb.KC + (size_t)b * 1024 * 128; p.k_pitch = 128; p.V = nullptr; p.v_pitch = 0; p.nt = ntc; p.j0 = 0; p.P0 = 0; p.W = 0x40000000; p.mfix = 0.f; p.t0 = t0;
      attn_block(p, lds, tid, m1, l1); }
    { PolCmp2 p; p.Q = Q; p.q_pitch = 128; p.K = nb.KC + (size_t)b * 1024 * 128; p.k_pitch = 128; p.V = nb.VC + (size_t)b * 1024 * 128; p.v_pitch = 128; p.nt = ntc; p.j0 = 0; p.P0 = 0; p.W = 0x40000000; p.t0 = t0;
      p.mfix = l1 > 0.f ? m1 + __builtin_amdgcn_logf(l1) : 1e30f; p.score = score; p.gates = gates; p.nsaf = nsaf; p.wid_ = wid;
      float m2, l2; attn_block(p, lds, tid, m2, l2); }
    {
        asm volatile("s_waitcnt lgkmcnt(0)" ::: "memory");
        unsigned key[8][4], sel[8];
        const int curb = (t0 + wid * 8) >> 6;
#pragma unroll
        for (int k = 0; k < 8; ++k) { sel[k] = 0u;
#pragma unroll
            for (int q = 0; q < 4; ++q) { const int j = lane + 64 * q; const float sv = score[(wid * 8 + k) * 256 + j];
                key[k][q] = (j >= 1 && j <= curb - 2) ? ((__float_as_uint(sv) & 0xFFFFFF00u) | (unsigned)(255 - j)) : 0u; } }
        if (curb >= 3) {
            for (int it = 0; it < 13; ++it) {
                unsigned best[8], wm[8]; int bq[8];
#pragma unroll
                for (int k = 0; k < 8; ++k) { best[k] = key[k][0]; bq[k] = 0;
#pragma unroll
                    for (int q = 1; q < 4; ++q) if (key[k][q] > best[k]) { best[k] = key[k][q]; bq[k] = q; }
                    wm[k] = best[k]; }
#pragma unroll
                for (int of = 1; of < 64; of <<= 1) {
#pragma unroll
                    for (int k = 0; k < 8; ++k) { const unsigned o_ = shxu(wm[k], of, lane); wm[k] = o_ > wm[k] ? o_ : wm[k]; } }
                unsigned any = 0u;
#pragma unroll
                for (int k = 0; k < 8; ++k) { any |= wm[k];
                    if (best[k] == wm[k] && wm[k] != 0u) { sel[k] |= 1u << bq[k];
#pragma unroll
                        for (int q = 0; q < 4; ++q) if (q == bq[k]) key[k][q] = 0u; } }
                if (__builtin_amdgcn_readfirstlane(any) == 0u) break;
            }
        }
        unsigned long long wuni[4] = {0ull, 0ull, 0ull, 0ull};
#pragma unroll
        for (int k = 0; k < 8; ++k) { const int tokl = wid * 8 + k;
#pragma unroll
            for (int q = 0; q < 4; ++q) { const int j = lane + 64 * q; const bool on = ((sel[k] >> q) & 1u) || j == 0 || j == curb || j == curb - 1;
                const unsigned long long bm = __ballot(on); wuni[q] |= bm;
                if (lane == 0) { selm[tokl * 8 + 2 * q] = (unsigned)bm; selm[tokl * 8 + 2 * q + 1] = (unsigned)(bm >> 32); } } }
        if (lane == 0) {
#pragma unroll
            for (int q = 0; q < 4; ++q) { wun[wid * 8 + 2 * q] = (unsigned)wuni[q]; wun[wid * 8 + 2 * q + 1] = (unsigned)(wuni[q] >> 32); } }
    }
    __syncthreads();
    if (tid < 8) { unsigned u = 0u; for (int w = 0; w < 8; ++w) u |= wun[w * 8 + tid]; uni[tid] = u; }
    __syncthreads();
    int nts = 0;
    { unsigned pre = 0u;
#pragma unroll
      for (int w = 0; w < 8; ++w) { const unsigned u = uni[w]; if (tid < 256 && w < (tid >> 5)) pre += __builtin_popcount(u); nts += __builtin_popcount(u); }
      if (tid < 256) { const unsigned u = uni[tid >> 5]; if ((u >> (tid & 31)) & 1u) tl[pre + __builtin_popcount(u & ((1u << (tid & 31)) - 1u))] = tid; } }
    nts = __builtin_amdgcn_readfirstlane(nts);
    __syncthreads();
    { PolSlc p; p.Q = Q; p.q_pitch = 128; p.K = nb.NKV + 2 * ((size_t)M * 128) + (size_t)b * SEQ * 128; p.k_pitch = 128; p.V = nb.NKV + 3 * ((size_t)M * 128) + (size_t)b * SEQ * 128; p.v_pitch = 128;
      p.nt = nts; p.j0 = 0; p.P0 = 0; p.W = 0x40000000; p.mfix = 0.f; p.t0 = t0; p.tlist = tl; p.selm = selm; p.wunion = wun; p.gates = gates; p.nsaf = nsaf;
      float m_, l_; attn_block(p, lds, tid, m_, l_); }
    { PolWin p; p.Q = Q; p.q_pitch = 128; p.K = nb.NKV + 4 * ((size_t)M * 128) + (size_t)b * SEQ * 128; p.k_pitch = 128; p.V = nb.NKV + 5 * ((size_t)M * 128) + (size_t)b * SEQ * 128; p.v_pitch = 128;
      const int jl = (t0 >> 6) - 8 > 0 ? (t0 >> 6) - 8 : 0; p.j0 = jl; p.nt = (t0 >> 6) - jl + 1; p.P0 = 0; p.W = 512; p.mfix = 0.f; p.t0 = t0; p.gates = gates; p.nsaf = nsaf; p.ocat = nb.OCAT + tok0 * DM + 1536;
      float m_, l_; attn_block(p, lds, tid, m_, l_); }
}
}

constexpr size_t WS_CTL = 0, CTL_ZERO_BYTES = 1u << 20;
constexpr size_t SZ_W1 = (size_t)NFF * DM * 2, SZ_W2 = (size_t)DM * FF * 2, SZ_WM = (size_t)NMIX * DM * 2, SZ_WU = (size_t)NUP * 512 * 2, SZ_WO = (size_t)DM * DM * 2, SZ_WC = (size_t)256 * 4096 * 2;
constexpr size_t LW_W1A = 0, LW_W2A = LW_W1A + SZ_W1, LW_W1B = LW_W2A + SZ_W2, LW_W2B = LW_W1B + SZ_W1, LW_WM = LW_W2B + SZ_W2, LW_WU = LW_WM + SZ_WM, LW_WO = LW_WU + SZ_WU,
                 LW_WCK = LW_WO + SZ_WO, LW_WCV = LW_WCK + SZ_WC, LW_SIZE = LW_WCV + SZ_WC;
constexpr size_t WS_W = CTL_ZERO_BYTES;
constexpr size_t WS_XB = WS_W + DEPTH * LW_SIZE;
constexpr size_t WS_SS = WS_XB + (size_t)M * DM * 2;
constexpr size_t WS_ROPE = WS_SS + (size_t)M * 32 * 4;
constexpr size_t WS_CB = WS_ROPE + (size_t)SEQ * 32 * 2 * 4;
constexpr size_t WS_BIG = WS_CB + 4096;
constexpr size_t WS_HID = WS_BIG;
constexpr size_t OV_LAT = 0, OV_LATSS = OV_LAT + (size_t)M * LATW * 2, OV_DQ = OV_LATSS + (size_t)M * 16 * 4, OV_DK = OV_DQ + (size_t)M * 768 * 2, OV_DV = OV_DK + (size_t)M * 768 * 2,
                 OV_NQ = OV_DV + (size_t)M * 768 * 2, OV_NKV = OV_NQ + (size_t)M * 512 * 2, OV_GATES = OV_NKV + 6 * (size_t)M * 128 * 2 + 65536, OV_MQ = OV_GATES + (size_t)DEPTH * M * 16 * 4,
                 OV_MK = OV_MQ + (size_t)M * 1152 * 2, OV_MV = OV_MK + (size_t)M * 1152 * 2, OV_END = OV_MV + (size_t)M * 768 * 2;
constexpr size_t BIG_BYTES = OV_END > (size_t)M * FF * 2 ? OV_END : (size_t)M * FF * 2;
constexpr size_t WS_OCAT = WS_BIG + BIG_BYTES;
constexpr size_t WS_DLSE = WS_OCAT + (size_t)M * DM * 2;
constexpr size_t WS_KC = WS_DLSE + (size_t)DEPTH * M * 8 * 4;
constexpr size_t WS_H1 = WS_KC + (size_t)DEPTH * 2 * 2048 * 128 * 2;
constexpr size_t WS_NSAF = WS_H1 + (size_t)DEPTH * 2 * 2048 * 128 * 2;
constexpr size_t WS_END_V1 = WS_NSAF + (size_t)M * 512 * 4;
static_assert(WS_END_V1 <= 1610670080ull, "d_ws map too large");
static_assert(OV_DK == OV_DQ + (size_t)M * 768 * 2 && OV_DV == OV_DK + (size_t)M * 768 * 2, "DQ|DK|DV contiguous");

constexpr int CW_CHAIN = 32768;
constexpr int CW_BAR = 4096, CW_QUEUE = 8192;
constexpr int RING_BYTES = 131072, LDSCTL_OFF = 159744, MISC_OFF = LDSCTL_OFF + 320, LDS_BYTES = 163840;

#define XB_TMO      128
#define XB_XCNT(j)  (256  + 64 * (j))
#define XB_XSUB(j)  (1280 + 64 * (j))
#define XB_XGEN(j)  (2304 + 64 * (j))
#define XB_TOP      3328
#define XB_TOPGEN   3392
#define XCD_BAR_WORDS 3456
#define XB_SPIN_CAP (1u << 18)
__device__ __forceinline__ unsigned xb_ld(unsigned* p)              { return __hip_atomic_load(p, __ATOMIC_RELAXED, __HIP_MEMORY_SCOPE_AGENT); }
__device__ __forceinline__ unsigned xb_add(unsigned* p, unsigned v) { return __hip_atomic_fetch_add(p, v, __ATOMIC_RELAXED, __HIP_MEMORY_SCOPE_AGENT); }
__device__ __forceinline__ unsigned xb_xcc_id() { return (unsigned)__builtin_amdgcn_s_getreg((3 << 11) | 20) & 0xFu; }
#define XB_SPIN(cond, bar) do { unsigned _sp = 0; while (cond) { __builtin_amdgcn_s_sleep(1); \
    if ((++_sp & 255u) == 0u) { if (xb_ld(&(bar)[XB_TMO])) break; if (_sp > XB_SPIN_CAP) { atomicAdd(&(bar)[XB_TMO], 1u); break; } } } } while (0)
struct XcdBarrier { unsigned* bar; unsigned x; volatile LAS unsigned* st; };
__device__ __forceinline__ XcdBarrier xcd_barrier_post(unsigned* bar, volatile LAS unsigned* st) {
    XcdBarrier b; b.bar = bar; b.x = xb_xcc_id(); b.st = st;
    if (threadIdx.x == 0) (void)xb_add(&bar[XB_XCNT(b.x)], 1u);
    return b;
}
__device__ __forceinline__ void xcd_barrier_complete(unsigned* bar, unsigned x, unsigned& nloc, unsigned& nx) {
    const unsigned G = gridDim.x * gridDim.y * gridDim.z;
    unsigned sum, cnt, mine, sp = 0u;
    for (;;) {
        sum = 0u; cnt = 0u; mine = 0u;
#pragma unroll
        for (unsigned j = 0; j < 16; ++j) { const unsigned c = xb_ld(&bar[XB_XCNT(j)]); sum += c; cnt += (c > 0u) ? 1u : 0u; mine = (j == x) ? c : mine; }
        if (sum == G) break;
        __builtin_amdgcn_s_sleep(1);
        if ((++sp & 255u) == 0u) { if (xb_ld(&bar[XB_TMO])) break; if (sp > XB_SPIN_CAP) { atomicAdd(&bar[XB_TMO], 1u); break; } }
    }
    nloc = mine > 0u ? mine : 1u; nx = cnt > 0u ? cnt : 1u;
}
__device__ __forceinline__ void xcd_barrier(const XcdBarrier& b, const int tid0) {
    asm volatile("s_waitcnt vmcnt(0)" ::: "memory");
    __syncthreads();
    if (tid0 == 0) {
        unsigned* bar = b.bar; asm volatile("" : "+s"(bar));
        unsigned bx = b.x; asm volatile("" : "+s"(bx));
        __builtin_amdgcn_s_waitcnt(0);
        unsigned nloc = b.st[0], nx = b.st[1];
        if (nloc == 0u) { xcd_barrier_complete(bar, bx, nloc, nx); b.st[0] = nloc; b.st[1] = nx; }
        const unsigned old = xb_add(&bar[XB_XSUB(bx)], 1u);
        const unsigned gen = old / nloc;
        if (old + 1u == (gen + 1u) * nloc) {
            __builtin_amdgcn_fence(__ATOMIC_RELEASE, "agent");
            asm volatile("s_waitcnt vmcnt(0)" ::: "memory");
            const unsigned og = xb_add(&bar[XB_TOP], 1u);
            const unsigned tg = og / nx;
            if (og + 1u == (tg + 1u) * nx) xb_add(&bar[XB_TOPGEN], 1u);
            else XB_SPIN(xb_ld(&bar[XB_TOPGEN]) == tg, bar);
            __builtin_amdgcn_fence(__ATOMIC_ACQUIRE, "agent");
            xb_add(&bar[XB_XGEN(bx)], 1u);
            asm volatile("s_waitcnt vmcnt(0)" ::: "memory");
        } else {
            XB_SPIN(xb_ld(&bar[XB_XGEN(bx)]) == gen, bar);
            __builtin_amdgcn_fence(__ATOMIC_ACQUIRE, "agent");
            asm volatile("s_waitcnt vmcnt(0)" ::: "memory");
        }
    }
    __syncthreads();
}

#define XL_OFF      (16384 - CW_BAR)
#define XL_SUB(j)   (XL_OFF + 64 * (j))
#define XL_GEN(j)   (XL_OFF + 1024 + 64 * (j))
#define XL_MM       (XL_OFF + 2048)
__device__ __forceinline__ void xcd_local_barrier(const XcdBarrier& b, const int tid0) {
    asm volatile("s_waitcnt vmcnt(0)" ::: "memory");
    __syncthreads();
    if (tid0 == 0) {
        unsigned* bar = b.bar; const unsigned bx = b.x;
        __builtin_amdgcn_s_waitcnt(0);
        const unsigned nloc = b.st[0];
        const unsigned old = xb_add(&bar[XL_SUB(bx)], 1u);
        const unsigned gen = old / nloc;
        if (old + 1u == (gen + 1u) * nloc) xb_add(&bar[XL_GEN(bx)], 1u);
        else XB_SPIN(xb_ld(&bar[XL_GEN(bx)]) == gen, bar);
        asm volatile("buffer_inv sc0\n\ts_waitcnt vmcnt(0)" ::: "memory");
    }
    __syncthreads();
}

struct Args { const float* in[20]; float* out; unsigned char* ws; };

struct MapId { int N; __device__ __forceinline__ int operator()(int n) const { return n < N ? n : -1; } };
struct MapSwiglu { __device__ __forceinline__ int operator()(int n) const { const int pn = n >> 8, j = n & 255; return j < 128 ? pn * 128 + j : FF + pn * 128 + (j - 128); } };
struct MapMix { __device__ __forceinline__ int operator()(int n) const {
    if (n < 1024) return n;
    if (n < 4608) return n + 64;
    if (n < 4672) { const int j = n - 4608; return 1024 + (j & 1) * 32 + (j >> 1); }
    if (n < 4684) return n;
    return -1; } };
struct MapUp { __device__ __forceinline__ int operator()(int n) const {
    if (n >= 1152) return -1;
    const int hd = n / 192, w = n - hd * 192; if (w < 128) return n;
    const int j = w - 128; return hd * 192 + 128 + (j & 1) * 32 + (j >> 1); } };

constexpr int CI_W1 = (DM / 64) * (NFF / 64), CI_W2 = (FF / 64) * (DM / 64), CI_WM = (DM / 64) * (NMIX / 64), CI_UQ = 8 * 20, CI_UKV = 8 * 24, CI_WO = (DM / 64) * (DM / 64), CI_WC = 64 * 4;
constexpr int CI_LAYER = 2 * CI_W1 + 2 * CI_W2 + CI_WM + CI_UQ + CI_UKV + CI_WO + 2 * CI_WC, CI_TOTAL = DEPTH * CI_LAYER;
struct ConvItem { const float* src; const float* gain; bf16_t* dst; int Nlog, K, lc; };
__device__ __forceinline__ void conv_decode(int it, const Args& args, unsigned char* ws, int lane, ConvItem& c) {
    const int l = it / CI_LAYER; int r = it - l * CI_LAYER; unsigned char* lw = ws + WS_W + (size_t)l * LW_SIZE;
    const float* W; const float* gain = nullptr; bf16_t* WT; int Nlog, K, nblk, mapid;
    if (r < CI_W1) { W = args.in[2] + (size_t)l * DM * NFF; gain = args.in[1] + l * DM; WT = (bf16_t*)(lw + LW_W1A); Nlog = NFF; K = DM; nblk = NFF / 64; mapid = 1; }
    else if ((r -= CI_W1) < CI_W2) { W = args.in[3] + (size_t)l * FF * DM; WT = (bf16_t*)(lw + LW_W2A); Nlog = DM; K = FF; nblk = DM / 64; mapid = 0; }
    else if ((r -= CI_W2) < CI_W1) { W = args.in[17] + (size_t)l * DM * NFF; gain = args.in[16] + l * DM; WT = (bf16_t*)(lw + LW_W1B); Nlog = NFF; K = DM; nblk = NFF / 64; mapid = 1; }
    else if ((r -= CI_W1) < CI_W2) { W = args.in[18] + (size_t)l * FF * DM; WT = (bf16_t*)(lw + LW_W2B); Nlog = DM; K = FF; nblk = DM / 64; mapid = 0; }
    else if ((r -= CI_W2) < CI_WM) { W = args.in[5] + (size_t)l * DM * NMIX_LOG; gain = args.in[4] + l * DM; WT = (bf16_t*)(lw + LW_WM); Nlog = NMIX_LOG; K = DM; nblk = NMIX / 64; mapid = 2; }
    else if ((r -= CI_WM) < CI_UQ) { W = args.in[7] + (size_t)l * 512 * 1152; gain = args.in[6] + l * 512; WT = (bf16_t*)(lw + LW_WU); Nlog = 1152; K = 512; nblk = 20; mapid = 3; }
    else if ((r -= CI_UQ) < CI_UKV) { W = args.in[9] + (size_t)l * 512 * 1536; gain = args.in[8] + l * 512; WT = (bf16_t*)(lw + LW_WU) + (size_t)1280 * 512; Nlog = 1536; K = 512; nblk = 24; mapid = 0; }
    else if ((r -= CI_UKV) < CI_WO) { W = args.in[15] + (size_t)l * DM * DM; WT = (bf16_t*)(lw + LW_WO); Nlog = DM; K = DM; nblk = DM / 64; mapid = 0; }
    else if ((r -= CI_WO) < CI_WC) { W = args.in[11] + (size_t)l * 4096 * 128; WT = (bf16_t*)(lw + LW_WCK); Nlog = 128; K = 4096; nblk = 4; mapid = 0; }
    else { r -= CI_WC; W = args.in[13] + (size_t)l * 4096 * 128; WT = (bf16_t*)(lw + LW_WCV); Nlog = 128; K = 4096; nblk = 4; mapid = 0; }
    const int kb = r / nblk, nb = r - kb * nblk, k0 = kb * 64, n0 = nb * 64, n = n0 + lane;
    int lc;
    if (mapid == 0) lc = n < Nlog ? n : -1; else if (mapid == 1) lc = MapSwiglu{}(n); else if (mapid == 2) lc = MapMix{}(n); else lc = MapUp{}(n);
    c.src = W + (size_t)k0 * Nlog + (lc >= 0 ? lc : 0); c.gain = gain ? gain + k0 : nullptr; c.dst = WT + (size_t)n0 * K + k0; c.Nlog = Nlog; c.K = K; c.lc = lc;
}
__device__ __forceinline__ void conv_load(const ConvItem& c, float (&v)[64]) {
#pragma unroll
    for (int kk = 0; kk < 64; ++kk) v[kk] = __builtin_nontemporal_load(c.src + (size_t)kk * c.Nlog);
}
__device__ __forceinline__ void conv_store(const ConvItem& c, const float (&v)[64], LAS float* scr, int lane) {
#pragma unroll
    for (int kk = 0; kk < 64; ++kk) { float x = v[kk]; if (c.gain) x *= c.gain[kk]; scr[kk * 65 + lane] = c.lc >= 0 ? x : 0.f; }
    LDS_WAIT();
    const int ch = lane & 7;
#pragma unroll
    for (int j = 0; j < 8; ++j) { const int n = (lane >> 3) + 8 * j; const LAS float* sp = scr + (8 * ch) * 65 + n;
        u32x4 o; o.x = cvt_pk_bf16(sp[0], sp[65]); o.y = cvt_pk_bf16(sp[2 * 65], sp[3 * 65]); o.z = cvt_pk_bf16(sp[4 * 65], sp[5 * 65]); o.w = cvt_pk_bf16(sp[6 * 65], sp[7 * 65]);
        *(u32x4*)(c.dst + (size_t)n * c.K + 8 * ch) = o; }
    LDS_WAIT();
}

__device__ __forceinline__ void sincos_acc(float angf, float& c, float& s) {
    const double a = (double)angf;
    const double k = __builtin_rint(a * 0.63661977236758134308);
    const double r = (a - k * 1.57079632679489655800) - k * 6.12323399573676603587e-17;
    const double r2 = r * r;
    double sp = -2.50521083854417187751e-08; sp = sp * r2 + 2.75573192239858906526e-06; sp = sp * r2 - 1.98412698412698412698e-04; sp = sp * r2 + 8.33333333333333333333e-03; sp = sp * r2 - 1.66666666666666666667e-01;
    const double sr = r + r * r2 * sp + r * r2 * r2 * r2 * r2 * r2 * r2 * 1.60590438368216145994e-10;
    double cp = 2.08767569878680989792e-09; cp = cp * r2 - 2.75573192239858906526e-07; cp = cp * r2 + 2.48015873015873015873e-05; cp = cp * r2 - 1.38888888888888888889e-03; cp = cp * r2 + 4.16666666666666666667e-02; cp = cp * r2 - 0.5;
    const double cr = 1.0 + r2 * cp;
    const int q = ((int)(long long)k) & 3;
    const double sv = (q == 0) ? sr : (q == 1) ? cr : (q == 2) ? -sr : -cr;
    const double cv = (q == 0) ? cr : (q == 1) ? -sr : (q == 2) ? -cr : sr;
    c = (float)cv; s = (float)sv;
}

__global__ void __launch_bounds__(512, 2) fwd_kernel(Args args) {
    extern __shared__ __attribute__((aligned(16))) unsigned char lds_raw[];
    LAS unsigned char* lds = (LAS unsigned char*)lds_raw;
    volatile LAS unsigned* MISC = (volatile LAS unsigned*)(lds + MISC_OFF);
    for (int u = threadIdx.x; u < (LDS_BYTES - LDSCTL_OFF) / 4; u += 512) ((LAS unsigned*)(lds + LDSCTL_OFF))[u] = 0u;
    __syncthreads();
    XcdBarrier bar = xcd_barrier_post((unsigned*)(args.ws + WS_CTL) + CW_BAR, MISC + 8);
    {   unsigned bq_ = blockIdx.x; asm volatile("" : "+s"(bq_)); const unsigned mmv_ = __builtin_amdgcn_readfirstlane(bar.x != (bq_ & 7u) ? 1u : 0u);
        if (mmv_ != 0u && threadIdx.x == 0) (void)xb_add(&bar.bar[XL_MM], 1u); }
    const int G = gridDim.x;
    const int wave_s = __builtin_amdgcn_readfirstlane(threadIdx.x >> 6);
#define TID_NOW(var) int var; { int z_ = 0; asm volatile("" : "+s"(z_)); var = wave_s * 64 + (int)__builtin_amdgcn_mbcnt_hi(~0u, __builtin_amdgcn_mbcnt_lo(~0u, (unsigned)z_)); }
#define GRID_BARRIER() do { TID_NOW(tb_); xcd_barrier(bar, tb_); } while (0)
#define LOC_OK() ({ int zq_ = 0; asm volatile("" : "+s"(zq_)); __builtin_amdgcn_readfirstlane(MISC[10 + zq_]); })
#define SEAM_LOCAL() do { TID_NOW(tb_); if (LOC_OK()) xcd_local_barrier(bar, tb_); else xcd_barrier(bar, tb_); } while (0)
#define PHASE_BEGIN() TID_NOW(tid); int bid = blockIdx.x; asm volatile("" : "+s"(bid)); unsigned char* ws = args.ws; asm volatile("" : "+s"(ws)); \
    const int lane = tid & 63, wave = __builtin_amdgcn_readfirstlane(tid >> 6); const int gw = bid * 8 + wave, ngw = G * 8; (void)lane; (void)wave; (void)gw; (void)ngw; \
    float* X = args.out; bf16_t* XB = (bf16_t*)(ws + WS_XB); float* SS = (float*)(ws + WS_SS); (void)X; (void)XB; (void)SS;
#define MIXBUFS() pg8::MixBufs MB; { unsigned char* ov = ws + WS_BIG; MB.LAT = (bf16_t*)(ov + OV_LAT); MB.LATSS = (float*)(ov + OV_LATSS); MB.DQ = (bf16_t*)(ov + OV_DQ); MB.DK = (bf16_t*)(ov + OV_DK); MB.DV = (bf16_t*)(ov + OV_DV); \
      MB.NQ = (bf16_t*)(ov + OV_NQ); MB.NKV = (bf16_t*)(ov + OV_NKV); MB.GATES = (float*)(ov + OV_GATES) + (size_t)l * M * 16; MB.MK = (bf16_t*)(ov + OV_MK); MB.ROPE = (const float*)(ws + WS_ROPE); } \
    bf16_t* MQ = (bf16_t*)(ws + WS_BIG + OV_MQ); bf16_t* MV = (bf16_t*)(ws + WS_BIG + OV_MV); (void)MQ; (void)MV;


    {
        PHASE_BEGIN();
        LAS float* scr = (LAS float*)(lds + wave * 16640);
        {
        {
            float va[64], vb[64]; ConvItem ca, cb; int it = gw;
            if (it < CI_TOTAL) { conv_decode(it, args, ws, lane, ca); conv_load(ca, va); }
            while (it < CI_TOTAL) {
                const int it1 = it + ngw;
                if (it1 < CI_TOTAL) { conv_decode(it1, args, ws, lane, cb); conv_load(cb, vb); }
                conv_store(ca, va, scr, lane);
                if (it1 >= CI_TOTAL) break;
                const int it2 = it1 + ngw;
                if (it2 < CI_TOTAL) { conv_decode(it2, args, ws, lane, ca); conv_load(ca, va); }
                conv_store(cb, vb, scr, lane);
                it = it2;
            }
        }
        {
            const float INVF[32] = {0x1.0000000000000p+0f, 0x1.7ff2240000000p-1f, 0x1.1feb340000000p-1f, 0x1.afd1360000000p-2f, 0x1.43d1360000000p-2f, 0x1.e5a8480000000p-3f, 0x1.6c310e0000000p-3f, 0x1.111aec0000000p-3f,
                0x1.99999a0000000p-4f, 0x1.33281a0000000p-4f, 0x1.ccab860000000p-5f, 0x1.59742c0000000p-5f, 0x1.030dc40000000p-5f, 0x1.8486a00000000p-6f, 0x1.235a720000000p-6f, 0x1.b4f7e40000000p-7f,
                0x1.47ae140000000p-7f, 0x1.eb735e0000000p-8f, 0x1.7089380000000p-8f, 0x1.145cee0000000p-8f, 0x1.9e7c6e0000000p-9f, 0x1.36d2180000000p-9f, 0x1.d22a500000000p-10f, 0x1.5d931c0000000p-10f,
                0x1.0624de0000000p-10f, 0x1.89291a0000000p-11f, 0x1.26d42c0000000p-11f, 0x1.ba2e4c0000000p-12f, 0x1.4b96be0000000p-12f, 0x1.f150280000000p-13f, 0x1.74eea60000000p-13f, 0x1.17a8e40000000p-13f};
            float* rope = (float*)(ws + WS_ROPE);
            for (int e = bid * 512 + tid; e < SEQ * 32; e += G * 512) { const int pos = e >> 5, i = e & 31; float fi = INVF[0];
#pragma unroll
                for (int q = 1; q < 32; ++q) fi = (i == q) ? INVF[q] : fi;
                const float ang = (float)pos * fi; float c, sn; sincos_acc(ang, c, sn); rope[2 * e] = c; rope[2 * e + 1] = sn; }
        }
        {
            float* cb = (float*)(ws + WS_CB);
            for (int o = gw; o < DEPTH * 2 * 128; o += ngw) { const int l = o >> 8, kv = (o >> 7) & 1, n = o & 127;
                const float* pe = args.in[10] + (size_t)l * 4096; const float* w1 = (kv ? args.in[13] : args.in[11]) + (size_t)l * 4096 * 128 + n; float a = 0.f;
                for (int r = lane; r < 4096; r += 64) a += pe[r] * w1[(size_t)r * 128];
#pragma unroll
                for (int of = 1; of < 64; of <<= 1) a += shx(a, of, lane);
                if (lane == 0) cb[o] = a; }
        }
        const float* x0 = args.in[0];
        for (int row = gw; row < M; row += ngw) {
            const f32x4* xr = (const f32x4*)(x0 + (size_t)row * DM) + lane; u32x2* xb = (u32x2*)(XB + (size_t)row * DM) + lane;
            float s = 0.f;
#pragma unroll
            for (int j = 0; j < 8; ++j) { const f32x4 v = xr[64 * j]; u32x2 w; w.x = cvt_pk_bf16(v[0], v[1]); w.y = cvt_pk_bf16(v[2], v[3]); xb[64 * j] = w; s += (v[0] * v[0] + v[1] * v[1]) + (v[2] * v[2] + v[3] * v[3]); }
#pragma unroll
            for (int o = 1; o < 64; o <<= 1) s += shx(s, o, lane);
            if (lane < 32) SS[(size_t)row * 32 + lane] = lane == 0 ? s : 0.f;
        }
        }
    }
    GRID_BARRIER();
    {   TID_NOW(t0_); if (t0_ == 0) { unsigned* bb_ = bar.bar; MISC[10] = (xb_ld(&bb_[XL_MM]) == 0u && MISC[8] * 8u == (unsigned)G && MISC[9] == 8u) ? 1u : 0u; }
        __syncthreads(); }

    for (int j = 0; j < 2 * DEPTH; ++j) {
        const int l = j >> 1, which = j & 1;
        {
            PHASE_BEGIN(); unsigned char* lw = ws + WS_W + (size_t)l * LW_SIZE;
            const bool lok = LOC_OK() != 0u; unsigned* cc = (unsigned*)(ws + WS_CTL) + CW_CHAIN;
            pg8::Gemm g{XB, (const bf16_t*)(lw + (which ? LW_W1B : LW_W1A)), M, NFF, DM, DM}; pg8::ChainOrder S; S.init(M, NFF, G, (lok && !which) ? ((bid + 128) & 255) : bid);
            S.need_cnt = (lok && j > 0) ? cc + (which ? 3 * (j - 1) + 2 : 3 * (j - 1) + 1) * 2048 : nullptr; S.need = 64u; S.done_cnt = lok ? cc + (3 * j) * 2048 : nullptr; S.tmo = (unsigned*)(ws + WS_CTL) + CW_BAR + XB_TMO;
            LAS float* rc = (LAS float*)(lds + pg8::RC_OFF + wave * pg8::RC_WAVE); if (lane == 0) ((LAS int*)rc)[128] = -1;
            pg8::EpiSwiGLU E{(bf16_t*)(ws + WS_HID), SS, rc};
            pg8::gemm_phase<pg8::EpiSwiGLU, pg8::ChainOrder, true>(lds, g, S, E, tid);
        }
        if (!LOC_OK()) GRID_BARRIER();
        {
            PHASE_BEGIN(); unsigned char* lw = ws + WS_W + (size_t)l * LW_SIZE;
            const bool lok = LOC_OK() != 0u; unsigned* cc = (unsigned*)(ws + WS_CTL) + CW_CHAIN;
            pg8::Gemm g{(const bf16_t*)(ws + WS_HID), (const bf16_t*)(lw + (which ? LW_W2B : LW_W2A)), M, DM, FF, FF}; pg8::ChainOrder S; S.init(M, DM, G, bid);
            S.need_cnt = lok ? cc + (3 * j) * 2048 : nullptr; S.need = (unsigned)(NFF / 256) * 8u; S.done_cnt = lok ? cc + (3 * j + 1) * 2048 : nullptr; S.tmo = (unsigned*)(ws + WS_CTL) + CW_BAR + XB_TMO;
            pg8::EpiResid E{j == 0 ? args.in[0] : nullptr, j + 1 == 2 * DEPTH ? X : nullptr, XB, SS, 0.5f};
            pg8::gemm_phase<pg8::EpiResid, pg8::ChainOrder, true>(lds, g, S, E, tid);
        }
        if (which) { if (j + 1 == 2 * DEPTH || !LOC_OK()) SEAM_LOCAL(); continue; }
        GRID_BARRIER();
        {
            PHASE_BEGIN(); MIXBUFS(); unsigned char* lw = ws + WS_W + (size_t)l * LW_SIZE;
            pg8::Gemm g{XB, (const bf16_t*)(lw + LW_WM), M, NMIX, DM, DM}; pg8::StaticOrder S; S.init(M, NMIX, G, bid);
            LAS float* rc = (LAS float*)(lds + pg8::RC_OFF + wave * pg8::RC_WAVE); if (lane == 0) ((LAS int*)rc)[128] = -1;
            pg8::EpiMixIn E{MB, SS, rc};
            pg8::gemm_phase<pg8::EpiMixIn, pg8::StaticOrder, true>(lds, g, S, E, tid);
        }
        GRID_BARRIER();
        {
            PHASE_BEGIN(); MIXBUFS(); unsigned char* lw = ws + WS_W + (size_t)l * LW_SIZE; const int c_ = bid;
            if (c_ >= 16) {
                pg8::Gemm g{MB.LAT, (const bf16_t*)(lw + LW_WU), M, NUP, 512, LATW}; pg8::StaticOrder S; S.init(M, NUP, G - 16, c_ - 16); S.acol_pn = 5; S.acol_off = 512;
                pg8::EpiUp E{MQ, MB.MK, MV, MB.LATSS, MB.ROPE};
                pg8::gemm_phase<pg8::EpiUp, pg8::StaticOrder, true>(lds, g, S, E, tid);
            } else {
                const int kv = c_ >> 3;
                const bf16_t* Ain = MB.NKV + (size_t)kv * ((size_t)M * 128);
                bf16_t* H1 = (bf16_t*)(ws + WS_H1) + ((size_t)l * 2 + kv) * 2048 * 128;
                pg8::Gemm g{Ain, (const bf16_t*)(lw + (kv ? LW_WCV : LW_WCK)), 2048, 256, 4096, 2048}; pg8::StaticOrder S; S.init(2048, 256, 8, c_ & 7);
                pg8::EpiCmp E{H1, (const float*)(ws + WS_CB) + (l * 2 + kv) * 128};
                pg8::gemm_phase<pg8::EpiCmp, pg8::StaticOrder, true>(lds, g, S, E, tid);
                VM_WAIT(); __syncthreads();
                const float* w2 = (kv ? args.in[14] : args.in[12]) + (size_t)l * 128 * 128;
                LAS bf16_t* w2t = (LAS bf16_t*)lds;
                for (int e = tid; e < 128 * 128; e += 512) { const int k = e >> 7, n = e & 127; const float wv = w2[e]; const unsigned hb = cvt_pk_bf16(wv, 0.f) & 0xffffu;
                    w2t[n * 136 + k] = (bf16_t)hb; w2t[128 * 136 + n * 136 + k] = (bf16_t)(cvt_pk_bf16(wv - __uint_as_float(hb << 16), 0.f) & 0xffffu); }
                __syncthreads();
                {
                    bf16_t* KC = (bf16_t*)(ws + WS_KC) + ((size_t)l * 2 + kv) * 2048 * 128;
                    const int r32 = lane & 31, hi = lane >> 5, rowb = (c_ & 7) * 256 + wave * 32;
                    bf16x8 af[8];
#pragma unroll
                    for (int ks = 0; ks < 8; ++ks) af[ks] = *(const bf16x8*)(H1 + (size_t)(rowb + r32) * 128 + ks * 16 + hi * 8);
#pragma unroll
                    for (int nb = 0; nb < 4; ++nb) { f32x16 acc = {};
#pragma unroll
                        for (int ks = 0; ks < 8; ++ks) { const bf16x8 bfr = *(const LAS bf16x8*)(w2t + (nb * 32 + r32) * 136 + ks * 16 + hi * 8);
                            const bf16x8 bfl = *(const LAS bf16x8*)(w2t + 128 * 136 + (nb * 32 + r32) * 136 + ks * 16 + hi * 8);
                            acc = __builtin_amdgcn_mfma_f32_32x32x16_bf16(af[ks], bfr, acc, 0, 0, 0); acc = __builtin_amdgcn_mfma_f32_32x32x16_bf16(af[ks], bfl, acc, 0, 0, 0); }
#pragma unroll
                        for (int r = 0; r < 16; ++r) KC[(size_t)(rowb + att::crow(r, hi)) * 128 + nb * 32 + r32] = (bf16_t)(cvt_pk_bf16(acc[r], 0.f) & 0xffffu); }
                }
                __syncthreads();
            }
            {
            gu32* qctr = (gu32*)(ws + WS_CTL) + CW_QUEUE + (l * 2 + 0) * 64;
            for (;;) {
                TID_NOW(tq);
                if (tq == 0) MISC[0] = __hip_atomic_fetch_add(qctr, 1u, __ATOMIC_RELAXED, __HIP_MEMORY_SCOPE_AGENT);
                __syncthreads();
                const int u = (int)MISC[0];
                __syncthreads();
                if (u >= 768) break;
                const int g = u >> 8, v = u & 255, dsh = 2 * g, d = 1 << dsh, nlb = 64 >> dsh;
                const int lb = v % nlb, w = v / nlb, r = w & (d - 1), bs = w >> dsh, sl = bs & 1, b = bs >> 1, head = 2 * g + sl;
                const size_t tokb = (size_t)b * SEQ + r;
                att::PolDil p; p.Q = MB.DQ + (tokb + (size_t)lb * 256 * d) * 768 + head * 128; p.q_pitch = 768 * d;
                p.K = MB.DK + tokb * 768 + head * 128; p.k_pitch = 768 * d; p.V = MB.DV + tokb * 768 + head * 128; p.v_pitch = 768 * d;
                p.P0 = lb * 256; p.W = 129; p.j0 = lb == 0 ? 0 : 4 * lb - 2; p.nt = 4 * lb + 4 - p.j0; p.mfix = 0.f;
                p.sl2 = att::alibi_slope(head + 1) * (float)d * 1.4426950408889634f;
                p.O = (bf16_t*)(ws + WS_OCAT) + (tokb + (size_t)lb * 256 * d) * DM + 768 + head * 128; p.o_pitch = DM * d;
                p.LSE = (float*)(ws + WS_DLSE) + (size_t)l * M * 8 + (tokb + (size_t)lb * 256 * d) * 8 + head; p.lse_pitch = 8 * d;
                float m_, l_; att::attn_block(p, lds, tq, m_, l_);
            }
            }
        }
        GRID_BARRIER();
        {
            PHASE_BEGIN(); MIXBUFS();
            att::NsaBufs nb; nb.NQ = MB.NQ; nb.NKV = MB.NKV; nb.KC = (const bf16_t*)(ws + WS_KC) + (size_t)l * 2 * 2048 * 128; nb.VC = nb.KC + 2048 * 128; nb.GATES = MB.GATES; nb.NSAF = (float*)(ws + WS_NSAF); nb.OCAT = (bf16_t*)(ws + WS_OCAT);
            {
            gu32* qctr = (gu32*)(ws + WS_CTL) + CW_QUEUE + (l * 2 + 1) * 64;
            const int ntot = 552 + 512 + 216 + 128;
            for (;;) {
                TID_NOW(tq); const int lane_q = tq & 63, wave_q = tq >> 6;
                if (tq == 0) MISC[0] = __hip_atomic_fetch_add(qctr, 1u, __ATOMIC_RELAXED, __HIP_MEMORY_SCOPE_AGENT);
                __syncthreads();
                int u = (int)MISC[0];
                __syncthreads();
                if (u >= ntot) break;
                int mla = -1;
                if (u < 552) mla = u; else if (u < 552 + 512) { const int n = u - 552; att::nsa_unit(nb, n >> 8, (n & 255) * 64, lds, tq); }
                else if (u < 552 + 512 + 216) mla = u - 512;
                else {
                    const int tb = (u - (552 + 512 + 216)) * 256; const float* dl = (const float*)(ws + WS_DLSE) + (size_t)l * M * 8; bf16_t* oc = (bf16_t*)(ws + WS_OCAT);
                    for (int k = wave_q; k < 256; k += 8) { const size_t tok = (size_t)tb + k; const float* lp = dl + tok * 8;
                        for (int ch = lane_q; ch < 96; ch += 64) { const int head = ch >> 4, slot = head & 1;
                            const float a0 = lp[slot], a1 = lp[2 + slot], a2 = lp[4 + slot], mx = fmaxf(a0, fmaxf(a1, a2));
                            const float e0 = __expf(a0 - mx), e1 = __expf(a1 - mx), e2 = __expf(a2 - mx), mine = head < 2 ? e0 : (head < 4 ? e1 : e2), al = mine / (e0 + e1 + e2);
                            u32x4* pp = (u32x4*)(oc + tok * DM + 768 + ch * 8); u32x4 w = *pp; unsigned* wp = (unsigned*)&w;
#pragma unroll
                            for (int e = 0; e < 4; ++e) { const float lo = __uint_as_float(wp[e] << 16) * al, hi_ = __uint_as_float(wp[e] & 0xffff0000u) * al; wp[e] = cvt_pk_bf16(lo, hi_); }
                            *pp = w; } }
                }
                if (mla >= 0) {
                    const int qb = 63 - mla / 12, bh = mla % 12, b = bh / 6, h = bh - b * 6;
                    att::PolMLA p; p.Q = MQ + ((size_t)b * SEQ + (size_t)qb * 256) * 1152 + h * 192; p.q_pitch = 1152;
                    p.K = MB.MK + (size_t)b * SEQ * 1152 + h * 192; p.k_pitch = 1152; p.V = MV + (size_t)b * SEQ * 768 + h * 128; p.v_pitch = 768;
                    p.nt = 4 * (qb + 1); p.j0 = 0; p.P0 = qb * 256; p.W = 0x40000000; p.mfix = 0.f;
                    p.O = (bf16_t*)(ws + WS_OCAT) + ((size_t)b * SEQ + (size_t)qb * 256) * DM + h * 128; p.o_pitch = DM;
                    float m_, l_; att::attn_block(p, lds, tq, m_, l_);
                }
            }
            }
        }
        GRID_BARRIER();
        {
            PHASE_BEGIN(); unsigned char* lw = ws + WS_W + (size_t)l * LW_SIZE;
            const bool lok = LOC_OK() != 0u; unsigned* cc = (unsigned*)(ws + WS_CTL) + CW_CHAIN;
            pg8::Gemm g{(const bf16_t*)(ws + WS_OCAT), (const bf16_t*)(lw + LW_WO), M, DM, DM, DM}; pg8::ChainOrder S; S.init(M, DM, G, bid);
            S.need_cnt = nullptr; S.need = 0u; S.done_cnt = lok ? cc + (3 * j + 2) * 2048 : nullptr; S.tmo = (unsigned*)(ws + WS_CTL) + CW_BAR + XB_TMO;
            pg8::EpiResid E{nullptr, nullptr, XB, SS, 1.0f};
            pg8::gemm_phase<pg8::EpiResid, pg8::ChainOrder, true>(lds, g, S, E, tid);
        }
        if (!LOC_OK()) GRID_BARRIER();
    }

    {
        PHASE_BEGIN();
        const float* gfin = args.in[19];
        const int rpx = M / 8, rbase = (bid & 7) * rpx;
        for (int row = rbase + (bid >> 3) * 8 + wave; row < rbase + rpx; row += (G >> 3) * 8) {
            float s = SS[(size_t)row * 32 + (lane & 31)];
#pragma unroll
            for (int o = 1; o < 32; o <<= 1) s += shx(s, o, lane);
            const float r = rsqrtf(s * (1.0f / DM) + RMS_EPS);
            f32x4* xo = (f32x4*)(X + (size_t)row * DM) + lane; const f32x4* gp = (const f32x4*)gfin + lane;
#pragma unroll
            for (int jj = 0; jj < 8; ++jj) { const f32x4 v = xo[64 * jj]; xo[64 * jj] = v * r * gp[64 * jj]; }
        }
    }
}

extern "C" void kernel_launch(void* const* d_in, const int* in_sizes, int n_in, void* d_out, int out_size, void* d_ws, size_t ws_size, hipStream_t stream) {
    static int grid = 0;
    if (grid == 0) {
        if (n_in != 20 || out_size != M * DM || ws_size < WS_END_V1) { fprintf(stderr, "kernel_launch: unexpected shapes (n_in %d out %d ws %zu)\n", n_in, out_size, ws_size); grid = -1; return; }
        int dev = 0, cus = 0, per_cu = 0;
        (void)hipGetDevice(&dev); (void)hipDeviceGetAttribute(&cus, hipDeviceAttributeMultiprocessorCount, dev);
        if (hipFuncSetAttribute((const void*)fwd_kernel, hipFuncAttributeMaxDynamicSharedMemorySize, LDS_BYTES) != hipSuccess) { fprintf(stderr, "kernel_launch: hipFuncSetAttribute failed\n"); grid = -1; return; }
        (void)hipOccupancyMaxActiveBlocksPerMultiprocessor(&per_cu, (const void*)fwd_kernel, 512, LDS_BYTES);
        (void)hipGetLastError();
        grid = cus > 0 ? cus : 256;
        fprintf(stderr, "kernel_launch: grid %d (occupancy query %d)\n", grid, per_cu);
    }
    if (grid < 0) return;
    (void)hipMemsetAsync((char*)d_ws + WS_CTL, 0, CTL_ZERO_BYTES, stream);
    Args a{};
    for (int i = 0; i < 20; ++i) a.in[i] = (const float*)d_in[i];
    a.out = (float*)d_out; a.ws = (unsigned char*)d_ws;
    hipLaunchKernelGGL(fwd_kernel, dim3(grid), dim3(512), LDS_BYTES, stream, a);
}
```

```cpp
#include <hip/hip_runtime.h>
#include <cstdio>
#include <cstdint>

#define LAS __attribute__((address_space(3)))
#define GAS __attribute__((address_space(1)))
typedef unsigned short bf16_t;
typedef short bf16x8 __attribute__((ext_vector_type(8)));
typedef short s16x4 __attribute__((ext_vector_type(4)));
typedef float f32x4 __attribute__((ext_vector_type(4)));
typedef float f32x16 __attribute__((ext_vector_type(16)));
typedef float f32x2 __attribute__((ext_vector_type(2)));
typedef unsigned u32x4 __attribute__((ext_vector_type(4)));
typedef unsigned u32x2 __attribute__((ext_vector_type(2)));
typedef GAS unsigned gu32;

constexpr int BATCH = 2, SEQ = 16384, M = BATCH * SEQ, DM = 2048, FF = 5504, NFF = 2 * FF, DEPTH = 4;
constexpr int NMIX = 4864, NMIX_LOG = 4684, NUP = 2816, LATW = 1024;
constexpr float RMS_EPS = 1e-6f;

__device__ __forceinline__ unsigned cvt_pk_bf16(float lo, float hi) { unsigned r; asm volatile("v_cvt_pk_bf16_f32 %0, %1, %2" : "=v"(r) : "v"(lo), "v"(hi)); return r; }
__device__ __forceinline__ float shx(float v, int mask, int lane) { return __int_as_float(__builtin_amdgcn_ds_bpermute((lane ^ mask) << 2, __float_as_int(v))); }
__device__ __forceinline__ unsigned shxu(unsigned v, int mask, int lane) { return (unsigned)__builtin_amdgcn_ds_bpermute((lane ^ mask) << 2, (int)v); }
__device__ __forceinline__ __amdgpu_buffer_rsrc_t mk_rsrc(const void* p) {
    const uintptr_t a = (uintptr_t)p; const unsigned lo = __builtin_amdgcn_readfirstlane((unsigned)a), hi = __builtin_amdgcn_readfirstlane((unsigned)(a >> 32));
    return __builtin_amdgcn_make_buffer_rsrc((void*)(((uintptr_t)hi << 32) | lo), 0, 0x7ffffff0, 0x00020000); }
__device__ __forceinline__ bf16x8 ld_sc1(__amdgpu_buffer_rsrc_t r, int byte_off) { const u32x4 v = __builtin_amdgcn_raw_buffer_load_b128(r, byte_off, 0, 16); return __builtin_bit_cast(bf16x8, v); }
#define LDS_WAIT() asm volatile("s_waitcnt lgkmcnt(0)" ::: "memory")
#define VM_WAIT() asm volatile("s_waitcnt vmcnt(0)" ::: "memory")

namespace pg8 {
constexpr int BM = 256, BK = 64, HALF = 128, HTB = HALF * BK * 2, STAGE_BYTES = 8 * HTB, NXCD = 8, WGM = 8;
__host__ __device__ __forceinline__ int lds_byte(int r, int c) { const int st = (r >> 4) * 2 + (c >> 5), rr = r & 15, cc = c & 31, ob = rr * 64 + cc * 2; return st * 1024 + (ob ^ (((ob >> 9) & 1) << 5)); }
__host__ __device__ __forceinline__ void stage_rc(int b, int& R, int& C) { const int st = b / 1024, sb = b % 1024, swz = sb ^ (((sb >> 9) & 1) << 5); R = (st >> 1) * 16 + swz / 64; C = (st & 1) * 32 + (swz % 64) / 2; }
__host__ __device__ __forceinline__ int perm32(int rho) { const int n = rho >> 4, i = rho & 15; return 8 * (i >> 2) + 4 * n + (i & 3); }
struct Unit { int pm, pn; };
struct Gemm { const bf16_t* A; const bf16_t* Bt; int M, N, K, lda; };
struct StaticOrder {
    int nM, nN, nwg, G, c, acol_pn, acol_off, wgm = 4, rev = 0;
    __device__ void init(int M_, int N_, int G_, int c_) { nM = M_ / BM; nN = N_ / BM; nwg = nM * nN; G = G_; c = c_; acol_pn = 1 << 30; acol_off = 0; }
    __device__ bool next(int i, Unit& u) const {
        if (c < 0) return false;
        if (rev && (long)i * G + c >= nwg) return false;
        const long L = (long)(rev ? (nwg / G - 1 - i) : i) * G + c; if (L >= nwg || L < 0) return false;
        int wgid = (int)L; { const int q = nwg / NXCD, r = nwg % NXCD, xcd = wgid % NXCD, off = wgid / NXCD; wgid = (xcd < r ? xcd * (q + 1) : r * (q + 1) + (xcd - r) * q) + off; }
        const int nig = wgm * nN, gid = wgid / nig, fm = gid * wgm, gsz = (nM - fm) < wgm ? (nM - fm) : wgm;
        u.pm = fm + ((wgid % nig) % gsz); u.pn = (wgid % nig) / gsz; return true;
    }
    __device__ __forceinline__ int acol(const Unit& u) const { return u.pn >= acol_pn ? acol_off : 0; }
};

struct ChainOrder : StaticOrder {
    static constexpr bool CHAIN = true;
    const unsigned* need_cnt; unsigned need; unsigned* done_cnt; unsigned* tmo;
    __device__ __forceinline__ unsigned peek(const Unit& u, bool valid, int wid) const {
        if (need_cnt != nullptr && valid && wid == 0) return __hip_atomic_load(need_cnt + 16 * u.pm, __ATOMIC_RELAXED, __HIP_MEMORY_SCOPE_AGENT);
        return 0u; }
    __device__ __forceinline__ void a_ready(const Unit& u, bool valid, int wid, unsigned first = 0u) const {
        if (need_cnt != nullptr && valid) {
            if (wid == 0) {
                const unsigned* p = need_cnt + 16 * u.pm; unsigned sp = 0u;
                if ((unsigned)__builtin_amdgcn_readfirstlane(first) < need)
                while ((unsigned)__builtin_amdgcn_readfirstlane(__hip_atomic_load(p, __ATOMIC_RELAXED, __HIP_MEMORY_SCOPE_AGENT)) < need) {
                    __builtin_amdgcn_s_sleep(2);
                    if ((++sp & 255u) == 0u) { if (__builtin_amdgcn_readfirstlane(__hip_atomic_load(tmo, __ATOMIC_RELAXED, __HIP_MEMORY_SCOPE_AGENT)) != 0u) break;
                        if (sp > (1u << 18)) { __hip_atomic_store(tmo, 1u, __ATOMIC_RELAXED, __HIP_MEMORY_SCOPE_AGENT); break; } } }
                asm volatile("buffer_inv sc0\n\ts_waitcnt vmcnt(0)" ::: "memory");
            }
            asm volatile("" ::: "memory"); __builtin_amdgcn_s_barrier(); asm volatile("" ::: "memory");
        }
    }
    __device__ __forceinline__ void done(const Unit& u, int lane) const {
        if (done_cnt != nullptr) { asm volatile("s_waitcnt vmcnt(0)" ::: "memory");
            if (lane == 0) (void)__hip_atomic_fetch_add(done_cnt + 16 * u.pm, 1u, __ATOMIC_RELAXED, __HIP_MEMORY_SCOPE_AGENT); }
    }
};
template <class T> struct is_chain { static constexpr bool v = false; };
template <> struct is_chain<ChainOrder> { static constexpr bool v = true; };
template <class Epi, class Sched, bool ALIGN_EPI>
__device__ __forceinline__ void gemm_phase(LAS unsigned char* lds, const Gemm g, const Sched& S, const Epi& E, const int tid) {
    const int wid = __builtin_amdgcn_readfirstlane(tid >> 6), lane = tid & 63, wr = wid >> 2, wc = wid & 3, fr = lane & 15, fq = lane >> 4;
    const int K = g.K, nt = K / BK, lda = g.lda;
    unsigned voffA[2], voffB[2];
#pragma unroll
    for (int i = 0; i < 2; ++i) { int R, C; stage_rc(tid * 16 + i * 8192, R, C); const int Rb = Epi::PERM ? ((R & ~31) + perm32(R & 31)) : R;
        voffA[i] = (unsigned)(R * lda + C) * 2u; voffB[i] = (unsigned)(Rb * K + C) * 2u; }
    const size_t kstep = (size_t)(BK * 2);
    const size_t hsA = (size_t)HALF * lda * 2, hsB = (size_t)HALF * K * 2;
    const size_t tsA = 2 * hsA, tsB = 2 * hsB;
    const unsigned ldsw = (unsigned)wid * 1024u;
    const int aoff = lds_byte(wr * 64 + fr, fq * 8), boff = lds_byte(wc * 32 + fr, fq * 8);
#define PG8_SA(b, h) (((b) * 2 + (h)) * HTB)
#define PG8_SB(b, h) ((4 + (b) * 2 + (h)) * HTB)
#define PG8_STAGE(bufoff, gbase, voff) do { _Pragma("unroll") for (int _i = 0; _i < 2; ++_i) \
        __builtin_amdgcn_global_load_lds((const unsigned*)((const char*)(gbase) + (voff)[_i]), (LAS unsigned*)(lds + (bufoff) + ldsw + _i * 8192), 16, 0, 0); } while (0)
#define PG8_LDA(dst, b, h) do { _Pragma("unroll") for (int m = 0; m < 4; ++m) _Pragma("unroll") for (int k = 0; k < 2; ++k) dst[m][k] = *(const LAS bf16x8*)(lds + PG8_SA(b, h) + aoff + m * 2048 + k * 1024); } while (0)
#define PG8_LDB(dst, b, h) do { _Pragma("unroll") for (int n = 0; n < 2; ++n) _Pragma("unroll") for (int k = 0; k < 2; ++k) dst[n][k] = *(const LAS bf16x8*)(lds + PG8_SB(b, h) + boff + n * 2048 + k * 1024); } while (0)
#define PG8_MMA(ai, bj, At, Bt) do { __builtin_amdgcn_s_setprio(1); _Pragma("unroll") for (int m = 0; m < 4; ++m) _Pragma("unroll") for (int n = 0; n < 2; ++n) _Pragma("unroll") for (int k = 0; k < 2; ++k) \
        acc[ai][bj][m][n] = __builtin_amdgcn_mfma_f32_16x16x32_bf16(Bt[n][k], At[m][k], acc[ai][bj][m][n], 0, 0, 0); __builtin_amdgcn_s_setprio(0); } while (0)
#define PG8_WAIT_V(n) asm volatile("s_waitcnt vmcnt(" #n ")" ::: "memory")
#define PG8_WAIT_L(n) asm volatile("s_waitcnt lgkmcnt(" #n ")" ::: "memory")
#define PG8_BAR __builtin_amdgcn_s_barrier()
#define PG8_SCHED __builtin_amdgcn_sched_barrier(0)
    Unit cur, nxt; int ui = 0;
    if (!S.next(0, cur)) return;
    if constexpr (is_chain<Sched>::v) { S.a_ready(cur, true, wid); Unit u1_; const bool h1_ = S.next(1, u1_); S.a_ready(u1_, h1_, wid); }
    f32x4 acc[2][2][4][2];
#pragma unroll
    for (int a = 0; a < 2; ++a)
#pragma unroll
        for (int b = 0; b < 2; ++b)
#pragma unroll
            for (int m = 0; m < 4; ++m)
#pragma unroll
                for (int n = 0; n < 2; ++n) acc[a][b][m][n] = (f32x4){0.f, 0.f, 0.f, 0.f};
    bf16x8 At[4][2], B0[2][2], B1[2][2];
    const char* cA = (const char*)g.A + (size_t)cur.pm * tsA + (size_t)S.acol(cur) * 2; const char* cB = (const char*)g.Bt + (size_t)cur.pn * tsB;
    PG8_STAGE(PG8_SB(0, 0), cB, voffB); PG8_STAGE(PG8_SB(0, 1), cB + hsB, voffB); PG8_STAGE(PG8_SA(0, 0), cA, voffA); PG8_STAGE(PG8_SA(0, 1), cA + hsA, voffA);
    if (wr == 1) PG8_BAR;
    PG8_WAIT_V(2); PG8_BAR;
    PG8_STAGE(PG8_SB(1, 0), cB + kstep, voffB); PG8_STAGE(PG8_SA(1, 0), cA + kstep, voffA); PG8_STAGE(PG8_SB(1, 1), cB + hsB + kstep, voffB);
    PG8_WAIT_V(6); PG8_BAR;
    for (;;) {
        const bool has_next = S.next(ui + 1, nxt);
        const char* nA = has_next ? (const char*)g.A + (size_t)nxt.pm * tsA + (size_t)S.acol(nxt) * 2 : cA; const char* nB = has_next ? (const char*)g.Bt + (size_t)nxt.pn * tsB : cB;
        for (int t = 0; t < nt; t += 2) {
            const bool last = (t == nt - 2);
            const char* a1 = cA + (size_t)(t + 1) * kstep;
            const char* a2 = last ? nA : cA + (size_t)(t + 2) * kstep; const char* b2 = last ? nB : cB + (size_t)(t + 2) * kstep;
            const char* a3 = a2 + kstep; const char* b3 = b2 + kstep;
            PG8_LDB(B0, 0, 0); PG8_LDB(B1, 0, 1); PG8_SCHED; PG8_LDA(At, 0, 0); PG8_STAGE(PG8_SA(1, 1), a1 + hsA, voffA);
            PG8_WAIT_V(8); PG8_WAIT_L(0); PG8_BAR; PG8_MMA(0, 0, At, B0); PG8_MMA(0, 1, At, B1); PG8_BAR; PG8_SCHED;
            PG8_LDA(At, 0, 1); PG8_STAGE(PG8_SB(0, 0), b2, voffB); PG8_STAGE(PG8_SB(0, 1), b2 + hsB, voffB); PG8_STAGE(PG8_SA(0, 0), a2, voffA);
            PG8_WAIT_V(8); PG8_WAIT_L(0); PG8_BAR; PG8_MMA(1, 0, At, B0); PG8_MMA(1, 1, At, B1); PG8_BAR; PG8_SCHED;
            PG8_LDB(B0, 1, 0); PG8_LDB(B1, 1, 1); PG8_SCHED; PG8_LDA(At, 1, 0); PG8_STAGE(PG8_SA(0, 1), a2 + hsA, voffA);
            PG8_WAIT_V(8); PG8_WAIT_L(0); PG8_BAR; PG8_MMA(0, 0, At, B0); PG8_MMA(0, 1, At, B1); PG8_BAR; PG8_SCHED;
            PG8_LDA(At, 1, 1); PG8_STAGE(PG8_SB(1, 0), b3, voffB); PG8_STAGE(PG8_SB(1, 1), b3 + hsB, voffB); PG8_STAGE(PG8_SA(1, 0), a3, voffA);
            PG8_WAIT_V(8); PG8_WAIT_L(0); PG8_BAR; PG8_MMA(1, 0, At, B0); PG8_MMA(1, 1, At, B1); PG8_BAR; PG8_SCHED;
        }
        if constexpr (ALIGN_EPI) { if (wr == 0) PG8_BAR; }
        Unit u2_; bool h2_ = false; unsigned pk_ = 0u;
        if constexpr (is_chain<Sched>::v) { h2_ = has_next && S.next(ui + 2, u2_); pk_ = S.peek(u2_, h2_, wid); }
        E(acc, cur, wr, wc, fr, fq);
        if constexpr (is_chain<Sched>::v) S.done(cur, lane);
        if (!has_next) break;
        if constexpr (is_chain<Sched>::v) S.a_ready(u2_, h2_, wid, pk_);
#pragma unroll
        for (int a = 0; a < 2; ++a)
#pragma unroll
            for (int b = 0; b < 2; ++b)
#pragma unroll
                for (int m = 0; m < 4; ++m)
#pragma unroll
                    for (int n = 0; n < 2; ++n) acc[a][b][m][n] = (f32x4){0.f, 0.f, 0.f, 0.f};
        cur = nxt; cA = nA; cB = nB; ++ui;
        if constexpr (ALIGN_EPI) { if (wr == 1) PG8_BAR; }
    }
    PG8_WAIT_V(0);
    if constexpr (!ALIGN_EPI) { if (wr == 0) PG8_BAR; }
    PG8_BAR;
#undef PG8_SA
#undef PG8_SB
#undef PG8_STAGE
#undef PG8_LDA
#undef PG8_LDB
#undef PG8_MMA
#undef PG8_WAIT_V
#undef PG8_WAIT_L
#undef PG8_BAR
#undef PG8_SCHED
}

template <int NS>
__device__ __forceinline__ void load_rstd8(const float* SS, int row0, int fq, int lane, float inv_n, float (&rs)[2][4]) {
#pragma unroll
    for (int ai = 0; ai < 2; ++ai)
#pragma unroll
        for (int m = 0; m < 4; ++m) { const float* p = SS + (size_t)(row0 + ai * HALF + m * 16) * NS + fq * (NS / 4); float s = 0.f;
#pragma unroll
            for (int j = 0; j < NS / 4; ++j) s += p[j];
            s += shx(s, 16, lane); s += shx(s, 32, lane); rs[ai][m] = rsqrtf(s * inv_n + RMS_EPS); }
}
constexpr int RC_OFF = 133120, RC_WAVE = 1024;
__device__ __forceinline__ void rstd8_cached(LAS float* rc, const float* SS, int pm, int row0, int fr, int fq, float (&rs)[2][4]) {
    const int tag = __builtin_amdgcn_readfirstlane(((LAS const int*)rc)[128]);
    if (tag == pm) {
#pragma unroll
        for (int ai = 0; ai < 2; ++ai)
#pragma unroll
            for (int m = 0; m < 4; ++m) rs[ai][m] = rc[ai * 64 + m * 16 + fr];
    } else {
        load_rstd8<32>(SS, row0, fq, fq * 16 + fr, 1.0f / DM, rs);
        if (fq == 0) {
#pragma unroll
            for (int ai = 0; ai < 2; ++ai)
#pragma unroll
                for (int m = 0; m < 4; ++m) rc[ai * 64 + m * 16 + fr] = rs[ai][m]; }
        if (fq * 16 + fr == 0) ((LAS int*)rc)[128] = pm;
    }
}
__device__ __forceinline__ float silu_mul(float g, float u) { return g * __builtin_amdgcn_rcpf(1.0f + __builtin_amdgcn_exp2f(-1.4426950408889634f * g)) * u; }

struct EpiSwiGLU {
    static constexpr bool PERM = true;
    bf16_t* H; const float* SS; LAS float* rc;
    __device__ __forceinline__ void operator()(const f32x4 (&acc)[2][2][4][2], const Unit& u, int wr, int wc, int fr, int fq) const {
        const int row0 = u.pm * BM + wr * 64 + fr, col0 = u.pn * HALF + wc * 32 + 8 * fq;
        float rs[2][4]; rstd8_cached(rc, SS, u.pm, row0, fr, fq, rs);
#pragma unroll
        for (int ai = 0; ai < 2; ++ai)
#pragma unroll
            for (int m = 0; m < 4; ++m) { const float r = rs[ai][m]; bf16_t* rowp = H + (size_t)(row0 + ai * HALF + m * 16) * FF + col0;
                const f32x4 g0 = acc[ai][0][m][0] * r, g1 = acc[ai][0][m][1] * r, u0 = acc[ai][1][m][0] * r, u1 = acc[ai][1][m][1] * r;
                u32x4 w; w.x = cvt_pk_bf16(silu_mul(g0[0], u0[0]), silu_mul(g0[1], u0[1])); w.y = cvt_pk_bf16(silu_mul(g0[2], u0[2]), silu_mul(g0[3], u0[3]));
                w.z = cvt_pk_bf16(silu_mul(g1[0], u1[0]), silu_mul(g1[1], u1[1])); w.w = cvt_pk_bf16(silu_mul(g1[2], u1[2]), silu_mul(g1[3], u1[3]));
                *(u32x4*)rowp = w; }
    }
};
struct EpiResid {
    static constexpr bool PERM = false;
    const float* Xin32; float* Xout32; bf16_t* XB; float* SS; float scale;
    __device__ __forceinline__ void operator()(const f32x4 (&acc)[2][2][4][2], const Unit& u, int wr, int wc, int fr, int fq) const {
        const int row0 = u.pm * BM + wr * 64 + fr, col0 = u.pn * BM + wc * 32 + 4 * fq;
#pragma unroll
        for (int ai = 0; ai < 2; ++ai) {
            f32x4 xo[4][2][2];
            if (Xin32 != nullptr) {
#pragma unroll
                for (int m = 0; m < 4; ++m)
#pragma unroll
                    for (int bj = 0; bj < 2; ++bj)
#pragma unroll
                        for (int n = 0; n < 2; ++n) xo[m][bj][n] = *(const f32x4*)(Xin32 + (size_t)(row0 + ai * HALF + m * 16) * DM + col0 + bj * HALF + n * 16);
            } else {
                u32x2 xr[4][2][2];
#pragma unroll
                for (int m = 0; m < 4; ++m)
#pragma unroll
                    for (int bj = 0; bj < 2; ++bj)
#pragma unroll
                        for (int n = 0; n < 2; ++n) xr[m][bj][n] = *(const u32x2*)(XB + (size_t)(row0 + ai * HALF + m * 16) * DM + col0 + bj * HALF + n * 16);
#pragma unroll
                for (int m = 0; m < 4; ++m)
#pragma unroll
                    for (int bj = 0; bj < 2; ++bj)
#pragma unroll
                        for (int n = 0; n < 2; ++n) { const u32x2 w = xr[m][bj][n];
                            xo[m][bj][n] = (f32x4){__uint_as_float(w.x << 16), __uint_as_float(w.x & 0xffff0000u), __uint_as_float(w.y << 16), __uint_as_float(w.y & 0xffff0000u)}; }
            }
            asm volatile("" ::: "memory");
#pragma unroll
            for (int m = 0; m < 4; ++m) { const int row = row0 + ai * HALF + m * 16; const size_t off = (size_t)row * DM + col0; float ss = 0.f;
#pragma unroll
                for (int bj = 0; bj < 2; ++bj)
#pragma unroll
                    for (int n = 0; n < 2; ++n) { const size_t o = off + bj * HALF + n * 16; const f32x4 xn = xo[m][bj][n] + acc[ai][bj][m][n] * scale;
                        if (Xout32 != nullptr) *(f32x4*)(Xout32 + o) = xn;
                        else { u32x2 w; w.x = cvt_pk_bf16(xn[0], xn[1]); w.y = cvt_pk_bf16(xn[2], xn[3]); *(u32x2*)(XB + o) = w; }
                        ss += (xn[0] * xn[0] + xn[1] * xn[1]) + (xn[2] * xn[2] + xn[3] * xn[3]); }
                ss += shx(ss, 16, fq * 16 + fr); ss += shx(ss, 32, fq * 16 + fr);
                if (fq == 0) SS[(size_t)row * 32 + u.pn * 4 + wc] = ss; }
        }
    }
};

constexpr float QSCALE_D = 0.08838834764831845f * 1.4426950408889634f;
constexpr float QSCALE_M = 0.07216878364870322f * 1.4426950408889634f;
template <int NS>
__device__ __forceinline__ void load_rstd8_lat(const float* SS16, int slot0, int row0, int fq, int lane, float inv_n, float (&rs)[2][4]) {
#pragma unroll
    for (int ai = 0; ai < 2; ++ai)
#pragma unroll
        for (int m = 0; m < 4; ++m) { const float* p = SS16 + (size_t)(row0 + ai * HALF + m * 16) * 16 + slot0 + fq * (NS / 4); float s = 0.f;
#pragma unroll
            for (int j = 0; j < NS / 4; ++j) s += p[j];
            s += shx(s, 16, lane); s += shx(s, 32, lane); rs[ai][m] = rsqrtf(s * inv_n + RMS_EPS); }
}
__device__ __forceinline__ u32x4 pack8f(const f32x4 a, const f32x4 b) { u32x4 w; w.x = cvt_pk_bf16(a[0], a[1]); w.y = cvt_pk_bf16(a[2], a[3]); w.z = cvt_pk_bf16(b[0], b[1]); w.w = cvt_pk_bf16(b[2], b[3]); return w; }
__device__ __forceinline__ void rope8(f32x4& a, f32x4& b, const float* cs, int pos, int i0) {
    const f32x4 t0 = *(const f32x4*)(cs + ((size_t)pos * 32 + i0) * 2), t1 = *(const f32x4*)(cs + ((size_t)pos * 32 + i0 + 2) * 2);
    const f32x4 x = a, y = b;
    a[0] = x[0] * t0[0] - x[1] * t0[1]; a[1] = x[1] * t0[0] + x[0] * t0[1]; a[2] = x[2] * t0[2] - x[3] * t0[3]; a[3] = x[3] * t0[2] + x[2] * t0[3];
    b[0] = y[0] * t1[0] - y[1] * t1[1]; b[1] = y[1] * t1[0] + y[0] * t1[1]; b[2] = y[2] * t1[2] - y[3] * t1[3]; b[3] = y[3] * t1[2] + y[2] * t1[3];
}
struct MixBufs { bf16_t *LAT, *DQ, *DK, *DV, *NQ, *NKV  , *MK; float *LATSS, *GATES; const float* ROPE; };
struct EpiMixIn {
    static constexpr bool PERM = true;
    MixBufs B; const float* SS; LAS float* rc;
    __device__ __forceinline__ void operator()(const f32x4 (&acc)[2][2][4][2], const Unit& u, int wr, int wc, int fr, int fq) const {
        const int row0 = u.pm * BM + wr * 64 + fr, cw = wc * 32 + 8 * fq, pn = u.pn;
        float rs[2][4]; rstd8_cached(rc, SS, u.pm, row0, fr, fq, rs);
#pragma unroll
        for (int ai = 0; ai < 2; ++ai)
#pragma unroll
            for (int m = 0; m < 4; ++m) { const float r = rs[ai][m]; const int row = row0 + ai * HALF + m * 16;
                f32x4 v00 = acc[ai][0][m][0] * r, v01 = acc[ai][0][m][1] * r, v10 = acc[ai][1][m][0] * r, v11 = acc[ai][1][m][1] * r;
                if (pn < 4) {
                    bf16_t* p = B.LAT + (size_t)row * LATW + pn * 256 + cw; *(u32x4*)p = pack8f(v00, v01); *(u32x4*)(p + HALF) = pack8f(v10, v11);
                    float ss = 0.f;
#pragma unroll
                    for (int e = 0; e < 4; ++e) ss += v00[e] * v00[e] + v01[e] * v01[e] + v10[e] * v10[e] + v11[e] * v11[e];
                    ss += shx(ss, 16, fq * 16 + fr); ss += shx(ss, 32, fq * 16 + fr);
                    if (fq == 0) B.LATSS[(size_t)row * 16 + pn * 4 + wc] = ss;
                } else if (pn < 13) {
                    const int t = pn - 4, seg = t / 3, c = (t - seg * 3) * 256 + cw; bf16_t* base = B.DQ + (size_t)seg * ((size_t)M * 768);
                    const float sc = seg == 0 ? QSCALE_D : 1.0f;
                    bf16_t* p = base + (size_t)row * 768 + c; *(u32x4*)p = pack8f(v00 * sc, v01 * sc); *(u32x4*)(p + HALF) = pack8f(v10 * sc, v11 * sc);
                } else if (pn < 15) {
                    bf16_t* p = B.NQ + (size_t)row * 512 + (pn - 13) * 256 + cw; *(u32x4*)p = pack8f(v00 * QSCALE_D, v01 * QSCALE_D); *(u32x4*)(p + HALF) = pack8f(v10 * QSCALE_D, v11 * QSCALE_D);
                } else if (pn < 18) {
                    bf16_t* p0 = B.NKV + (size_t)(2 * (pn - 15)) * ((size_t)M * 128) + (size_t)row * 128 + cw; *(u32x4*)p0 = pack8f(v00, v01);
                    *(u32x4*)(p0 + (size_t)M * 128) = pack8f(v10, v11);
                } else {
                    if (wc < 2) { rope8(v00, v01, B.ROPE, row & (SEQ - 1), cw >> 1); const u32x4 w = pack8f(v00, v01);
#pragma unroll
                        for (int h = 0; h < 6; ++h) *(u32x4*)(B.MK + (size_t)row * 1152 + h * 192 + 128 + cw) = w;
                    } else if (wc == 2 && fq < 2) {
                        float* gp = B.GATES + (size_t)row * 16 + 8 * fq; f32x4 s0, s1;
#pragma unroll
                        for (int e = 0; e < 4; ++e) { s0[e] = __builtin_amdgcn_rcpf(1.0f + __builtin_amdgcn_exp2f(-1.4426950408889634f * v00[e])); s1[e] = __builtin_amdgcn_rcpf(1.0f + __builtin_amdgcn_exp2f(-1.4426950408889634f * v01[e])); }
                        *(f32x4*)gp = s0; *(f32x4*)(gp + 4) = s1;
                    }
                }
            }
    }
};
struct EpiUp {
    static constexpr bool PERM = true;
    bf16_t *MQ, *MK, *MV; const float* LATSS; const float* ROPE;
    __device__ __forceinline__ void operator()(const f32x4 (&acc)[2][2][4][2], const Unit& u, int wr, int wc, int fr, int fq) const {
        const int row0 = u.pm * BM + wr * 64 + fr, cw = wc * 32 + 8 * fq, pn = u.pn;
        float rs[2][4]; load_rstd8_lat<8>(LATSS, pn < 5 ? 0 : 8, row0, fq, fq * 16 + fr, 1.0f / 512.0f, rs);
#pragma unroll
        for (int ai = 0; ai < 2; ++ai)
#pragma unroll
            for (int m = 0; m < 4; ++m) { const int row = row0 + ai * HALF + m * 16;
                if (pn < 5) { const float r = rs[ai][m] * QSCALE_M;
#pragma unroll
                    for (int bj = 0; bj < 2; ++bj) { const int c = pn * 256 + bj * HALF + cw; if (c < 1152) { f32x4 a = acc[ai][bj][m][0] * r, b = acc[ai][bj][m][1] * r; const int w = c % 192;
                        if (w >= 128) rope8(a, b, ROPE, row & (SEQ - 1), (w - 128) >> 1);
                        *(u32x4*)(MQ + (size_t)row * 1152 + c) = pack8f(a, b); } }
                } else { const float r = rs[ai][m]; const int h = pn - 5;
                    *(u32x4*)(MK + (size_t)row * 1152 + h * 192 + cw) = pack8f(acc[ai][0][m][0] * r, acc[ai][0][m][1] * r);
                    *(u32x4*)(MV + (size_t)row * 768 + h * 128 + cw) = pack8f(acc[ai][1][m][0] * r, acc[ai][1][m][1] * r); }
            }
    }
};
struct EpiCmp {
    static constexpr bool PERM = true;
    bf16_t* H1; const float* CB;
    __device__ __forceinline__ void operator()(const f32x4 (&acc)[2][2][4][2], const Unit& u, int wr, int wc, int fr, int fq) const {
        const int row0 = u.pm * BM + wr * 64 + fr, cw = wc * 32 + 8 * fq;
        const f32x4 b0 = *(const f32x4*)(CB + cw), b1 = *(const f32x4*)(CB + cw + 4);
#pragma unroll
        for (int ai = 0; ai < 2; ++ai)
#pragma unroll
            for (int m = 0; m < 4; ++m) { const int row = row0 + ai * HALF + m * 16; f32x4 a = acc[ai][0][m][0] + b0, b = acc[ai][0][m][1] + b1;
#pragma unroll
                for (int e = 0; e < 4; ++e) { a[e] = silu_mul(a[e], 1.0f); b[e] = silu_mul(b[e], 1.0f); }
                *(u32x4*)(H1 + (size_t)row * 128 + cw) = pack8f(a, b); }
    }
};
}


namespace att {
#ifndef DIL_DMA
#define DIL_DMA true
#endif
constexpr int SHM_V = 16384;
constexpr float THR2 = 11.5f;
#define SBAR() __builtin_amdgcn_sched_barrier(0)
__device__ __forceinline__ int v_st(int k, int c) { const int kk = (k & ~0xC) | ((k & 4) << 1) | ((k & 8) >> 1); return ((kk >> 3) * 4 + (c >> 5)) * 512 + ((kk & 7) * 32 + (c & 31)) * 2; }
__device__ __forceinline__ int v_rd_base(int lane) { return ((lane & 3) << 3) | (((lane >> 2) & 3) << 6) | (((lane >> 4) & 1) << 5) | (((lane >> 5) & 1) << 8); }
constexpr int v_rd_off(int d0, int ks, int half) { return d0 * 512 + ks * 4096 + half * 2048; }
__device__ __forceinline__ int crow(int r, int hi) { return (r & 3) + 8 * (r >> 2) + 4 * hi; }
__device__ __forceinline__ void mask_tile(f32x16& p0, f32x16& p1, int dq, unsigned W) {
    const float NEG = -__builtin_inff();
#pragma unroll
    for (int r = 0; r < 16; ++r) { const int c = (r & 3) + 8 * (r >> 2);
        if ((unsigned)(dq - c) >= W) p0[r] = NEG;
        if ((unsigned)(dq - c - 32) >= W) p1[r] = NEG; }
}
__device__ __forceinline__ void bias_tile(f32x16& p0, f32x16& p1, int dq, float sl2) {
    const float base = -sl2 * (float)dq;
#pragma unroll
    for (int r = 0; r < 16; ++r) { const int c = (r & 3) + 8 * (r >> 2); p0[r] += fmaf(sl2, (float)c, base); p1[r] += fmaf(sl2, (float)(c + 32), base); }
}
template <bool FIXEDM>
__device__ __forceinline__ void partialSM(f32x16& p0, f32x16& p1, float& m_reg, float& mn, float& alpha) {
    if constexpr (FIXEDM) { mn = m_reg; alpha = 1.f; }
    else {
        float pmax = p0[0];
#pragma unroll
        for (int r = 1; r < 16; ++r) pmax = fmaxf(pmax, p0[r]);
#pragma unroll
        for (int r = 0; r < 16; ++r) pmax = fmaxf(pmax, p1[r]);
        { auto rr = __builtin_amdgcn_permlane32_swap(__float_as_uint(pmax), __float_as_uint(pmax), false, false); pmax = fmaxf(__uint_as_float(rr[0]), __uint_as_float(rr[1])); }
        if (__builtin_expect(__all(pmax - m_reg <= THR2), 1)) { mn = m_reg; alpha = 1.f; }
        else { mn = fmaxf(m_reg, pmax); alpha = __builtin_amdgcn_exp2f(m_reg - mn); m_reg = mn; }
    }
#pragma unroll
    for (int r = 0; r < 16; ++r) { p0[r] -= mn; p1[r] -= mn; }
#pragma unroll
    for (int r = 0; r < 16; ++r) p0[r] = __builtin_amdgcn_exp2f(p0[r]);
}
__device__ __forceinline__ void finishSM_exp(f32x16& p0, f32x16& p1, float alpha, float& l_reg) {
#pragma unroll
    for (int r = 0; r < 16; ++r) p1[r] = __builtin_amdgcn_exp2f(p1[r]);
    float ps = 0;
#pragma unroll
    for (int r = 0; r < 16; ++r) ps += p0[r];
#pragma unroll
    for (int r = 0; r < 16; ++r) ps += p1[r];
    { auto rr = __builtin_amdgcn_permlane32_swap(__float_as_uint(ps), __float_as_uint(ps), false, false); ps = __uint_as_float(rr[0]) + __uint_as_float(rr[1]); }
    l_reg = l_reg * alpha + ps;
}
__device__ __forceinline__ void finishSM_pack(const f32x16& p0, const f32x16& p1, bf16x8& pa0, bf16x8& pa1, bf16x8& pa2, bf16x8& pa3) {
#define PK4(P, B_, OUT) do { unsigned a0 = cvt_pk_bf16(P[B_+0], P[B_+1]), a1 = cvt_pk_bf16(P[B_+2], P[B_+3]); unsigned b0 = cvt_pk_bf16(P[B_+4], P[B_+5]), b1 = cvt_pk_bf16(P[B_+6], P[B_+7]); \
        auto r0 = __builtin_amdgcn_permlane32_swap(a0, b0, false, false); auto r1 = __builtin_amdgcn_permlane32_swap(a1, b1, false, false); \
        u32x4 w = {r0[0], r1[0], r0[1], r1[1]}; OUT = *reinterpret_cast<bf16x8*>(&w); } while (0)
    PK4(p0, 0, pa0); PK4(p0, 8, pa1); PK4(p1, 0, pa2); PK4(p1, 8, pa3);
#undef PK4
}
template <int DQK> __device__ __forceinline__ int kswz(int r) { return DQK == 192 ? ((r >> 1) & 7) : (r & 7); }
template <int KB, int DQK, int NQR>
__device__ __forceinline__ void qkt(f32x16& p0, f32x16& p1, LAS const unsigned char* K_lds, int r32, int hi, const bf16x8* qr, LAS const unsigned char* qlds, bool act) {
    constexpr int KROWB = DQK * 2, SHM_K = 64 * KROWB;
    if (!act) { const float NEG = -__builtin_inff();
#pragma unroll
        for (int r = 0; r < 16; ++r) { p0[r] = NEG; p1[r] = NEG; } return; }
    p0 = f32x16{}; p1 = f32x16{};
    if constexpr (NQR == DQK / 16) {
        constexpr int NF = DQK / 8;
        int r_ = r32; asm volatile("" : "+v"(r_));
        const int rowa = (int)(uintptr_t)(K_lds + KB * SHM_K) + r_ * KROWB, xr = kswz<DQK>(r_) << 4;
        int kbA[4];
#pragma unroll
        for (int dd = 0; dd < 4; ++dd) kbA[dd] = rowa + (((dd * 16 + hi * 8) * 2) ^ xr);
#define KADDR(f) "v"(kbA[((f) >> 1) & 3]), "i"((((f) >> 1) >> 2) * 128 + ((f) & 1) * 32 * KROWB)
#define KRD0(dst, f) asm volatile("ds_read_b128 %0, %1 offset:%2" : "=&v"(dst) : KADDR(f) : "memory")
#define KRDP(dst, f, P) asm volatile("ds_read_b128 %0, %2 offset:%3" : "=&v"(dst), "+v"(P) : KADDR(f) : "memory")
#define KWAIT(n, F) asm volatile("s_waitcnt lgkmcnt(%1)" : "+v"(F) : "i"(n) : "memory")
        bf16x8 F0, F1, F2, F3;
        KRD0(F0, 0); KRD0(F1, 1); KRD0(F2, 2); KRD0(F3, 3);
    if constexpr (0 < NF) { KWAIT((NF - 1 - 0) < 3 ? (NF - 1 - 0) : 3, F0); p0 = __builtin_amdgcn_mfma_f32_32x32x16_bf16(F0, qr[0], p0, 0, 0, 0); if constexpr (0 + 4 < NF) KRDP(F0, 0 + 4, p0); }
    if constexpr (1 < NF) { KWAIT((NF - 1 - 1) < 3 ? (NF - 1 - 1) : 3, F1); p1 = __builtin_amdgcn_mfma_f32_32x32x16_bf16(F1, qr[0], p1, 0, 0, 0); if constexpr (1 + 4 < NF) KRDP(F1, 1 + 4, p1); }
    if constexpr (2 < NF) { KWAIT((NF - 1 - 2) < 3 ? (NF - 1 - 2) : 3, F2); p0 = __builtin_amdgcn_mfma_f32_32x32x16_bf16(F2, qr[1], p0, 0, 0, 0); if constexpr (2 + 4 < NF) KRDP(F2, 2 + 4, p0); }
    if constexpr (3 < NF) { KWAIT((NF - 1 - 3) < 3 ? (NF - 1 - 3) : 3, F3); p1 = __builtin_amdgcn_mfma_f32_32x32x16_bf16(F3, qr[1], p1, 0, 0, 0); if constexpr (3 + 4 < NF) KRDP(F3, 3 + 4, p1); }
    if constexpr (4 < NF) { KWAIT((NF - 1 - 4) < 3 ? (NF - 1 - 4) : 3, F0); p0 = __builtin_amdgcn_mfma_f32_32x32x16_bf16(F0, qr[2], p0, 0, 0, 0); if constexpr (4 + 4 < NF) KRDP(F0, 4 + 4, p0); }
    if constexpr (5 < NF) { KWAIT((NF - 1 - 5) < 3 ? (NF - 1 - 5) : 3, F1); p1 = __builtin_amdgcn_mfma_f32_32x32x16_bf16(F1, qr[2], p1, 0, 0, 0); if constexpr (5 + 4 < NF) KRDP(F1, 5 + 4, p1); }
    if constexpr (6 < NF) { KWAIT((NF - 1 - 6) < 3 ? (NF - 1 - 6) : 3, F2); p0 = __builtin_amdgcn_mfma_f32_32x32x16_bf16(F2, qr[3], p0, 0, 0, 0); if constexpr (6 + 4 < NF) KRDP(F2, 6 + 4, p0); }
    if constexpr (7 < NF) { KWAIT((NF - 1 - 7) < 3 ? (NF - 1 - 7) : 3, F3); p1 = __builtin_amdgcn_mfma_f32_32x32x16_bf16(F3, qr[3], p1, 0, 0, 0); if constexpr (7 + 4 < NF) KRDP(F3, 7 + 4, p1); }
    if constexpr (8 < NF) { KWAIT((NF - 1 - 8) < 3 ? (NF - 1 - 8) : 3, F0); p0 = __builtin_amdgcn_mfma_f32_32x32x16_bf16(F0, qr[4], p0, 0, 0, 0); if constexpr (8 + 4 < NF) KRDP(F0, 8 + 4, p0); }
    if constexpr (9 < NF) { KWAIT((NF - 1 - 9) < 3 ? (NF - 1 - 9) : 3, F1); p1 = __builtin_amdgcn_mfma_f32_32x32x16_bf16(F1, qr[4], p1, 0, 0, 0); if constexpr (9 + 4 < NF) KRDP(F1, 9 + 4, p1); }
    if constexpr (10 < NF) { KWAIT((NF - 1 - 10) < 3 ? (NF - 1 - 10) : 3, F2); p0 = __builtin_amdgcn_mfma_f32_32x32x16_bf16(F2, qr[5], p0, 0, 0, 0); if constexpr (10 + 4 < NF) KRDP(F2, 10 + 4, p0); }
    if constexpr (11 < NF) { KWAIT((NF - 1 - 11) < 3 ? (NF - 1 - 11) : 3, F3); p1 = __builtin_amdgcn_mfma_f32_32x32x16_bf16(F3, qr[5], p1, 0, 0, 0); if constexpr (11 + 4 < NF) KRDP(F3, 11 + 4, p1); }
    if constexpr (12 < NF) { KWAIT((NF - 1 - 12) < 3 ? (NF - 1 - 12) : 3, F0); p0 = __builtin_amdgcn_mfma_f32_32x32x16_bf16(F0, qr[6], p0, 0, 0, 0); if constexpr (12 + 4 < NF) KRDP(F0, 12 + 4, p0); }
    if constexpr (13 < NF) { KWAIT((NF - 1 - 13) < 3 ? (NF - 1 - 13) : 3, F1); p1 = __builtin_amdgcn_mfma_f32_32x32x16_bf16(F1, qr[6], p1, 0, 0, 0); if constexpr (13 + 4 < NF) KRDP(F1, 13 + 4, p1); }
    if constexpr (14 < NF) { KWAIT((NF - 1 - 14) < 3 ? (NF - 1 - 14) : 3, F2); p0 = __builtin_amdgcn_mfma_f32_32x32x16_bf16(F2, qr[7], p0, 0, 0, 0); if constexpr (14 + 4 < NF) KRDP(F2, 14 + 4, p0); }
    if constexpr (15 < NF) { KWAIT((NF - 1 - 15) < 3 ? (NF - 1 - 15) : 3, F3); p1 = __builtin_amdgcn_mfma_f32_32x32x16_bf16(F3, qr[7], p1, 0, 0, 0); if constexpr (15 + 4 < NF) KRDP(F3, 15 + 4, p1); }
    if constexpr (16 < NF) { KWAIT((NF - 1 - 16) < 3 ? (NF - 1 - 16) : 3, F0); p0 = __builtin_amdgcn_mfma_f32_32x32x16_bf16(F0, qr[8], p0, 0, 0, 0); if constexpr (16 + 4 < NF) KRDP(F0, 16 + 4, p0); }
    if constexpr (17 < NF) { KWAIT((NF - 1 - 17) < 3 ? (NF - 1 - 17) : 3, F1); p1 = __builtin_amdgcn_mfma_f32_32x32x16_bf16(F1, qr[8], p1, 0, 0, 0); if constexpr (17 + 4 < NF) KRDP(F1, 17 + 4, p1); }
    if constexpr (18 < NF) { KWAIT((NF - 1 - 18) < 3 ? (NF - 1 - 18) : 3, F2); p0 = __builtin_amdgcn_mfma_f32_32x32x16_bf16(F2, qr[9], p0, 0, 0, 0); if constexpr (18 + 4 < NF) KRDP(F2, 18 + 4, p0); }
    if constexpr (19 < NF) { KWAIT((NF - 1 - 19) < 3 ? (NF - 1 - 19) : 3, F3); p1 = __builtin_amdgcn_mfma_f32_32x32x16_bf16(F3, qr[9], p1, 0, 0, 0); if constexpr (19 + 4 < NF) KRDP(F3, 19 + 4, p1); }
    if constexpr (20 < NF) { KWAIT((NF - 1 - 20) < 3 ? (NF - 1 - 20) : 3, F0); p0 = __builtin_amdgcn_mfma_f32_32x32x16_bf16(F0, qr[10], p0, 0, 0, 0); if constexpr (20 + 4 < NF) KRDP(F0, 20 + 4, p0); }
    if constexpr (21 < NF) { KWAIT((NF - 1 - 21) < 3 ? (NF - 1 - 21) : 3, F1); p1 = __builtin_amdgcn_mfma_f32_32x32x16_bf16(F1, qr[10], p1, 0, 0, 0); if constexpr (21 + 4 < NF) KRDP(F1, 21 + 4, p1); }
    if constexpr (22 < NF) { KWAIT((NF - 1 - 22) < 3 ? (NF - 1 - 22) : 3, F2); p0 = __builtin_amdgcn_mfma_f32_32x32x16_bf16(F2, qr[11], p0, 0, 0, 0); if constexpr (22 + 4 < NF) KRDP(F2, 22 + 4, p0); }
    if constexpr (23 < NF) { KWAIT((NF - 1 - 23) < 3 ? (NF - 1 - 23) : 3, F3); p1 = __builtin_amdgcn_mfma_f32_32x32x16_bf16(F3, qr[11], p1, 0, 0, 0); if constexpr (23 + 4 < NF) KRDP(F3, 23 + 4, p1); }
#undef KRD0
#undef KRDP
#undef KADDR
#undef KWAIT
    } else {
    LAS const unsigned char* kb[4];
#pragma unroll
    for (int dd = 0; dd < 4; ++dd) kb[dd] = K_lds + KB * SHM_K + r32 * KROWB + (((dd * 16 + hi * 8) * 2) ^ (kswz<DQK>(r32) << 4));
#pragma unroll
    for (int d0 = 0; d0 < DQK / 16; ++d0) { LAS const unsigned char* a = kb[d0 & 3] + (d0 >> 2) * 128;
        bf16x8 b0 = *reinterpret_cast<LAS const bf16x8*>(a);
        bf16x8 b1 = *reinterpret_cast<LAS const bf16x8*>(a + 32 * KROWB);
        bf16x8 q; if (d0 < NQR) q = qr[d0]; else q = *reinterpret_cast<LAS const bf16x8*>(qlds + (d0 - NQR) * 1024);
        p0 = __builtin_amdgcn_mfma_f32_32x32x16_bf16(b0, q, p0, 0, 0, 0);
        p1 = __builtin_amdgcn_mfma_f32_32x32x16_bf16(b1, q, p1, 0, 0, 0); }
    }
}
template <int C>
__device__ __forceinline__ void fin_item(f32x16& y0, f32x16& y1, float& ps0, float& ps1, unsigned (&wv)[16]) {
    if constexpr (C < 16) { const float e = __builtin_amdgcn_exp2f(y1[C]); y1[C] = e; ps0 += y0[C]; ps1 += e; }
    else { constexpr int j = C - 16, q = j >> 1, h = j & 1, B_ = (q & 1) * 8 + 2 * h; unsigned a, b;
        if constexpr (q < 2) { a = cvt_pk_bf16(y0[B_], y0[B_ + 1]); b = cvt_pk_bf16(y0[B_ + 4], y0[B_ + 5]); } else { a = cvt_pk_bf16(y1[B_], y1[B_ + 1]); b = cvt_pk_bf16(y1[B_ + 4], y1[B_ + 5]); }
        auto r = __builtin_amdgcn_permlane32_swap(a, b, false, false); wv[q * 4 + h] = r[0]; wv[q * 4 + 2 + h] = r[1];
        asm volatile("" : "+v"(wv[q * 4 + h]), "+v"(wv[q * 4 + 2 + h])); }
}
template <int A, int B>
__device__ __forceinline__ void fin_range(f32x16& y0, f32x16& y1, float& ps0, float& ps1, unsigned (&wv)[16]) { if constexpr (A < B) { fin_item<A>(y0, y1, ps0, ps1, wv); fin_range<A + 1, B>(y0, y1, ps0, ps1, wv); } }
template <int KB, int DQK, class DMF>
__device__ __forceinline__ void qkt_fin(f32x16& p0, f32x16& p1, LAS const unsigned char* K_lds, int r32, int hi, const bf16x8* qr, bool act,
                                        f32x16& y0, f32x16& y1, float alpha, float& l_reg, bf16x8& pa0, bf16x8& pa1, bf16x8& pa2, bf16x8& pa3, const DMF& dm) {
    if (!act) { _Pragma("unroll") for (int f_ = 0; f_ < DQK / 8; ++f_) dm(f_); qkt<KB, DQK, DQK / 16>(p0, p1, K_lds, r32, hi, qr, nullptr, false); finishSM_exp(y0, y1, alpha, l_reg); finishSM_pack(y0, y1, pa0, pa1, pa2, pa3); return; }
    constexpr int KROWB = DQK * 2, SHM_K = 64 * KROWB, NF = DQK / 8;
    p0 = f32x16{}; p1 = f32x16{};
    int r_ = r32; asm volatile("" : "+v"(r_));
    const int rowa = (int)(uintptr_t)(K_lds + KB * SHM_K) + r_ * KROWB, xr = kswz<DQK>(r_) << 4;
    int kbA[4];
#pragma unroll
    for (int dd = 0; dd < 4; ++dd) kbA[dd] = rowa + (((dd * 16 + hi * 8) * 2) ^ xr);
    float ps0 = 0.f, ps1 = 0.f; unsigned wv[16];
#define KADDR(f) "v"(kbA[((f) >> 1) & 3]), "i"((((f) >> 1) >> 2) * 128 + ((f) & 1) * 32 * KROWB)
#define KRD0(dst, f) asm volatile("ds_read_b128 %0, %1 offset:%2" : "=&v"(dst) : KADDR(f) : "memory")
#define KRDP(dst, f, P) asm volatile("ds_read_b128 %0, %2 offset:%3" : "=&v"(dst), "+v"(P) : KADDR(f) : "memory")
#define KWAIT(n, F) asm volatile("s_waitcnt lgkmcnt(%1)" : "+v"(F) : "i"(n) : "memory")
#define FTIE(P) asm volatile("" : "+v"(y0), "+v"(y1), "+v"(ps0), "+v"(ps1), "+v"(P))
    bf16x8 F0, F1, F2, F3;
    KRD0(F0, 0); KRD0(F1, 1); KRD0(F2, 2); KRD0(F3, 3);
    if constexpr (0 < NF) { KWAIT((NF - 1 - 0) < 3 ? (NF - 1 - 0) : 3, F0); p0 = __builtin_amdgcn_mfma_f32_32x32x16_bf16(F0, qr[0], p0, 0, 0, 0); if constexpr (0 + 4 < NF) KRDP(F0, 0 + 4, p0); fin_range<(0 * 24) / NF, ((0 + 1) * 24) / NF>(y0, y1, ps0, ps1, wv); FTIE(p0); dm(0); }
    if constexpr (1 < NF) { KWAIT((NF - 1 - 1) < 3 ? (NF - 1 - 1) : 3, F1); p1 = __builtin_amdgcn_mfma_f32_32x32x16_bf16(F1, qr[0], p1, 0, 0, 0); if constexpr (1 + 4 < NF) KRDP(F1, 1 + 4, p1); fin_range<(1 * 24) / NF, ((1 + 1) * 24) / NF>(y0, y1, ps0, ps1, wv); FTIE(p1); dm(1); }
    if constexpr (2 < NF) { KWAIT((NF - 1 - 2) < 3 ? (NF - 1 - 2) : 3, F2); p0 = __builtin_amdgcn_mfma_f32_32x32x16_bf16(F2, qr[1], p0, 0, 0, 0); if constexpr (2 + 4 < NF) KRDP(F2, 2 + 4, p0); fin_range<(2 * 24) / NF, ((2 + 1) * 24) / NF>(y0, y1, ps0, ps1, wv); FTIE(p0); dm(2); }
    if constexpr (3 < NF) { KWAIT((NF - 1 - 3) < 3 ? (NF - 1 - 3) : 3, F3); p1 = __builtin_amdgcn_mfma_f32_32x32x16_bf16(F3, qr[1], p1, 0, 0, 0); if constexpr (3 + 4 < NF) KRDP(F3, 3 + 4, p1); fin_range<(3 * 24) / NF, ((3 + 1) * 24) / NF>(y0, y1, ps0, ps1, wv); FTIE(p1); dm(3); }
    if constexpr (4 < NF) { KWAIT((NF - 1 - 4) < 3 ? (NF - 1 - 4) : 3, F0); p0 = __builtin_amdgcn_mfma_f32_32x32x16_bf16(F0, qr[2], p0, 0, 0, 0); if constexpr (4 + 4 < NF) KRDP(F0, 4 + 4, p0); fin_range<(4 * 24) / NF, ((4 + 1) * 24) / NF>(y0, y1, ps0, ps1, wv); FTIE(p0); dm(4); }
    if constexpr (5 < NF) { KWAIT((NF - 1 - 5) < 3 ? (NF - 1 - 5) : 3, F1); p1 = __builtin_amdgcn_mfma_f32_32x32x16_bf16(F1, qr[2], p1, 0, 0, 0); if constexpr (5 + 4 < NF) KRDP(F1, 5 + 4, p1); fin_range<(5 * 24) / NF, ((5 + 1) * 24) / NF>(y0, y1, ps0, ps1, wv); FTIE(p1); dm(5); }
    if constexpr (6 < NF) { KWAIT((NF - 1 - 6) < 3 ? (NF - 1 - 6) : 3, F2); p0 = __builtin_amdgcn_mfma_f32_32x32x16_bf16(F2, qr[3], p0, 0, 0, 0); if constexpr (6 + 4 < NF) KRDP(F2, 6 + 4, p0); fin_range<(6 * 24) / NF, ((6 + 1) * 24) / NF>(y0, y1, ps0, ps1, wv); FTIE(p0); dm(6); }
    if constexpr (7 < NF) { KWAIT((NF - 1 - 7) < 3 ? (NF - 1 - 7) : 3, F3); p1 = __builtin_amdgcn_mfma_f32_32x32x16_bf16(F3, qr[3], p1, 0, 0, 0); if constexpr (7 + 4 < NF) KRDP(F3, 7 + 4, p1); fin_range<(7 * 24) / NF, ((7 + 1) * 24) / NF>(y0, y1, ps0, ps1, wv); FTIE(p1); dm(7); }
    if constexpr (8 < NF) { KWAIT((NF - 1 - 8) < 3 ? (NF - 1 - 8) : 3, F0); p0 = __builtin_amdgcn_mfma_f32_32x32x16_bf16(F0, qr[4], p0, 0, 0, 0); if constexpr (8 + 4 < NF) KRDP(F0, 8 + 4, p0); fin_range<(8 * 24) / NF, ((8 + 1) * 24) / NF>(y0, y1, ps0, ps1, wv); FTIE(p0); dm(8); }
    if constexpr (9 < NF) { KWAIT((NF - 1 - 9) < 3 ? (NF - 1 - 9) : 3, F1); p1 = __builtin_amdgcn_mfma_f32_32x32x16_bf16(F1, qr[4], p1, 0, 0, 0); if constexpr (9 + 4 < NF) KRDP(F1, 9 + 4, p1); fin_range<(9 * 24) / NF, ((9 + 1) * 24) / NF>(y0, y1, ps0, ps1, wv); FTIE(p1); dm(9); }
    if constexpr (10 < NF) { KWAIT((NF - 1 - 10) < 3 ? (NF - 1 - 10) : 3, F2); p0 = __builtin_amdgcn_mfma_f32_32x32x16_bf16(F2, qr[5], p0, 0, 0, 0); if constexpr (10 + 4 < NF) KRDP(F2, 10 + 4, p0); fin_range<(10 * 24) / NF, ((10 + 1) * 24) / NF>(y0, y1, ps0, ps1, wv); FTIE(p0); dm(10); }
    if constexpr (11 < NF) { KWAIT((NF - 1 - 11) < 3 ? (NF - 1 - 11) : 3, F3); p1 = __builtin_amdgcn_mfma_f32_32x32x16_bf16(F3, qr[5], p1, 0, 0, 0); if constexpr (11 + 4 < NF) KRDP(F3, 11 + 4, p1); fin_range<(11 * 24) / NF, ((11 + 1) * 24) / NF>(y0, y1, ps0, ps1, wv); FTIE(p1); dm(11); }
    if constexpr (12 < NF) { KWAIT((NF - 1 - 12) < 3 ? (NF - 1 - 12) : 3, F0); p0 = __builtin_amdgcn_mfma_f32_32x32x16_bf16(F0, qr[6], p0, 0, 0, 0); if constexpr (12 + 4 < NF) KRDP(F0, 12 + 4, p0); fin_range<(12 * 24) / NF, ((12 + 1) * 24) / NF>(y0, y1, ps0, ps1, wv); FTIE(p0); dm(12); }
    if constexpr (13 < NF) { KWAIT((NF - 1 - 13) < 3 ? (NF - 1 - 13) : 3, F1); p1 = __builtin_amdgcn_mfma_f32_32x32x16_bf16(F1, qr[6], p1, 0, 0, 0); if constexpr (13 + 4 < NF) KRDP(F1, 13 + 4, p1); fin_range<(13 * 24) / NF, ((13 + 1) * 24) / NF>(y0, y1, ps0, ps1, wv); FTIE(p1); dm(13); }
    if constexpr (14 < NF) { KWAIT((NF - 1 - 14) < 3 ? (NF - 1 - 14) : 3, F2); p0 = __builtin_amdgcn_mfma_f32_32x32x16_bf16(F2, qr[7], p0, 0, 0, 0); if constexpr (14 + 4 < NF) KRDP(F2, 14 + 4, p0); fin_range<(14 * 24) / NF, ((14 + 1) * 24) / NF>(y0, y1, ps0, ps1, wv); FTIE(p0); dm(14); }
    if constexpr (15 < NF) { KWAIT((NF - 1 - 15) < 3 ? (NF - 1 - 15) : 3, F3); p1 = __builtin_amdgcn_mfma_f32_32x32x16_bf16(F3, qr[7], p1, 0, 0, 0); if constexpr (15 + 4 < NF) KRDP(F3, 15 + 4, p1); fin_range<(15 * 24) / NF, ((15 + 1) * 24) / NF>(y0, y1, ps0, ps1, wv); FTIE(p1); dm(15); }
    if constexpr (16 < NF) { KWAIT((NF - 1 - 16) < 3 ? (NF - 1 - 16) : 3, F0); p0 = __builtin_amdgcn_mfma_f32_32x32x16_bf16(F0, qr[8], p0, 0, 0, 0); if constexpr (16 + 4 < NF) KRDP(F0, 16 + 4, p0); fin_range<(16 * 24) / NF, ((16 + 1) * 24) / NF>(y0, y1, ps0, ps1, wv); FTIE(p0); dm(16); }
    if constexpr (17 < NF) { KWAIT((NF - 1 - 17) < 3 ? (NF - 1 - 17) : 3, F1); p1 = __builtin_amdgcn_mfma_f32_32x32x16_bf16(F1, qr[8], p1, 0, 0, 0); if constexpr (17 + 4 < NF) KRDP(F1, 17 + 4, p1); fin_range<(17 * 24) / NF, ((17 + 1) * 24) / NF>(y0, y1, ps0, ps1, wv); FTIE(p1); dm(17); }
    if constexpr (18 < NF) { KWAIT((NF - 1 - 18) < 3 ? (NF - 1 - 18) : 3, F2); p0 = __builtin_amdgcn_mfma_f32_32x32x16_bf16(F2, qr[9], p0, 0, 0, 0); if constexpr (18 + 4 < NF) KRDP(F2, 18 + 4, p0); fin_range<(18 * 24) / NF, ((18 + 1) * 24) / NF>(y0, y1, ps0, ps1, wv); FTIE(p0); dm(18); }
    if constexpr (19 < NF) { KWAIT((NF - 1 - 19) < 3 ? (NF - 1 - 19) : 3, F3); p1 = __builtin_amdgcn_mfma_f32_32x32x16_bf16(F3, qr[9], p1, 0, 0, 0); if constexpr (19 + 4 < NF) KRDP(F3, 19 + 4, p1); fin_range<(19 * 24) / NF, ((19 + 1) * 24) / NF>(y0, y1, ps0, ps1, wv); FTIE(p1); dm(19); }
    if constexpr (20 < NF) { KWAIT((NF - 1 - 20) < 3 ? (NF - 1 - 20) : 3, F0); p0 = __builtin_amdgcn_mfma_f32_32x32x16_bf16(F0, qr[10], p0, 0, 0, 0); if constexpr (20 + 4 < NF) KRDP(F0, 20 + 4, p0); fin_range<(20 * 24) / NF, ((20 + 1) * 24) / NF>(y0, y1, ps0, ps1, wv); FTIE(p0); dm(20); }
    if constexpr (21 < NF) { KWAIT((NF - 1 - 21) < 3 ? (NF - 1 - 21) : 3, F1); p1 = __builtin_amdgcn_mfma_f32_32x32x16_bf16(F1, qr[10], p1, 0, 0, 0); if constexpr (21 + 4 < NF) KRDP(F1, 21 + 4, p1); fin_range<(21 * 24) / NF, ((21 + 1) * 24) / NF>(y0, y1, ps0, ps1, wv); FTIE(p1); dm(21); }
    if constexpr (22 < NF) { KWAIT((NF - 1 - 22) < 3 ? (NF - 1 - 22) : 3, F2); p0 = __builtin_amdgcn_mfma_f32_32x32x16_bf16(F2, qr[11], p0, 0, 0, 0); if constexpr (22 + 4 < NF) KRDP(F2, 22 + 4, p0); fin_range<(22 * 24) / NF, ((22 + 1) * 24) / NF>(y0, y1, ps0, ps1, wv); FTIE(p0); dm(22); }
    if constexpr (23 < NF) { KWAIT((NF - 1 - 23) < 3 ? (NF - 1 - 23) : 3, F3); p1 = __builtin_amdgcn_mfma_f32_32x32x16_bf16(F3, qr[11], p1, 0, 0, 0); if constexpr (23 + 4 < NF) KRDP(F3, 23 + 4, p1); fin_range<(23 * 24) / NF, ((23 + 1) * 24) / NF>(y0, y1, ps0, ps1, wv); FTIE(p1); dm(23); }
#undef KADDR
#undef KRD0
#undef KRDP
#undef KWAIT
#undef FTIE
    float ps = ps0 + ps1;
    { auto rr = __builtin_amdgcn_permlane32_swap(__float_as_uint(ps), __float_as_uint(ps), false, false); ps = __uint_as_float(rr[0]) + __uint_as_float(rr[1]); }
    l_reg = l_reg * alpha + ps;
    { u32x4 w = {wv[0], wv[1], wv[2], wv[3]}; pa0 = *reinterpret_cast<bf16x8*>(&w); } { u32x4 w = {wv[4], wv[5], wv[6], wv[7]}; pa1 = *reinterpret_cast<bf16x8*>(&w); }
    { u32x4 w = {wv[8], wv[9], wv[10], wv[11]}; pa2 = *reinterpret_cast<bf16x8*>(&w); } { u32x4 w = {wv[12], wv[13], wv[14], wv[15]}; pa3 = *reinterpret_cast<bf16x8*>(&w); }
}
template <int VB>
__device__ __forceinline__ void pv_tile(f32x16* o, int vb0, bf16x8 pa0, bf16x8 pa1, bf16x8 pa2, bf16x8 pa3, bool act) {
    if (!act) return;
#define TRRD(dst, off) asm volatile("ds_read_b64_tr_b16 %0, %1 offset:%2" : "=&v"(dst) : "v"(vb0), "i"(off) : "memory")
#define PV_D0(d0) do { s16x4 l0, l1, l2, l3, h0, h1, h2, h3; constexpr int b_ = VB * SHM_V + v_rd_off(d0, 0, 0); \
        TRRD(l0, b_); TRRD(h0, b_ + 2048); TRRD(l1, b_ + 4096); TRRD(h1, b_ + 6144); TRRD(l2, b_ + 8192); TRRD(h2, b_ + 10240); TRRD(l3, b_ + 12288); TRRD(h3, b_ + 14336); \
        asm volatile("s_waitcnt lgkmcnt(0)" ::: "memory"); SBAR(); \
        o[d0] = __builtin_amdgcn_mfma_f32_32x32x16_bf16(pa0, (bf16x8){l0[0], l0[1], l0[2], l0[3], h0[0], h0[1], h0[2], h0[3]}, o[d0], 0, 0, 0); \
        o[d0] = __builtin_amdgcn_mfma_f32_32x32x16_bf16(pa1, (bf16x8){l1[0], l1[1], l1[2], l1[3], h1[0], h1[1], h1[2], h1[3]}, o[d0], 0, 0, 0); \
        o[d0] = __builtin_amdgcn_mfma_f32_32x32x16_bf16(pa2, (bf16x8){l2[0], l2[1], l2[2], l2[3], h2[0], h2[1], h2[2], h2[3]}, o[d0], 0, 0, 0); \
        o[d0] = __builtin_amdgcn_mfma_f32_32x32x16_bf16(pa3, (bf16x8){l3[0], l3[1], l3[2], l3[3], h3[0], h3[1], h3[2], h3[3]}, o[d0], 0, 0, 0); } while (0)
    PV_D0(0); PV_D0(1); PV_D0(2); PV_D0(3);
#undef PV_D0
#undef TRRD
}

__device__ __forceinline__ void pv_sm(f32x16* o, int vb, bf16x8 pa0, bf16x8 pa1, bf16x8 pa2, bf16x8 pa3, bool act, f32x16& x0, f32x16& x1, float& m_reg, float& mn, float& alpha) {
    if (!act) { partialSM<false>(x0, x1, m_reg, mn, alpha); return; }
    s16x4 S0, S1, S2, S3, S4, S5, S6, S7; float pm = -__builtin_inff();
#define TRRD(dst, off) asm volatile("ds_read_b64_tr_b16 %0, %1 offset:%2" : "=&v"(dst) : "v"(vb), "i"(off) : "memory")
#define TRRDT(dst, off, O) asm volatile("ds_read_b64_tr_b16 %0, %2 offset:%3" : "=&v"(dst), "+v"(O) : "v"(vb), "i"(off) : "memory")
#define VWAIT(n, A, B) asm volatile("s_waitcnt lgkmcnt(%2)" : "+v"(A), "+v"(B) : "i"(n) : "memory")
#define PTIE(O) asm volatile("" : "+v"(x0), "+v"(x1), "+v"(pm), "+v"(O))
#define XV(j) ((j) < 16 ? x0[(j) & 15] : x1[(j) & 15])
    TRRD(S0, 0); TRRD(S1, 2048); TRRD(S2, 4096); TRRD(S3, 6144); TRRD(S4, 8192); TRRD(S5, 10240); TRRD(S6, 12288); TRRD(S7, 14336);
    VWAIT(6, S0, S1); o[0] = __builtin_amdgcn_mfma_f32_32x32x16_bf16(pa0, (bf16x8){S0[0], S0[1], S0[2], S0[3], S1[0], S1[1], S1[2], S1[3]}, o[0], 0, 0, 0); TRRDT(S0, 512, o[0]); TRRD(S1, 2560); pm = fmaxf(fmaxf(pm, XV(0)), XV(1)); pm = fmaxf(fmaxf(pm, XV(2)), XV(3)); pm = fmaxf(fmaxf(pm, XV(4)), XV(5)); pm = fmaxf(fmaxf(pm, XV(6)), XV(7)); PTIE(o[0]);
    VWAIT(6, S2, S3); o[0] = __builtin_amdgcn_mfma_f32_32x32x16_bf16(pa1, (bf16x8){S2[0], S2[1], S2[2], S2[3], S3[0], S3[1], S3[2], S3[3]}, o[0], 0, 0, 0); TRRDT(S2, 4608, o[0]); TRRD(S3, 6656); pm = fmaxf(fmaxf(pm, XV(8)), XV(9)); pm = fmaxf(fmaxf(pm, XV(10)), XV(11)); pm = fmaxf(fmaxf(pm, XV(12)), XV(13)); pm = fmaxf(fmaxf(pm, XV(14)), XV(15)); PTIE(o[0]);
    VWAIT(6, S4, S5); o[0] = __builtin_amdgcn_mfma_f32_32x32x16_bf16(pa2, (bf16x8){S4[0], S4[1], S4[2], S4[3], S5[0], S5[1], S5[2], S5[3]}, o[0], 0, 0, 0); TRRDT(S4, 8704, o[0]); TRRD(S5, 10752); pm = fmaxf(fmaxf(pm, XV(16)), XV(17)); pm = fmaxf(fmaxf(pm, XV(18)), XV(19)); pm = fmaxf(fmaxf(pm, XV(20)), XV(21)); pm = fmaxf(fmaxf(pm, XV(22)), XV(23)); PTIE(o[0]);
    VWAIT(6, S6, S7); o[0] = __builtin_amdgcn_mfma_f32_32x32x16_bf16(pa3, (bf16x8){S6[0], S6[1], S6[2], S6[3], S7[0], S7[1], S7[2], S7[3]}, o[0], 0, 0, 0); TRRDT(S6, 12800, o[0]); TRRD(S7, 14848); pm = fmaxf(fmaxf(pm, XV(24)), XV(25)); pm = fmaxf(fmaxf(pm, XV(26)), XV(27)); pm = fmaxf(fmaxf(pm, XV(28)), XV(29)); pm = fmaxf(fmaxf(pm, XV(30)), XV(31)); PTIE(o[0]);
    VWAIT(6, S0, S1); o[1] = __builtin_amdgcn_mfma_f32_32x32x16_bf16(pa0, (bf16x8){S0[0], S0[1], S0[2], S0[3], S1[0], S1[1], S1[2], S1[3]}, o[1], 0, 0, 0); TRRDT(S0, 1024, o[1]); TRRD(S1, 3072); { auto rr = __builtin_amdgcn_permlane32_swap(__float_as_uint(pm), __float_as_uint(pm), false, false); pm = fmaxf(__uint_as_float(rr[0]), __uint_as_float(rr[1])); } { const bool ok_ = __all(pm - m_reg <= THR2); const float mx_ = fmaxf(m_reg, pm); mn = ok_ ? m_reg : mx_; alpha = __builtin_amdgcn_exp2f(m_reg - mn); m_reg = mn; asm volatile("" : "+v"(mn), "+v"(alpha)); } PTIE(o[1]);
    VWAIT(6, S2, S3); o[1] = __builtin_amdgcn_mfma_f32_32x32x16_bf16(pa1, (bf16x8){S2[0], S2[1], S2[2], S2[3], S3[0], S3[1], S3[2], S3[3]}, o[1], 0, 0, 0); TRRDT(S2, 5120, o[1]); TRRD(S3, 7168); x0[0] = __builtin_amdgcn_exp2f(x0[0] - mn); x1[0] -= mn; PTIE(o[1]);
    VWAIT(6, S4, S5); o[1] = __builtin_amdgcn_mfma_f32_32x32x16_bf16(pa2, (bf16x8){S4[0], S4[1], S4[2], S4[3], S5[0], S5[1], S5[2], S5[3]}, o[1], 0, 0, 0); TRRDT(S4, 9216, o[1]); TRRD(S5, 11264); x0[1] = __builtin_amdgcn_exp2f(x0[1] - mn); x1[1] -= mn; PTIE(o[1]);
    VWAIT(6, S6, S7); o[1] = __builtin_amdgcn_mfma_f32_32x32x16_bf16(pa3, (bf16x8){S6[0], S6[1], S6[2], S6[3], S7[0], S7[1], S7[2], S7[3]}, o[1], 0, 0, 0); TRRDT(S6, 13312, o[1]); TRRD(S7, 15360); x0[2] = __builtin_amdgcn_exp2f(x0[2] - mn); x1[2] -= mn; x0[3] = __builtin_amdgcn_exp2f(x0[3] - mn); x1[3] -= mn; PTIE(o[1]);
    VWAIT(6, S0, S1); o[2] = __builtin_amdgcn_mfma_f32_32x32x16_bf16(pa0, (bf16x8){S0[0], S0[1], S0[2], S0[3], S1[0], S1[1], S1[2], S1[3]}, o[2], 0, 0, 0); TRRDT(S0, 1536, o[2]); TRRD(S1, 3584); x0[4] = __builtin_amdgcn_exp2f(x0[4] - mn); x1[4] -= mn; PTIE(o[2]);
    VWAIT(6, S2, S3); o[2] = __builtin_amdgcn_mfma_f32_32x32x16_bf16(pa1, (bf16x8){S2[0], S2[1], S2[2], S2[3], S3[0], S3[1], S3[2], S3[3]}, o[2], 0, 0, 0); TRRDT(S2, 5632, o[2]); TRRD(S3, 7680); x0[5] = __builtin_amdgcn_exp2f(x0[5] - mn); x1[5] -= mn; x0[6] = __builtin_amdgcn_exp2f(x0[6] - mn); x1[6] -= mn; PTIE(o[2]);
    VWAIT(6, S4, S5); o[2] = __builtin_amdgcn_mfma_f32_32x32x16_bf16(pa2, (bf16x8){S4[0], S4[1], S4[2], S4[3], S5[0], S5[1], S5[2], S5[3]}, o[2], 0, 0, 0); TRRDT(S4, 9728, o[2]); TRRD(S5, 11776); x0[7] = __builtin_amdgcn_exp2f(x0[7] - mn); x1[7] -= mn; PTIE(o[2]);
    VWAIT(6, S6, S7); o[2] = __builtin_amdgcn_mfma_f32_32x32x16_bf16(pa3, (bf16x8){S6[0], S6[1], S6[2], S6[3], S7[0], S7[1], S7[2], S7[3]}, o[2], 0, 0, 0); TRRDT(S6, 13824, o[2]); TRRD(S7, 15872); x0[8] = __builtin_amdgcn_exp2f(x0[8] - mn); x1[8] -= mn; x0[9] = __builtin_amdgcn_exp2f(x0[9] - mn); x1[9] -= mn; PTIE(o[2]);
    VWAIT(6, S0, S1); o[3] = __builtin_amdgcn_mfma_f32_32x32x16_bf16(pa0, (bf16x8){S0[0], S0[1], S0[2], S0[3], S1[0], S1[1], S1[2], S1[3]}, o[3], 0, 0, 0); x0[10] = __builtin_amdgcn_exp2f(x0[10] - mn); x1[10] -= mn; PTIE(o[3]);
    VWAIT(4, S2, S3); o[3] = __builtin_amdgcn_mfma_f32_32x32x16_bf16(pa1, (bf16x8){S2[0], S2[1], S2[2], S2[3], S3[0], S3[1], S3[2], S3[3]}, o[3], 0, 0, 0); x0[11] = __builtin_amdgcn_exp2f(x0[11] - mn); x1[11] -= mn; x0[12] = __builtin_amdgcn_exp2f(x0[12] - mn); x1[12] -= mn; PTIE(o[3]);
    VWAIT(2, S4, S5); o[3] = __builtin_amdgcn_mfma_f32_32x32x16_bf16(pa2, (bf16x8){S4[0], S4[1], S4[2], S4[3], S5[0], S5[1], S5[2], S5[3]}, o[3], 0, 0, 0); x0[13] = __builtin_amdgcn_exp2f(x0[13] - mn); x1[13] -= mn; PTIE(o[3]);
    VWAIT(0, S6, S7); o[3] = __builtin_amdgcn_mfma_f32_32x32x16_bf16(pa3, (bf16x8){S6[0], S6[1], S6[2], S6[3], S7[0], S7[1], S7[2], S7[3]}, o[3], 0, 0, 0); x0[14] = __builtin_amdgcn_exp2f(x0[14] - mn); x1[14] -= mn; x0[15] = __builtin_amdgcn_exp2f(x0[15] - mn); x1[15] -= mn; PTIE(o[3]);
#undef TRRD
#undef TRRDT
#undef VWAIT
#undef PTIE
#undef XV
}

template <class P>
__device__ __forceinline__ void attn_block(const P& p, LAS unsigned char* lds, const int tid_in, float& m_out, float& l_out) {
    int tid = tid_in; asm volatile("" : "+v"(tid));
    constexpr int DQK = P::DQK, NQF = DQK / 16, KROWB = DQK * 2, SHM_K = 64 * KROWB, KCH = DQK / 8, NKL = KCH * 64 / 512;
    const int wid = __builtin_amdgcn_readfirstlane(tid >> 6), lane = tid & 63, r32 = lane & 31, hi = lane >> 5;
    constexpr int NVB = P::DMA ? 3 : 2;
    LAS unsigned char* V_lds = lds; LAS unsigned char* K_lds = lds + NVB * SHM_V;
    LAS float* wsf = (LAS float*)(lds + NVB * SHM_V + 2 * SHM_K) + wid * 64; LAS float* li_l = wsf; LAS float* al_l = wsf + 32;
    const int NT = p.nt, row = wid * 32 + r32;
    constexpr int NQR = P::NQR;
    LAS unsigned char* qlds = lds + NVB * SHM_V + 2 * SHM_K + 2048 + wid * ((NQF - NQR) * 1024) + lane * 16;
    bf16x8 qr[NQR];
    { const bf16_t* qp = p.Q + (size_t)row * p.q_pitch + hi * 8;
#pragma unroll
      for (int d0 = 0; d0 < NQF; ++d0) { const bf16x8 v = *(const bf16x8*)(qp + d0 * 16); if (d0 < NQR) qr[d0] = v; else *(LAS bf16x8*)(qlds + (d0 - NQR) * 1024) = v; } }
    const int qm = p.pos(row) - 4 * hi;
    const int wlo = __builtin_amdgcn_readfirstlane(p.pos(wid * 32)), whi = __builtin_amdgcn_readfirstlane(p.pos(wid * 32 + 31));
    const unsigned W = (unsigned)p.W;
    float sl2 = 0.f; if constexpr (P::ALIBI) sl2 = p.slope2(row);
    float m_reg = -1e30f, l_reg = 0.f; if constexpr (P::FIXEDM) m_reg = p.mfix;
    f32x16 o[4] = {};
    const int vb0 = (int)(uintptr_t)V_lds + v_rd_base(lane);
    bf16x8 st_k[NKL], st_v0, st_v1;
#define VMW() asm volatile("s_waitcnt vmcnt(0)" ::: "memory")
#define SLOAD(t) do { int t_ = tid; asm volatile("" : "+v"(t_)); const int kb_ = p.kbase(t); const bf16_t* kp_ = p.K + (size_t)kb_ * p.k_pitch; \
        if constexpr (P::SC1) { const __amdgpu_buffer_rsrc_t kr_s = mk_rsrc(kp_); \
            _Pragma("unroll") for (int i_ = 0; i_ < NKL; ++i_) { const int id_ = t_ + 512 * i_, kr_ = id_ / KCH, kc_ = id_ - kr_ * KCH; st_k[i_] = ld_sc1(kr_s, (kr_ * p.k_pitch + kc_ * 8) * 2); } \
            if constexpr (P::PV) { const __amdgpu_buffer_rsrc_t vr_s = mk_rsrc(p.V + (size_t)kb_ * p.v_pitch); const int sr_ = t_ >> 4, sc_ = (t_ & 15) * 8; st_v0 = ld_sc1(vr_s, (sr_ * p.v_pitch + sc_) * 2); st_v1 = ld_sc1(vr_s, ((32 + sr_) * p.v_pitch + sc_) * 2); } \
        } else { \
        _Pragma("unroll") for (int i_ = 0; i_ < NKL; ++i_) { const int id_ = t_ + 512 * i_, kr_ = id_ / KCH, kc_ = id_ - kr_ * KCH; st_k[i_] = *(const bf16x8*)(kp_ + kr_ * p.k_pitch + kc_ * 8); } \
        if constexpr (P::PV) { const bf16_t* vp_ = p.V + (size_t)kb_ * p.v_pitch; const int sr_ = t_ >> 4, sc_ = (t_ & 15) * 8; st_v0 = *(const bf16x8*)(vp_ + sr_ * p.v_pitch + sc_); st_v1 = *(const bf16x8*)(vp_ + (32 + sr_) * p.v_pitch + sc_); } } } while (0)
#define SWRITE(bf) do { int t_ = tid; asm volatile("" : "+v"(t_)); \
        _Pragma("unroll") for (int i_ = 0; i_ < NKL; ++i_) { const int id_ = t_ + 512 * i_, kr_ = id_ / KCH, kc_ = id_ - kr_ * KCH; *(LAS bf16x8*)(K_lds + (bf) * SHM_K + kr_ * KROWB + ((kc_ * 16) ^ (kswz<DQK>(kr_) << 4))) = st_k[i_]; } \
        if constexpr (P::PV) { const int sr_ = t_ >> 4, sc_ = (t_ & 15) * 8; *(LAS bf16x8*)(V_lds + (bf) * SHM_V + v_st(sr_, sc_)) = st_v0; *(LAS bf16x8*)(V_lds + (bf) * SHM_V + v_st(32 + sr_, sc_)) = st_v1; } } while (0)
#define RESC(a) do { if constexpr (P::PV && !P::FIXEDM) { if (__any((a) < 1.f)) { if (hi == 0) al_l[r32] = (a); asm volatile("s_waitcnt lgkmcnt(0)" ::: "memory"); \
        _Pragma("unroll") for (int d_ = 0; d_ < 4; ++d_) _Pragma("unroll") for (int r = 0; r < 16; ++r) o[d_][r] *= al_l[crow(r, hi)]; } } } while (0)
#define ACT(t) (!P::SK || (p.kbase(t) <= whi && p.kbase(t) + 63 >= wlo - (int)W + 1 && (!P::SEL || p.sel_wave(wid, (t)))))
#define MASKT(P0_, P1_, t) do { const int kb_ = p.kbase(t); if (ACT(t)) { if constexpr (P::ALIBI) bias_tile(P0_, P1_, qm - kb_, sl2); \
        if (kb_ + 63 > wlo || kb_ <= whi - (int)W) mask_tile(P0_, P1_, qm - kb_, W); \
        if constexpr (P::SEL) { if (!p.sel_row(row, (t))) { const float NEG_ = -__builtin_inff(); _Pragma("unroll") for (int r = 0; r < 16; ++r) { P0_[r] = NEG_; P1_[r] = NEG_; } } } } } while (0)
#define FINISH(PY0, PY1, alY, t) do { finishSM_exp(PY0, PY1, alY, l_reg); p.hook(PY0, PY1, p.kbase(t), lane, ACT(t)); if constexpr (P::PV) finishSM_pack(PY0, PY1, pa0, pa1, pa2, pa3); } while (0)
#define PVT(VB, t) do { if constexpr (P::PV) pv_tile<VB>(o, vb0, pa0, pa1, pa2, pa3, ACT(t)); } while (0)
    f32x16 pA0, pA1, pB0, pB1; float mnA, mnB, alA, alB; bf16x8 pa0, pa1, pa2, pa3;
    if constexpr (P::DMA) {
    unsigned kvo[NKL], vvo[2];
#pragma unroll
    for (int i_ = 0; i_ < NKL; ++i_) { const int ci = tid + 512 * i_, kr_ = ci / KCH, pc_ = ci - kr_ * KCH, kc_ = pc_ ^ kswz<DQK>(kr_); kvo[i_] = (unsigned)((kr_ * p.k_pitch + kc_ * 8) * 2); }
#pragma unroll
    for (int j_ = 0; j_ < 2; ++j_) { const int ci = tid + 512 * j_, kk = ((ci >> 7) << 3) | ((ci & 31) >> 2), k_ = (kk & ~0xC) | ((kk & 4) << 1) | ((kk & 8) >> 1), c_ = ((ci >> 5) & 3) * 32 + (ci & 3) * 8;
        vvo[j_] = (unsigned)((k_ * p.v_pitch + c_) * 2); }
#define DMAT(t, KS, VS) do { const int kb_ = p.kbase(t); const char* kp_ = (const char*)(p.K + (size_t)kb_ * p.k_pitch); const char* vp_ = (const char*)(p.V + (size_t)kb_ * p.v_pitch); \
        _Pragma("unroll") for (int i_ = 0; i_ < NKL; ++i_) __builtin_amdgcn_global_load_lds((const unsigned*)(kp_ + kvo[i_]), (LAS unsigned*)(K_lds + (KS) * SHM_K + (i_ * 8 + wid) * 1024), 16, 0, 0); \
        _Pragma("unroll") for (int j_ = 0; j_ < 2; ++j_) __builtin_amdgcn_global_load_lds((const unsigned*)(vp_ + vvo[j_]), (LAS unsigned*)(V_lds + (VS) * SHM_V + (j_ * 8 + wid) * 1024), 16, 0, 0); } while (0)
#define PVR(vs, t) do { pv_tile<0>(o, vb0 + (vs) * SHM_V, pa0, pa1, pa2, pa3, ACT(t)); } while (0)
    DMAT(0, 0, 0); VMW(); __syncthreads();
    if (NT > 1) DMAT(1, 1, 1);
    SBAR(); qkt<0, DQK, NQR>(pA0, pA1, K_lds, r32, hi, qr, qlds, ACT(0)); SBAR();
    MASKT(pA0, pA1, 0); partialSM<P::FIXEDM>(pA0, pA1, m_reg, mnA, alA);
    VMW(); __syncthreads();
    int vr = 0;
#define DSTEP(PX0, PX1, mnX, alX, PY0, PY1, alY, t, KB) do { \
        const int tn_ = (t) + 1 < NT ? (t) + 1 : NT - 1, kbn_ = p.kbase(tn_), vw_ = vr == 0 ? 2 : vr - 1;        \
        const char* kpn_ = (const char*)(p.K + (size_t)kbn_ * p.k_pitch); const char* vpn_ = (const char*)(p.V + (size_t)kbn_ * p.v_pitch); \
        auto dm_ = [&](int f_) { _Pragma("unroll") for (int k_ = 0; k_ < NKL + 2; ++k_) if (f_ == (k_ * (DQK / 8)) / (NKL + 2) + 1) { \
            if (k_ < NKL) __builtin_amdgcn_global_load_lds((const unsigned*)(kpn_ + kvo[k_ < NKL ? k_ : 0]), (LAS unsigned*)(K_lds + ((KB) ^ 1) * SHM_K + (k_ * 8 + wid) * 1024), 16, 0, 0); \
            else __builtin_amdgcn_global_load_lds((const unsigned*)(vpn_ + vvo[k_ < NKL ? 0 : k_ - NKL]), (LAS unsigned*)(V_lds + vw_ * SHM_V + ((k_ - NKL) * 8 + wid) * 1024), 16, 0, 0); } }; \
        qkt_fin<KB, DQK>(PX0, PX1, K_lds, r32, hi, qr, ACT(t), PY0, PY1, alY, l_reg, pa0, pa1, pa2, pa3, dm_); \
        MASKT(PX0, PX1, (t)); pv_sm(o, vb0 + vr * SHM_V, pa0, pa1, pa2, pa3, ACT((t) - 1), PX0, PX1, m_reg, mnX, alX); RESC(alX); \
        vr = vr == 2 ? 0 : vr + 1; \
        VMW(); __syncthreads(); } while (0)
    for (int t = 1; t + 1 < NT; t += 2) {
        DSTEP(pB0, pB1, mnB, alB, pA0, pA1, alA, t, 1);
        DSTEP(pA0, pA1, mnA, alA, pB0, pB1, alB, t + 1, 0);
    }
    const bool even = (NT & 1) == 0;
    if (even) { SBAR(); qkt<1, DQK, NQR>(pB0, pB1, K_lds, r32, hi, qr, qlds, ACT(NT - 1)); SBAR(); }
    FINISH(pA0, pA1, alA, even ? NT - 2 : NT - 1); SBAR();
    PVR(vr, even ? NT - 2 : NT - 1);
    if (even) { MASKT(pB0, pB1, NT - 1); partialSM<P::FIXEDM>(pB0, pB1, m_reg, mnB, alB); RESC(alB);
        FINISH(pB0, pB1, alB, NT - 1); SBAR(); PVR(vr == 2 ? 0 : vr + 1, NT - 1); }
#undef DMAT
#undef PVR
#undef DSTEP
    } else {
    SLOAD(0); VMW(); SWRITE(0);
    if (NT > 1) SLOAD(1);
    __syncthreads();
    SBAR(); qkt<0, DQK, NQR>(pA0, pA1, K_lds, r32, hi, qr, qlds, ACT(0));
    MASKT(pA0, pA1, 0); partialSM<P::FIXEDM>(pA0, pA1, m_reg, mnA, alA);
    if (NT > 1) { VMW(); SWRITE(1); }
    __syncthreads();
#define HALF_STEP(PX0, PX1, mnX, alX, PY0, PY1, alY, t, KB, VB, SB) do { \
        SBAR(); if constexpr (NQR == NQF && P::PV) { qkt_fin<KB, DQK>(PX0, PX1, K_lds, r32, hi, qr, ACT(t), PY0, PY1, alY, l_reg, pa0, pa1, pa2, pa3); } \
        else { qkt<KB, DQK, NQR>(PX0, PX1, K_lds, r32, hi, qr, qlds, ACT(t)); FINISH(PY0, PY1, alY, (t) - 1); } SBAR(); \
        if ((t) + 1 < NT) { SLOAD((t) + 1); SBAR(); } \
        PVT(VB, (t) - 1); MASKT(PX0, PX1, (t)); partialSM<P::FIXEDM>(PX0, PX1, m_reg, mnX, alX); \
        __syncthreads(); \
        if ((t) + 1 < NT) { VMW(); SWRITE(SB); } \
        RESC(alX); __syncthreads(); } while (0)
    for (int t = 1; t + 1 < NT; t += 2) {
        HALF_STEP(pB0, pB1, mnB, alB, pA0, pA1, alA, t, 1, 0, 0);
        HALF_STEP(pA0, pA1, mnA, alA, pB0, pB1, alB, t + 1, 0, 1, 1);
    }
    const bool even = (NT & 1) == 0;
    if (even) { SBAR(); qkt<1, DQK, NQR>(pB0, pB1, K_lds, r32, hi, qr, qlds, ACT(NT - 1)); SBAR(); }
    FINISH(pA0, pA1, alA, even ? NT - 2 : NT - 1); SBAR();
    PVT(0, even ? NT - 2 : NT - 1);
    if (even) { MASKT(pB0, pB1, NT - 1); partialSM<P::FIXEDM>(pB0, pB1, m_reg, mnB, alB); RESC(alB);
        FINISH(pB0, pB1, alB, NT - 1); SBAR(); PVT(1, NT - 1); }
    }
    m_out = m_reg; l_out = l_reg;
    p.store(o, l_reg, m_reg, li_l, wid, lane, r32, hi);
    __syncthreads();
#undef VMW
#undef SLOAD
#undef SWRITE
#undef RESC
#undef ACT
#undef MASKT
#undef FINISH
#undef PVT
#undef HALF_STEP
}

struct PolBase {
    static constexpr bool DMA = false;
    const bf16_t* Q; const bf16_t* K; const bf16_t* V; int q_pitch, k_pitch, v_pitch; int nt, j0, P0, W; float mfix;
    __device__ __forceinline__ int kbase(int t) const { return (j0 + t) * 64; }
    __device__ __forceinline__ void hook(const f32x16&, const f32x16&, int, int, bool) const {}
    __device__ __forceinline__ bool sel_row(int, int) const { return true; }
    __device__ __forceinline__ bool sel_wave(int, int) const { return true; }
};
struct PolMLA : PolBase {
    static constexpr int DQK = 192, NQR = 12; static constexpr bool ALIBI = false, SK = false, SEL = false, FIXEDM = false, PV = true, SC1 = false, DMA = true;
    bf16_t* O; int o_pitch;
    __device__ __forceinline__ int pos(int row) const { return P0 + row; }
    __device__ __forceinline__ float slope2(int) const { return 0.f; }
    __device__ __forceinline__ void store(const f32x16 (&o)[4], float l_reg, float, LAS float* li_l, int wid, int lane, int r32, int hi) const {
        asm volatile("" : "+v"(r32), "+v"(hi));
        if (hi == 0) li_l[r32] = l_reg; asm volatile("s_waitcnt lgkmcnt(0)" ::: "memory");
        bf16_t* Ow = O + (size_t)(wid * 32) * o_pitch;
#pragma unroll
        for (int r = 0; r < 16; ++r) { const int orow = crow(r, hi); const float rl = __builtin_amdgcn_rcpf(li_l[orow]);
#pragma unroll
            for (int d0 = 0; d0 < 4; ++d0) { const float v = o[d0][r] * rl; const float vn = shx(v, 1, hi * 32 + r32);
                if ((r32 & 1) == 0) *(unsigned*)(Ow + (size_t)orow * o_pitch + d0 * 32 + r32) = cvt_pk_bf16(v, vn); } }
    }
};

__device__ __forceinline__ float alibi_slope(int i) { return __builtin_amdgcn_exp2f(-0.8f * (float)i); }
__device__ __forceinline__ float dpp_xor1(float v) { return __int_as_float(__builtin_amdgcn_update_dpp(0, __float_as_int(v), 0xB1, 0xF, 0xF, true)); }
__device__ __forceinline__ float dpp_xor2(float v) { return __int_as_float(__builtin_amdgcn_update_dpp(0, __float_as_int(v), 0x4E, 0xF, 0xF, true)); }

struct PolDil : PolBase {
    static constexpr int DQK = 128, NQR = 8; static constexpr bool ALIBI = true, SK = true, SEL = false, FIXEDM = false, PV = true, SC1 = false, DMA = DIL_DMA;
    bf16_t* O; int o_pitch; float* LSE; int lse_pitch; float sl2;
    __device__ __forceinline__ int pos(int row) const { return P0 + row; }
    __device__ __forceinline__ float slope2(int) const { return sl2; }
    __device__ __forceinline__ void store(const f32x16 (&o)[4], float l_reg, float m_reg, LAS float* li_l, int wid, int lane, int r32, int hi) const {
        asm volatile("" : "+v"(r32), "+v"(hi));
        if (hi == 0) { li_l[r32] = l_reg; LSE[(size_t)(wid * 32 + r32) * lse_pitch] = (m_reg + __builtin_amdgcn_logf(l_reg)) * 0.6931471805599453f; }
        asm volatile("s_waitcnt lgkmcnt(0)" ::: "memory");
        bf16_t* Ow = O + (size_t)(wid * 32) * o_pitch;
#pragma unroll
        for (int r = 0; r < 16; ++r) { const int orow = crow(r, hi); const float rl = __builtin_amdgcn_rcpf(li_l[orow]);
#pragma unroll
            for (int d0 = 0; d0 < 4; ++d0) { const float v = o[d0][r] * rl; const float vn = shx(v, 1, hi * 32 + r32);
                if ((r32 & 1) == 0) *(unsigned*)(Ow + (size_t)orow * o_pitch + d0 * 32 + r32) = cvt_pk_bf16(v, vn); } }
    }
};
struct PolNsaBase : PolBase {
    static constexpr int DQK = 128, NQR = 6;
    int t0;
    __device__ __forceinline__ float slope2(int row) const { return alibi_slope(7 + (row & 3)) * 1.4426950408889634f; }
};
struct PolCmp1 : PolNsaBase {
    static constexpr bool ALIBI = true, SK = false, SEL = false, FIXEDM = false, PV = false, SC1 = false;
    __device__ __forceinline__ int pos(int row) const { return (t0 + (row >> 2) - 31) >> 4; }
    __device__ __forceinline__ float slope2(int row) const { return 16.0f * PolNsaBase::slope2(row); }
    __device__ __forceinline__ void store(const f32x16 (&)[4], float, float, LAS float*, int, int, int, int) const {}
};
template <int BR>
__device__ __forceinline__ void nsa_store(const f32x16 (&o)[4], float l_reg, LAS float* li_l, int wid, int r32, int hi, const float* gates  , float* nsaf  , bf16_t* ocat  ) {
    asm volatile("" : "+v"(r32), "+v"(hi));
    if (hi == 0) { const int row = wid * 32 + r32; const float g = gates[(size_t)(row >> 2) * 16 + (row & 3) * 3 + BR];
        li_l[r32] = BR == 0 ? g : (l_reg > 0.f ? g * __builtin_amdgcn_rcpf(l_reg) : 0.f); }
    asm volatile("s_waitcnt lgkmcnt(0)" ::: "memory");
#pragma unroll
    for (int r = 0; r < 16; ++r) { const int grow = wid * 32 + crow(r, hi); const float f = li_l[crow(r, hi)];
#pragma unroll
        for (int d0 = 0; d0 < 4; ++d0) { float v = o[d0][r] * f; float* np = nsaf + (size_t)grow * 128 + d0 * 32 + r32;
            if (BR == 0) *np = v;
            else if (BR == 1) *np += v;
            else { v += *np; const float vn = shx(v, 1, hi * 32 + r32);
                if ((r32 & 1) == 0) *(unsigned*)(ocat + (size_t)(grow >> 2) * DM + (grow & 3) * 128 + d0 * 32 + r32) = cvt_pk_bf16(v, vn); } } }
}
struct PolCmp2 : PolNsaBase {
    static constexpr bool ALIBI = true, SK = false, SEL = false, FIXEDM = true, PV = true, SC1 = false;
    LAS float* score; const float* gates; float* nsaf; int wid_;
    __device__ __forceinline__ int pos(int row) const { return (t0 + (row >> 2) - 31) >> 4; }
    __device__ __forceinline__ float slope2(int row) const { return 16.0f * PolNsaBase::slope2(row); }
    __device__ __forceinline__ void hook(const f32x16& p0, const f32x16& p1, int kb, int lane, bool) const {
        const int r32 = lane & 31, hi = lane >> 5; LAS float* sc = score + (wid_ * 8 + (r32 >> 2)) * 256 + (kb >> 2) + hi;
        asm volatile("s_waitcnt lgkmcnt(0)" ::: "memory");
#pragma unroll
        for (int g = 0; g < 4; ++g) {
            float a = (p0[4 * g] + p0[4 * g + 1]) + (p0[4 * g + 2] + p0[4 * g + 3]), b = (p1[4 * g] + p1[4 * g + 1]) + (p1[4 * g + 2] + p1[4 * g + 3]);
            a += dpp_xor1(a); a += dpp_xor2(a); b += dpp_xor1(b); b += dpp_xor2(b);
            if ((r32 & 3) == 0) { sc[2 * g] += a; sc[8 + 2 * g] += b; } }
        asm volatile("s_waitcnt lgkmcnt(0)" ::: "memory");
#pragma unroll
        for (int g = 0; g < 4; ++g) {
            float ea = p0[4 * g + 3], eb = p1[4 * g + 3];
            ea += dpp_xor1(ea); ea += dpp_xor2(ea); eb += dpp_xor1(eb); eb += dpp_xor2(eb);
            if ((r32 & 3) == 0) { sc[2 * g + 1] += ea; if ((kb >> 2) + hi + 8 + 2 * g + 1 < 256) sc[8 + 2 * g + 1] += eb; } }
    }
    __device__ __forceinline__ void store(const f32x16 (&o)[4], float l_reg, float, LAS float* li_l, int wid, int, int r32, int hi) const { nsa_store<0>(o, l_reg, li_l, wid, r32, hi, gates, nsaf, nullptr); }
};
struct PolSlc : PolNsaBase {
    static constexpr bool ALIBI = true, SK = true, SEL = true, FIXEDM = false, PV = true, SC1 = true;
    LAS const int* tlist; LAS const unsigned* selm  ; LAS const unsigned* wunion  ; const float* gates; float* nsaf;
    __device__ __forceinline__ int kbase(int t) const { return __builtin_amdgcn_readfirstlane(tlist[t]) * 64; }
    __device__ __forceinline__ int pos(int row) const { return t0 + (row >> 2); }
    __device__ __forceinline__ bool sel_wave(int wid, int t) const { const int j = __builtin_amdgcn_readfirstlane(tlist[t]); return (__builtin_amdgcn_readfirstlane(wunion[wid * 8 + (j >> 5)]) >> (j & 31)) & 1u; }
    __device__ __forceinline__ bool sel_row(int row, int t) const { const int j = __builtin_amdgcn_readfirstlane(tlist[t]); return (selm[(row >> 2) * 8 + (j >> 5)] >> (j & 31)) & 1u; }
    __device__ __forceinline__ void store(const f32x16 (&o)[4], float l_reg, float, LAS float* li_l, int wid, int, int r32, int hi) const { nsa_store<1>(o, l_reg, li_l, wid, r32, hi, gates, nsaf, nullptr); }
};
struct PolWin : PolNsaBase {
    static constexpr bool ALIBI = true, SK = true, SEL = false, FIXEDM = false, PV = true, SC1 = true;
    const float* gates; float* nsaf; bf16_t* ocat;
    __device__ __forceinline__ int pos(int row) const { return t0 + (row >> 2); }
    __device__ __forceinline__ void store(const f32x16 (&o)[4], float l_reg, float, LAS float* li_l, int wid, int, int r32, int hi) const { nsa_store<2>(o, l_reg, li_l, wid, r32, hi, gates, nsaf, ocat); }
};

constexpr int NSA_SCORE_OFF = 83968, NSA_SEL_OFF = NSA_SCORE_OFF + 65536, NSA_WUN_OFF = NSA_SEL_OFF + 2048, NSA_UNI_OFF = NSA_WUN_OFF + 256, NSA_TL_OFF = NSA_UNI_OFF + 64, NSA_END = NSA_TL_OFF + 1028;
static_assert(NSA_END <= 159744, "NSA LDS map");
struct NsaBufs { const bf16_t* NQ; const bf16_t* NKV; const bf16_t* KC; const bf16_t* VC; const float* GATES; float* NSAF; bf16_t* OCAT; };
__device__ __forceinline__ void nsa_unit(const NsaBufs& nb, int b, int t0, LAS unsigned char* lds, const int tid_in) {
    int tid = tid_in; asm volatile("" : "+v"(tid));
    const int wid = __builtin_amdgcn_readfirstlane(tid >> 6), lane = tid & 63;
    LAS float* score = (LAS float*)(lds + NSA_SCORE_OFF); LAS unsigned* selm = (LAS unsigned*)(lds + NSA_SEL_OFF); LAS unsigned* wun = (LAS unsigned*)(lds + NSA_WUN_OFF);
    LAS unsigned* uni = (LAS unsigned*)(lds + NSA_UNI_OFF); LAS int* tl = (LAS int*)(lds + NSA_TL_OFF);
    const size_t tok0 = (size_t)b * SEQ + t0;
    const float* gates = nb.GATES + tok0 * 16; float* nsaf = nb.NSAF + tok0 * 512; const bf16_t* Q = nb.NQ + tok0 * 512;
    for (int e = tid; e < 64 * 256; e += 512) score[e] = 0.f;
    __syncthreads();
    const int maxc = (t0 + 32) >> 4, ntc = (maxc >> 6) + 1;
    float m1, l1;
    { PolCmp1 p; p.Q = Q; p.q_pitch = 128; p.K = nb.KC + (size_t)b * 1024 * 128; p.k_pitch = 128; p.V = nullptr; p.v_pitch = 0; p.nt = ntc; p.j0 = 0; p.P0 = 0; p.W = 0x40000000; p.mfix = 0.f; p.t0 = t0;
      attn_block(p, lds, tid, m1, l1); }
    { PolCmp2 p; p.Q = Q; p.q_pitch = 128; p.K = nb.KC + (size_t)b * 1024 * 128; p.k_pitch = 128; p.V = nb.VC + (size_t)b * 1024 * 128; p.v_pitch = 128; p.nt = ntc; p.j0 = 0; p.P0 = 0; p.W = 0x40000000; p.t0 = t0;
      p.mfix = l1 > 0.f ? m1 + __builtin_amdgcn_logf(l1) : 1e30f; p.score = score; p.gates = gates; p.nsaf = nsaf; p.wid_ = wid;
      float m2, l2; attn_block(p, lds, tid, m2, l2); }
    {
        asm volatile("s_waitcnt lgkmcnt(0)" ::: "memory");
        unsigned key[8][4], sel[8];
        const int curb = (t0 + wid * 8) >> 6;
#pragma unroll
        for (int k = 0; k < 8; ++k) { sel[k] = 0u;
#pragma unroll
            for (int q = 0; q < 4; ++q) { const int j = lane + 64 * q; const float sv = score[(wid * 8 + k) * 256 + j];
                key[k][q] = (j >= 1 && j <= curb - 2) ? ((__float_as_uint(sv) & 0xFFFFFF00u) | (unsigned)(255 - j)) : 0u; } }
        if (curb >= 3) {
            for (int it = 0; it < 13; ++it) {
                unsigned best[8], wm[8]; int bq[8];
#pragma unroll
                for (int k = 0; k < 8; ++k) { best[k] = key[k][0]; bq[k] = 0;
#pragma unroll
                    for (int q = 1; q < 4; ++q) if (key[k][q] > best[k]) { best[k] = key[k][q]; bq[k] = q; }
                    wm[k] = best[k]; }
#pragma unroll
                for (int of = 1; of < 64; of <<= 1) {
#pragma unroll
                    for (int k = 0; k < 8; ++k) { const unsigned o_ = shxu(wm[k], of, lane); wm[k] = o_ > wm[k] ? o_ : wm[k]; } }
                unsigned any = 0u;
#pragma unroll
                for (int k = 0; k < 8; ++k) { any |= wm[k];
                    if (best[k] == wm[k] && wm[k] != 0u) { sel[k] |= 1u << bq[k];
#pragma unroll
                        for (int q = 0; q < 4; ++q) if (q == bq[k]) key[k][q] = 0u; } }
                if (__builtin_amdgcn_readfirstlane(any) == 0u) break;
            }
        }
        unsigned long long wuni[4] = {0ull, 0ull, 0ull, 0ull};
#pragma unroll
        for (int k = 0; k < 8; ++k) { const int tokl = wid * 8 + k;
#pragma unroll
            for (int q = 0; q < 4; ++q) { const int j = lane + 64 * q; const bool on = ((sel[k] >> q) & 1u) || j == 0 || j == curb || j == curb - 1;
                const unsigned long long bm = __ballot(on); wuni[q] |= bm;
                if (lane == 0) { selm[tokl * 8 + 2 * q] = (unsigned)bm; selm[tokl * 8 + 2 * q + 1] = (unsigned)(bm >> 32); } } }
        if (lane == 0) {
#pragma unroll
            for (int q = 0; q < 4; ++q) { wun[wid * 8 + 2 * q] = (unsigned)wuni[q]; wun[wid * 8 + 2 * q + 1] = (unsigned)(wuni[q] >> 32); } }
    }
    __syncthreads();
    if (tid < 8) { unsigned u = 0u; for (int w = 0; w < 8; ++w) u |= wun[w * 8 + tid]; uni[tid] = u; }
    __syncthreads();
    int nts = 0;
    { unsigned pre = 0u;
#pragma unroll
      for (int w = 0; w < 8; ++w) { const unsigned u = uni[w]; if (tid < 256 && w < (tid >> 5)) pre += __builtin_popcount(u); nts += __builtin_popcount(u); }
      if (tid < 256) { const unsigned u = uni[tid >> 5]; if ((u >> (tid & 31)) & 1u) tl[pre + __builtin_popcount(u & ((1u << (tid & 31)) - 1u))] = tid; } }
    nts = __builtin_amdgcn_readfirstlane(nts);
    __syncthreads();
    { PolSlc p; p.Q = Q; p.q_pitch = 128; p.K = nb.NKV + 2 * ((size_t)M * 128) + (size_t)b * SEQ * 128; p.k_pitch = 128; p.V = nb.NKV + 3 * ((size_t)M * 128) + (size_t)b * SEQ * 128; p.v_pitch = 128;
      p.nt = nts; p.j0 = 0; p.P0 = 0; p.W = 0x40000000; p.mfix = 0.f; p.t0 = t0; p.tlist = tl; p.selm = selm; p.wunion = wun; p.gates = gates; p.nsaf = nsaf;
      float m_, l_; attn_block(p, lds, tid, m_, l_); }
    { PolWin p; p.Q = Q; p.q_pitch = 128; p.K = nb.NKV + 4 * ((size_t)M * 128) + (size_t)b * SEQ * 128; p.k_pitch = 128; p.V = nb.NKV + 5 * ((size_t)M * 128) + (size_t)b * SEQ * 128; p.v_pitch = 128;
      const int jl = (t0 >> 6) - 8 > 0 ? (t0 >> 6) - 8 : 0; p.j0 = jl; p.nt = (t0 >> 6) - jl + 1; p.P0 = 0; p.W = 512; p.mfix = 0.f; p.t0 = t0; p.gates = gates; p.nsaf = nsaf; p.ocat = nb.OCAT + tok0 * DM + 1536;
      float m_, l_; attn_block(p, lds, tid, m_, l_); }
}
}

constexpr size_t WS_CTL = 0, CTL_ZERO_BYTES = 1u << 20;
constexpr size_t SZ_W1 = (size_t)NFF * DM * 2, SZ_W2 = (size_t)DM * FF * 2, SZ_WM = (size_t)NMIX * DM * 2, SZ_WU = (size_t)NUP * 512 * 2, SZ_WO = (size_t)DM * DM * 2, SZ_WC = (size_t)256 * 4096 * 2;
constexpr size_t LW_W1A = 0, LW_W2A = LW_W1A + SZ_W1, LW_W1B = LW_W2A + SZ_W2, LW_W2B = LW_W1B + SZ_W1, LW_WM = LW_W2B + SZ_W2, LW_WU = LW_WM + SZ_WM, LW_WO = LW_WU + SZ_WU,
                 LW_WCK = LW_WO + SZ_WO, LW_WCV = LW_WCK + SZ_WC, LW_SIZE = LW_WCV + SZ_WC;
constexpr size_t WS_W = CTL_ZERO_BYTES;
constexpr size_t WS_XB = WS_W + DEPTH * LW_SIZE;
constexpr size_t WS_SS = WS_XB + (size_t)M * DM * 2;
constexpr size_t WS_ROPE = WS_SS + (size_t)M * 32 * 4;
constexpr size_t WS_CB = WS_ROPE + (size_t)SEQ * 32 * 2 * 4;
constexpr size_t WS_BIG = WS_CB + 4096;
constexpr size_t WS_HID = WS_BIG;
constexpr size_t OV_LAT = 0, OV_LATSS = OV_LAT + (size_t)M * LATW * 2, OV_DQ = OV_LATSS + (size_t)M * 16 * 4, OV_DK = OV_DQ + (size_t)M * 768 * 2, OV_DV = OV_DK + (size_t)M * 768 * 2,
                 OV_NQ = OV_DV + (size_t)M * 768 * 2, OV_NKV = OV_NQ + (size_t)M * 512 * 2, OV_GATES = OV_NKV + 6 * (size_t)M * 128 * 2 + 65536, OV_MQ = OV_GATES + (size_t)DEPTH * M * 16 * 4,
                 OV_MK = OV_MQ + (size_t)M * 1152 * 2, OV_MV = OV_MK + (size_t)M * 1152 * 2, OV_END = OV_MV + (size_t)M * 768 * 2;
constexpr size_t BIG_BYTES = OV_END > (size_t)M * FF * 2 ? OV_END : (size_t)M * FF * 2;
constexpr size_t WS_OCAT = WS_BIG + BIG_BYTES;
constexpr size_t WS_DLSE = WS_OCAT + (size_t)M * DM * 2;
constexpr size_t WS_KC = WS_DLSE + (size_t)DEPTH * M * 8 * 4;
constexpr size_t WS_H1 = WS_KC + (size_t)DEPTH * 2 * 2048 * 128 * 2;
constexpr size_t WS_NSAF = WS_H1 + (size_t)DEPTH * 2 * 2048 * 128 * 2;
constexpr size_t WS_END_V1 = WS_NSAF + (size_t)M * 512 * 4;
static_assert(WS_END_V1 <= 1610670080ull, "d_ws map too large");
static_assert(OV_DK == OV_DQ + (size_t)M * 768 * 2 && OV_DV == OV_DK + (size_t)M * 768 * 2, "DQ|DK|DV contiguous");

constexpr int CW_CHAIN = 32768;
constexpr int CW_BAR = 4096, CW_QUEUE = 8192;
constexpr int RING_BYTES = 131072, LDSCTL_OFF = 159744, MISC_OFF = LDSCTL_OFF + 320, LDS_BYTES = 163840;

#define XB_TMO      128
#define XB_XCNT(j)  (256  + 64 * (j))
#define XB_XSUB(j)  (1280 + 64 * (j))
#define XB_XGEN(j)  (2304 + 64 * (j))
#define XB_TOP      3328
#define XB_TOPGEN   3392
#define XCD_BAR_WORDS 3456
#define XB_SPIN_CAP (1u << 18)
__device__ __forceinline__ unsigned xb_ld(unsigned* p)              { return __hip_atomic_load(p, __ATOMIC_RELAXED, __HIP_MEMORY_SCOPE_AGENT); }
__device__ __forceinline__ unsigned xb_add(unsigned* p, unsigned v) { return __hip_atomic_fetch_add(p, v, __ATOMIC_RELAXED, __HIP_MEMORY_SCOPE_AGENT); }
__device__ __forceinline__ unsigned xb_xcc_id() { return (unsigned)__builtin_amdgcn_s_getreg((3 << 11) | 20) & 0xFu; }
#define XB_SPIN(cond, bar) do { unsigned _sp = 0; while (cond) { __builtin_amdgcn_s_sleep(1); \
    if ((++_sp & 255u) == 0u) { if (xb_ld(&(bar)[XB_TMO])) break; if (_sp > XB_SPIN_CAP) { atomicAdd(&(bar)[XB_TMO], 1u); break; } } } } while (0)
struct XcdBarrier { unsigned* bar; unsigned x; volatile LAS unsigned* st; };
__device__ __forceinline__ XcdBarrier xcd_barrier_post(unsigned* bar, volatile LAS unsigned* st) {
    XcdBarrier b; b.bar = bar; b.x = xb_xcc_id(); b.st = st;
    if (threadIdx.x == 0) (void)xb_add(&bar[XB_XCNT(b.x)], 1u);
    return b;
}
__device__ __forceinline__ void xcd_barrier_complete(unsigned* bar, unsigned x, unsigned& nloc, unsigned& nx) {
    const unsigned G = gridDim.x * gridDim.y * gridDim.z;
    unsigned sum, cnt, mine, sp = 0u;
    for (;;) {
        sum = 0u; cnt = 0u; mine = 0u;
#pragma unroll
        for (unsigned j = 0; j < 16; ++j) { const unsigned c = xb_ld(&bar[XB_XCNT(j)]); sum += c; cnt += (c > 0u) ? 1u : 0u; mine = (j == x) ? c : mine; }
        if (sum == G) break;
        __builtin_amdgcn_s_sleep(1);
        if ((++sp & 255u) == 0u) { if (xb_ld(&bar[XB_TMO])) break; if (sp > XB_SPIN_CAP) { atomicAdd(&bar[XB_TMO], 1u); break; } }
    }
    nloc = mine > 0u ? mine : 1u; nx = cnt > 0u ? cnt : 1u;
}
__device__ __forceinline__ void xcd_barrier(const XcdBarrier& b, const int tid0) {
    asm volatile("s_waitcnt vmcnt(0)" ::: "memory");
    __syncthreads();
    if (tid0 == 0) {
        unsigned* bar = b.bar; asm volatile("" : "+s"(bar));
        unsigned bx = b.x; asm volatile("" : "+s"(bx));
        __builtin_amdgcn_s_waitcnt(0);
        unsigned nloc = b.st[0], nx = b.st[1];
        if (nloc == 0u) { xcd_barrier_complete(bar, bx, nloc, nx); b.st[0] = nloc; b.st[1] = nx; }
        const unsigned old = xb_add(&bar[XB_XSUB(bx)], 1u);
        const unsigned gen = old / nloc;
        if (old + 1u == (gen + 1u) * nloc) {
            __builtin_amdgcn_fence(__ATOMIC_RELEASE, "agent");
            asm volatile("s_waitcnt vmcnt(0)" ::: "memory");
            const unsigned og = xb_add(&bar[XB_TOP], 1u);
            const unsigned tg = og / nx;
            if (og + 1u == (tg + 1u) * nx) xb_add(&bar[XB_TOPGEN], 1u);
            else XB_SPIN(xb_ld(&bar[XB_TOPGEN]) == tg, bar);
            __builtin_amdgcn_fence(__ATOMIC_ACQUIRE, "agent");
            xb_add(&bar[XB_XGEN(bx)], 1u);
            asm volatile("s_waitcnt vmcnt(0)" ::: "memory");
        } else {
            XB_SPIN(xb_ld(&bar[XB_XGEN(bx)]) == gen, bar);
            __builtin_amdgcn_fence(__ATOMIC_ACQUIRE, "agent");
            asm volatile("s_waitcnt vmcnt(0)" ::: "memory");
        }
    }
    __syncthreads();
}

#define XL_OFF      (16384 - CW_BAR)
#define XL_SUB(j)   (XL_OFF + 64 * (j))
#define XL_GEN(j)   (XL_OFF + 1024 + 64 * (j))
#define XL_MM       (XL_OFF + 2048)
__device__ __forceinline__ void xcd_local_barrier(const XcdBarrier& b, const int tid0) {
    asm volatile("s_waitcnt vmcnt(0)" ::: "memory");
    __syncthreads();
    if (tid0 == 0) {
        unsigned* bar = b.bar; const unsigned bx = b.x;
        __builtin_amdgcn_s_waitcnt(0);
        const unsigned nloc = b.st[0];
        const unsigned old = xb_add(&bar[XL_SUB(bx)], 1u);
        const unsigned gen = old / nloc;
        if (old + 1u == (gen + 1u) * nloc) xb_add(&bar[XL_GEN(bx)], 1u);
        else XB_SPIN(xb_ld(&bar[XL_GEN(bx)]) == gen, bar);
        asm volatile("buffer_inv sc0\n\ts_waitcnt vmcnt(0)" ::: "memory");
    }
    __syncthreads();
}

struct Args { const float* in[20]; float* out; unsigned char* ws; };

struct MapId { int N; __device__ __forceinline__ int operator()(int n) const { return n < N ? n : -1; } };
struct MapSwiglu { __device__ __forceinline__ int operator()(int n) const { const int pn = n >> 8, j = n & 255; return j < 128 ? pn * 128 + j : FF + pn * 128 + (j - 128); } };
struct MapMix { __device__ __forceinline__ int operator()(int n) const {
    if (n < 1024) return n;
    if (n < 4608) return n + 64;
    if (n < 4672) { const int j = n - 4608; return 1024 + (j & 1) * 32 + (j >> 1); }
    if (n < 4684) return n;
    return -1; } };
struct MapUp { __device__ __forceinline__ int operator()(int n) const {
    if (n >= 1152) return -1;
    const int hd = n / 192, w = n - hd * 192; if (w < 128) return n;
    const int j = w - 128; return hd * 192 + 128 + (j & 1) * 32 + (j >> 1); } };

constexpr int CI_W1 = (DM / 64) * (NFF / 64), CI_W2 = (FF / 64) * (DM / 64), CI_WM = (DM / 64) * (NMIX / 64), CI_UQ = 8 * 20, CI_UKV = 8 * 24, CI_WO = (DM / 64) * (DM / 64), CI_WC = 64 * 4;
constexpr int CI_LAYER = 2 * CI_W1 + 2 * CI_W2 + CI_WM + CI_UQ + CI_UKV + CI_WO + 2 * CI_WC, CI_TOTAL = DEPTH * CI_LAYER;
struct ConvItem { const float* src; const float* gain; bf16_t* dst; int Nlog, K, lc; };
__device__ __forceinline__ void conv_decode(int it, const Args& args, unsigned char* ws, int lane, ConvItem& c) {
    const int l = it / CI_LAYER; int r = it - l * CI_LAYER; unsigned char* lw = ws + WS_W + (size_t)l * LW_SIZE;
    const float* W; const float* gain = nullptr; bf16_t* WT; int Nlog, K, nblk, mapid;
    if (r < CI_W1) { W = args.in[2] + (size_t)l * DM * NFF; gain = args.in[1] + l * DM; WT = (bf16_t*)(lw + LW_W1A); Nlog = NFF; K = DM; nblk = NFF / 64; mapid = 1; }
    else if ((r -= CI_W1) < CI_W2) { W = args.in[3] + (size_t)l * FF * DM; WT = (bf16_t*)(lw + LW_W2A); Nlog = DM; K = FF; nblk = DM / 64; mapid = 0; }
    else if ((r -= CI_W2) < CI_W1) { W = args.in[17] + (size_t)l * DM * NFF; gain = args.in[16] + l * DM; WT = (bf16_t*)(lw + LW_W1B); Nlog = NFF; K = DM; nblk = NFF / 64; mapid = 1; }
    else if ((r -= CI_W1) < CI_W2) { W = args.in[18] + (size_t)l * FF * DM; WT = (bf16_t*)(lw + LW_W2B); Nlog = DM; K = FF; nblk = DM / 64; mapid = 0; }
    else if ((r -= CI_W2) < CI_WM) { W = args.in[5] + (size_t)l * DM * NMIX_LOG; gain = args.in[4] + l * DM; WT = (bf16_t*)(lw + LW_WM); Nlog = NMIX_LOG; K = DM; nblk = NMIX / 64; mapid = 2; }
    else if ((r -= CI_WM) < CI_UQ) { W = args.in[7] + (size_t)l * 512 * 1152; gain = args.in[6] + l * 512; WT = (bf16_t*)(lw + LW_WU); Nlog = 1152; K = 512; nblk = 20; mapid = 3; }
    else if ((r -= CI_UQ) < CI_UKV) { W = args.in[9] + (size_t)l * 512 * 1536; gain = args.in[8] + l * 512; WT = (bf16_t*)(lw + LW_WU) + (size_t)1280 * 512; Nlog = 1536; K = 512; nblk = 24; mapid = 0; }
    else if ((r -= CI_UKV) < CI_WO) { W = args.in[15] + (size_t)l * DM * DM; WT = (bf16_t*)(lw + LW_WO); Nlog = DM; K = DM; nblk = DM / 64; mapid = 0; }
    else if ((r -= CI_WO) < CI_WC) { W = args.in[11] + (size_t)l * 4096 * 128; WT = (bf16_t*)(lw + LW_WCK); Nlog = 128; K = 4096; nblk = 4; mapid = 0; }
    else { r -= CI_WC; W = args.in[13] + (size_t)l * 4096 * 128; WT = (bf16_t*)(lw + LW_WCV); Nlog = 128; K = 4096; nblk = 4; mapid = 0; }
    const int kb = r / nblk, nb = r - kb * nblk, k0 = kb * 64, n0 = nb * 64, n = n0 + lane;
    int lc;
    if (mapid == 0) lc = n < Nlog ? n : -1; else if (mapid == 1) lc = MapSwiglu{}(n); else if (mapid == 2) lc = MapMix{}(n); else lc = MapUp{}(n);
    c.src = W + (size_t)k0 * Nlog + (lc >= 0 ? lc : 0); c.gain = gain ? gain + k0 : nullptr; c.dst = WT + (size_t)n0 * K + k0; c.Nlog = Nlog; c.K = K; c.lc = lc;
}
__device__ __forceinline__ void conv_load(const ConvItem& c, float (&v)[64]) {
#pragma unroll
    for (int kk = 0; kk < 64; ++kk) v[kk] = __builtin_nontemporal_load(c.src + (size_t)kk * c.Nlog);
}
__device__ __forceinline__ void conv_store(const ConvItem& c, const float (&v)[64], LAS float* scr, int lane) {
#pragma unroll
    for (int kk = 0; kk < 64; ++kk) { float x = v[kk]; if (c.gain) x *= c.gain[kk]; scr[kk * 65 + lane] = c.lc >= 0 ? x : 0.f; }
    LDS_WAIT();
    const int ch = lane & 7;
#pragma unroll
    for (int j = 0; j < 8; ++j) { const int n = (lane >> 3) + 8 * j; const LAS float* sp = scr + (8 * ch) * 65 + n;
        u32x4 o; o.x = cvt_pk_bf16(sp[0], sp[65]); o.y = cvt_pk_bf16(sp[2 * 65], sp[3 * 65]); o.z = cvt_pk_bf16(sp[4 * 65], sp[5 * 65]); o.w = cvt_pk_bf16(sp[6 * 65], sp[7 * 65]);
        *(u32x4*)(c.dst + (size_t)n * c.K + 8 * ch) = o; }
    LDS_WAIT();
}

__device__ __forceinline__ void sincos_acc(float angf, float& c, float& s) {
    const double a = (double)angf;
    const double k = __builtin_rint(a * 0.63661977236758134308);
    const double r = (a - k * 1.57079632679489655800) - k * 6.12323399573676603587e-17;
    const double r2 = r * r;
    double sp = -2.50521083854417187751e-08; sp = sp * r2 + 2.75573192239858906526e-06; sp = sp * r2 - 1.98412698412698412698e-04; sp = sp * r2 + 8.33333333333333333333e-03; sp = sp * r2 - 1.66666666666666666667e-01;
    const double sr = r + r * r2 * sp + r * r2 * r2 * r2 * r2 * r2 * r2 * 1.60590438368216145994e-10;
    double cp = 2.08767569878680989792e-09; cp = cp * r2 - 2.75573192239858906526e-07; cp = cp * r2 + 2.48015873015873015873e-05; cp = cp * r2 - 1.38888888888888888889e-03; cp = cp * r2 + 4.16666666666666666667e-02; cp = cp * r2 - 0.5;
    const double cr = 1.0 + r2 * cp;
    const int q = ((int)(long long)k) & 3;
    const double sv = (q == 0) ? sr : (q == 1) ? cr : (q == 2) ? -sr : -cr;
    const double cv = (q == 0) ? cr : (q == 1) ? -sr : (q == 2) ? -cr : sr;
    c = (float)cv; s = (float)sv;
}

__global__ void __launch_bounds__(512, 2) fwd_kernel(Args args) {
    extern __shared__ __attribute__((aligned(16))) unsigned char lds_raw[];
    LAS unsigned char* lds = (LAS unsigned char*)lds_raw;
    volatile LAS unsigned* MISC = (volatile LAS unsigned*)(lds + MISC_OFF);
    for (int u = threadIdx.x; u < (LDS_BYTES - LDSCTL_OFF) / 4; u += 512) ((LAS unsigned*)(lds + LDSCTL_OFF))[u] = 0u;
    __syncthreads();
    XcdBarrier bar = xcd_barrier_post((unsigned*)(args.ws + WS_CTL) + CW_BAR, MISC + 8);
    {   unsigned bq_ = blockIdx.x; asm volatile("" : "+s"(bq_)); const unsigned mmv_ = __builtin_amdgcn_readfirstlane(bar.x != (bq_ & 7u) ? 1u : 0u);
        if (mmv_ != 0u && threadIdx.x == 0) (void)xb_add(&bar.bar[XL_MM], 1u); }
    const int G = gridDim.x;
    const int wave_s = __builtin_amdgcn_readfirstlane(threadIdx.x >> 6);
#define TID_NOW(var) int var; { int z_ = 0; asm volatile("" : "+s"(z_)); var = wave_s * 64 + (int)__builtin_amdgcn_mbcnt_hi(~0u, __builtin_amdgcn_mbcnt_lo(~0u, (unsigned)z_)); }
#define GRID_BARRIER() do { TID_NOW(tb_); xcd_barrier(bar, tb_); } while (0)
#define LOC_OK() ({ int zq_ = 0; asm volatile("" : "+s"(zq_)); __builtin_amdgcn_readfirstlane(MISC[10 + zq_]); })
#define SEAM_LOCAL() do { TID_NOW(tb_); if (LOC_OK()) xcd_local_barrier(bar, tb_); else xcd_barrier(bar, tb_); } while (0)
#define PHASE_BEGIN() TID_NOW(tid); int bid = blockIdx.x; asm volatile("" : "+s"(bid)); unsigned char* ws = args.ws; asm volatile("" : "+s"(ws)); \
    const int lane = tid & 63, wave = __builtin_amdgcn_readfirstlane(tid >> 6); const int gw = bid * 8 + wave, ngw = G * 8; (void)lane; (void)wave; (void)gw; (void)ngw; \
    float* X = args.out; bf16_t* XB = (bf16_t*)(ws + WS_XB); float* SS = (float*)(ws + WS_SS); (void)X; (void)XB; (void)SS;
#define MIXBUFS() pg8::MixBufs MB; { unsigned char* ov = ws + WS_BIG; MB.LAT = (bf16_t*)(ov + OV_LAT); MB.LATSS = (float*)(ov + OV_LATSS); MB.DQ = (bf16_t*)(ov + OV_DQ); MB.DK = (bf16_t*)(ov + OV_DK); MB.DV = (bf16_t*)(ov + OV_DV); \
      MB.NQ = (bf16_t*)(ov + OV_NQ); MB.NKV = (bf16_t*)(ov + OV_NKV); MB.GATES = (float*)(ov + OV_GATES) + (size_t)l * M * 16; MB.MK = (bf16_t*)(ov + OV_MK); MB.ROPE = (const float*)(ws + WS_ROPE); } \
    bf16_t* MQ = (bf16_t*)(ws + WS_BIG + OV_MQ); bf16_t* MV = (bf16_t*)(ws + WS_BIG + OV_MV); (void)MQ; (void)MV;


    {
        PHASE_BEGIN();
        LAS float* scr = (LAS float*)(lds + wave * 16640);
        {
        {
            float va[64], vb[64]; ConvItem ca, cb; int it = gw;
            if (it < CI_TOTAL) { conv_decode(it, args, ws, lane, ca); conv_load(ca, va); }
            while (it < CI_TOTAL) {
                const int it1 = it + ngw;
                if (it1 < CI_TOTAL) { conv_decode(it1, args, ws, lane, cb); conv_load(cb, vb); }
                conv_store(ca, va, scr, lane);
                if (it1 >= CI_TOTAL) break;
                const int it2 = it1 + ngw;
                if (it2 < CI_TOTAL) { conv_decode(it2, args, ws, lane, ca); conv_load(ca, va); }
                conv_store(cb, vb, scr, lane);
                it = it2;
            }
        }
        {
            const float INVF[32] = {0x1.0000000000000p+0f, 0x1.7ff2240000000p-1f, 0x1.1feb340000000p-1f, 0x1.afd1360000000p-2f, 0x1.43d1360000000p-2f, 0x1.e5a8480000000p-3f, 0x1.6c310e0000000p-3f, 0x1.111aec0000000p-3f,
                0x1.99999a0000000p-4f, 0x1.33281a0000000p-4f, 0x1.ccab860000000p-5f, 0x1.59742c0000000p-5f, 0x1.030dc40000000p-5f, 0x1.8486a00000000p-6f, 0x1.235a720000000p-6f, 0x1.b4f7e40000000p-7f,
                0x1.47ae140000000p-7f, 0x1.eb735e0000000p-8f, 0x1.7089380000000p-8f, 0x1.145cee0000000p-8f, 0x1.9e7c6e0000000p-9f, 0x1.36d2180000000p-9f, 0x1.d22a500000000p-10f, 0x1.5d931c0000000p-10f,
                0x1.0624de0000000p-10f, 0x1.89291a0000000p-11f, 0x1.26d42c0000000p-11f, 0x1.ba2e4c0000000p-12f, 0x1.4b96be0000000p-12f, 0x1.f150280000000p-13f, 0x1.74eea60000000p-13f, 0x1.17a8e40000000p-13f};
            float* rope = (float*)(ws + WS_ROPE);
            for (int e = bid * 512 + tid; e < SEQ * 32; e += G * 512) { const int pos = e >> 5, i = e & 31; float fi = INVF[0];
#pragma unroll
                for (int q = 1; q < 32; ++q) fi = (i == q) ? INVF[q] : fi;
                const float ang = (float)pos * fi; float c, sn; sincos_acc(ang, c, sn); rope[2 * e] = c; rope[2 * e + 1] = sn; }
        }
        {
            float* cb = (float*)(ws + WS_CB);
            for (int o = gw; o < DEPTH * 2 * 128; o += ngw) { const int l = o >> 8, kv = (o >> 7) & 1, n = o & 127;
                const float* pe = args.in[10] + (size_t)l * 4096; const float* w1 = (kv ? args.in[13] : args.in[11]) + (size_t)l * 4096 * 128 + n; float a = 0.f;
                for (int r = lane; r < 4096; r += 64) a += pe[r] * w1[(size_t)r * 128];
#pragma unroll
                for (int of = 1; of < 64; of <<= 1) a += shx(a, of, lane);
                if (lane == 0) cb[o] = a; }
        }
        const float* x0 = args.in[0];
        for (int row = gw; row < M; row += ngw) {
            const f32x4* xr = (const f32x4*)(x0 + (size_t)row * DM) + lane; u32x2* xb = (u32x2*)(XB + (size_t)row * DM) + lane;
            float s = 0.f;
#pragma unroll
            for (int j = 0; j < 8; ++j) { const f32x4 v = xr[64 * j]; u32x2 w; w.x = cvt_pk_bf16(v[0], v[1]); w.y = cvt_pk_bf16(v[2], v[3]); xb[64 * j] = w; s += (v[0] * v[0] + v[1] * v[1]) + (v[2] * v[2] + v[3] * v[3]); }
#pragma unroll
            for (int o = 1; o < 64; o <<= 1) s += shx(s, o, lane);
            if (lane < 32) SS[(size_t)row * 32 + lane] = lane == 0 ? s : 0.f;
        }
        }
    }
    GRID_BARRIER();
    {   TID_NOW(t0_); if (t0_ == 0) { unsigned* bb_ = bar.bar; MISC[10] = (xb_ld(&bb_[XL_MM]) == 0u && MISC[8] * 8u == (unsigned)G && MISC[9] == 8u) ? 1u : 0u; }
        __syncthreads(); }

    for (int j = 0; j < 2 * DEPTH; ++j) {
        const int l = j >> 1, which = j & 1;
        {
            PHASE_BEGIN(); unsigned char* lw = ws + WS_W + (size_t)l * LW_SIZE;
            const bool lok = LOC_OK() != 0u; unsigned* cc = (unsigned*)(ws + WS_CTL) + CW_CHAIN;
            pg8::Gemm g{XB, (const bf16_t*)(lw + (which ? LW_W1B : LW_W1A)), M, NFF, DM, DM}; pg8::ChainOrder S; S.init(M, NFF, G, (lok && !which) ? ((bid + 128) & 255) : bid);
            S.need_cnt = (lok && j > 0) ? cc + (which ? 3 * (j - 1) + 2 : 3 * (j - 1) + 1) * 2048 : nullptr; S.need = 64u; S.done_cnt = lok ? cc + (3 * j) * 2048 : nullptr; S.tmo = (unsigned*)(ws + WS_CTL) + CW_BAR + XB_TMO;
            LAS float* rc = (LAS float*)(lds + pg8::RC_OFF + wave * pg8::RC_WAVE); if (lane == 0) ((LAS int*)rc)[128] = -1;
            pg8::EpiSwiGLU E{(bf16_t*)(ws + WS_HID), SS, rc};
            pg8::gemm_phase<pg8::EpiSwiGLU, pg8::ChainOrder, true>(lds, g, S, E, tid);
        }
        if (!LOC_OK()) GRID_BARRIER();
        {
            PHASE_BEGIN(); unsigned char* lw = ws + WS_W + (size_t)l * LW_SIZE;
            const bool lok = LOC_OK() != 0u; unsigned* cc = (unsigned*)(ws + WS_CTL) + CW_CHAIN;
            pg8::Gemm g{(const bf16_t*)(ws + WS_HID), (const bf16_t*)(lw + (which ? LW_W2B : LW_W2A)), M, DM, FF, FF}; pg8::ChainOrder S; S.init(M, DM, G, bid); S.rev = 1;
            S.need_cnt = lok ? cc + (3 * j) * 2048 : nullptr; S.need = (unsigned)(NFF / 256) * 8u; S.done_cnt = lok ? cc + (3 * j + 1) * 2048 : nullptr; S.tmo = (unsigned*)(ws + WS_CTL) + CW_BAR + XB_TMO;
            pg8::EpiResid E{j == 0 ? args.in[0] : nullptr, j + 1 == 2 * DEPTH ? X : nullptr, XB, SS, 0.5f};
            pg8::gemm_phase<pg8::EpiResid, pg8::ChainOrder, true>(lds, g, S, E, tid);
        }
        if (which) { if (j + 1 == 2 * DEPTH || !LOC_OK()) SEAM_LOCAL(); continue; }
        GRID_BARRIER();
        {
            PHASE_BEGIN(); MIXBUFS(); unsigned char* lw = ws + WS_W + (size_t)l * LW_SIZE;
            pg8::Gemm g{XB, (const bf16_t*)(lw + LW_WM), M, NMIX, DM, DM}; pg8::StaticOrder S; S.init(M, NMIX, G, bid);
            LAS float* rc = (LAS float*)(lds + pg8::RC_OFF + wave * pg8::RC_WAVE); if (lane == 0) ((LAS int*)rc)[128] = -1;
            pg8::EpiMixIn E{MB, SS, rc};
            pg8::gemm_phase<pg8::EpiMixIn, pg8::StaticOrder, true>(lds, g, S, E, tid);
        }
        GRID_BARRIER();
        {
            PHASE_BEGIN(); MIXBUFS(); unsigned char* lw = ws + WS_W + (size_t)l * LW_SIZE; const int c_ = bid;
            if (c_ >= 16) {
                pg8::Gemm g{MB.LAT, (const bf16_t*)(lw + LW_WU), M, NUP, 512, LATW}; pg8::StaticOrder S; S.init(M, NUP, G - 16, c_ - 16); S.acol_pn = 5; S.acol_off = 512;
                pg8::EpiUp E{MQ, MB.MK, MV, MB.LATSS, MB.ROPE};
                pg8::gemm_phase<pg8::EpiUp, pg8::StaticOrder, true>(lds, g, S, E, tid);
            } else {
                const int kv = c_ >> 3;
                const bf16_t* Ain = MB.NKV + (size_t)kv * ((size_t)M * 128);
                bf16_t* H1 = (bf16_t*)(ws + WS_H1) + ((size_t)l * 2 + kv) * 2048 * 128;
                pg8::Gemm g{Ain, (const bf16_t*)(lw + (kv ? LW_WCV : LW_WCK)), 2048, 256, 4096, 2048}; pg8::StaticOrder S; S.init(2048, 256, 8, c_ & 7);
                pg8::EpiCmp E{H1, (const float*)(ws + WS_CB) + (l * 2 + kv) * 128};
                pg8::gemm_phase<pg8::EpiCmp, pg8::StaticOrder, true>(lds, g, S, E, tid);
                VM_WAIT(); __syncthreads();
                const float* w2 = (kv ? args.in[14] : args.in[12]) + (size_t)l * 128 * 128;
                LAS bf16_t* w2t = (LAS bf16_t*)lds;
                for (int e = tid; e < 128 * 128; e += 512) { const int k = e >> 7, n = e & 127; const float wv = w2[e]; const unsigned hb = cvt_pk_bf16(wv, 0.f) & 0xffffu;
                    w2t[n * 136 + k] = (bf16_t)hb; w2t[128 * 136 + n * 136 + k] = (bf16_t)(cvt_pk_bf16(wv - __uint_as_float(hb << 16), 0.f) & 0xffffu); }
                __syncthreads();
                {
                    bf16_t* KC = (bf16_t*)(ws + WS_KC) + ((size_t)l * 2 + kv) * 2048 * 128;
                    const int r32 = lane & 31, hi = lane >> 5, rowb = (c_ & 7) * 256 + wave * 32;
                    bf16x8 af[8];
#pragma unroll
                    for (int ks = 0; ks < 8; ++ks) af[ks] = *(const bf16x8*)(H1 + (size_t)(rowb + r32) * 128 + ks * 16 + hi * 8);
#pragma unroll
                    for (int nb = 0; nb < 4; ++nb) { f32x16 acc = {};
#pragma unroll
                        for (int ks = 0; ks < 8; ++ks) { const bf16x8 bfr = *(const LAS bf16x8*)(w2t + (nb * 32 + r32) * 136 + ks * 16 + hi * 8);
                            const bf16x8 bfl = *(const LAS bf16x8*)(w2t + 128 * 136 + (nb * 32 + r32) * 136 + ks * 16 + hi * 8);
                            acc = __builtin_amdgcn_mfma_f32_32x32x16_bf16(af[ks], bfr, acc, 0, 0, 0); acc = __builtin_amdgcn_mfma_f32_32x32x16_bf16(af[ks], bfl, acc, 0, 0, 0); }
#pragma unroll
                        for (int r = 0; r < 16; ++r) KC[(size_t)(rowb + att::crow(r, hi)) * 128 + nb * 32 + r32] = (bf16_t)(cvt_pk_bf16(acc[r], 0.f) & 0xffffu); }
                }
                __syncthreads();
            }
            {
            gu32* qctr = (gu32*)(ws + WS_CTL) + CW_QUEUE + (l * 2 + 0) * 64;
            for (;;) {
                TID_NOW(tq);
                if (tq == 0) MISC[0] = __hip_atomic_fetch_add(qctr, 1u, __ATOMIC_RELAXED, __HIP_MEMORY_SCOPE_AGENT);
                __syncthreads();
                const int u = (int)MISC[0];
                __syncthreads();
                if (u >= 768) break;
                const int g = u >> 8, v = u & 255, dsh = 2 * g, d = 1 << dsh, nlb = 64 >> dsh;
                const int lb = v % nlb, w = v / nlb, r = w & (d - 1), bs = w >> dsh, sl = bs & 1, b = bs >> 1, head = 2 * g + sl;
                const size_t tokb = (size_t)b * SEQ + r;
                att::PolDil p; p.Q = MB.DQ + (tokb + (size_t)lb * 256 * d) * 768 + head * 128; p.q_pitch = 768 * d;
                p.K = MB.DK + tokb * 768 + head * 128; p.k_pitch = 768 * d; p.V = MB.DV + tokb * 768 + head * 128; p.v_pitch = 768 * d;
                p.P0 = lb * 256; p.W = 129; p.j0 = lb == 0 ? 0 : 4 * lb - 2; p.nt = 4 * lb + 4 - p.j0; p.mfix = 0.f;
                p.sl2 = att::alibi_slope(head + 1) * (float)d * 1.4426950408889634f;
                p.O = (bf16_t*)(ws + WS_OCAT) + (tokb + (size_t)lb * 256 * d) * DM + 768 + head * 128; p.o_pitch = DM * d;
                p.LSE = (float*)(ws + WS_DLSE) + (size_t)l * M * 8 + (tokb + (size_t)lb * 256 * d) * 8 + head; p.lse_pitch = 8 * d;
                float m_, l_; att::attn_block(p, lds, tq, m_, l_);
            }
            }
        }
        GRID_BARRIER();
        {
            PHASE_BEGIN(); MIXBUFS();
            att::NsaBufs nb; nb.NQ = MB.NQ; nb.NKV = MB.NKV; nb.KC = (const bf16_t*)(ws + WS_KC) + (size_t)l * 2 * 2048 * 128; nb.VC = nb.KC + 2048 * 128; nb.GATES = MB.GATES; nb.NSAF = (float*)(ws + WS_NSAF); nb.OCAT = (bf16_t*)(ws + WS_OCAT);
            {
            gu32* qctr = (gu32*)(ws + WS_CTL) + CW_QUEUE + (l * 2 + 1) * 64;
            const int ntot = 552 + 512 + 216 + 128;
            for (;;) {
                TID_NOW(tq); const int lane_q = tq & 63, wave_q = tq >> 6;
                if (tq == 0) MISC[0] = __hip_atomic_fetch_add(qctr, 1u, __ATOMIC_RELAXED, __HIP_MEMORY_SCOPE_AGENT);
                __syncthreads();
                int u = (int)MISC[0];
                __syncthreads();
                if (u >= ntot) break;
                int mla = -1;
                if (u < 552) mla = u; else if (u < 552 + 512) { const int n = u - 552; att::nsa_unit(nb, n >> 8, (n & 255) * 64, lds, tq); }
                else if (u < 552 + 512 + 216) mla = u - 512;
                else {
                    const int tb = (u - (552 + 512 + 216)) * 256; const float* dl = (const float*)(ws + WS_DLSE) + (size_t)l * M * 8; bf16_t* oc = (bf16_t*)(ws + WS_OCAT);
                    for (int k = wave_q; k < 256; k += 8) { const size_t tok = (size_t)tb + k; const float* lp = dl + tok * 8;
                        for (int ch = lane_q; ch < 96; ch += 64) { const int head = ch >> 4, slot = head & 1;
                            const float a0 = lp[slot], a1 = lp[2 + slot], a2 = lp[4 + slot], mx = fmaxf(a0, fmaxf(a1, a2));
                            const float e0 = __expf(a0 - mx), e1 = __expf(a1 - mx), e2 = __expf(a2 - mx), mine = head < 2 ? e0 : (head < 4 ? e1 : e2), al = mine / (e0 + e1 + e2);
                            u32x4* pp = (u32x4*)(oc + tok * DM + 768 + ch * 8); u32x4 w = *pp; unsigned* wp = (unsigned*)&w;
#pragma unroll
                            for (int e = 0; e < 4; ++e) { const float lo = __uint_as_float(wp[e] << 16) * al, hi_ = __uint_as_float(wp[e] & 0xffff0000u) * al; wp[e] = cvt_pk_bf16(lo, hi_); }
                            *pp = w; } }
                }
                if (mla >= 0) {
                    const int qb = 63 - mla / 12, bh = mla % 12, b = bh / 6, h = bh - b * 6;
                    att::PolMLA p; p.Q = MQ + ((size_t)b * SEQ + (size_t)qb * 256) * 1152 + h * 192; p.q_pitch = 1152;
                    p.K = MB.MK + (size_t)b * SEQ * 1152 + h * 192; p.k_pitch = 1152; p.V = MV + (size_t)b * SEQ * 768 + h * 128; p.v_pitch = 768;
                    p.nt = 4 * (qb + 1); p.j0 = 0; p.P0 = qb * 256; p.W = 0x40000000; p.mfix = 0.f;
                    p.O = (bf16_t*)(ws + WS_OCAT) + ((size_t)b * SEQ + (size_t)qb * 256) * DM + h * 128; p.o_pitch = DM;
                    float m_, l_; att::attn_block(p, lds, tq, m_, l_);
                }
            }
            }
        }
        GRID_BARRIER();
        {
            PHASE_BEGIN(); unsigned char* lw = ws + WS_W + (size_t)l * LW_SIZE;
            const bool lok = LOC_OK() != 0u; unsigned* cc = (unsigned*)(ws + WS_CTL) + CW_CHAIN;
            pg8::Gemm g{(const bf16_t*)(ws + WS_OCAT), (const bf16_t*)(lw + LW_WO), M, DM, DM, DM}; pg8::ChainOrder S; S.init(M, DM, G, bid);
            S.need_cnt = nullptr; S.need = 0u; S.done_cnt = lok ? cc + (3 * j + 2) * 2048 : nullptr; S.tmo = (unsigned*)(ws + WS_CTL) + CW_BAR + XB_TMO;
            pg8::EpiResid E{nullptr, nullptr, XB, SS, 1.0f};
            pg8::gemm_phase<pg8::EpiResid, pg8::ChainOrder, true>(lds, g, S, E, tid);
        }
        if (!LOC_OK()) GRID_BARRIER();
    }

    {
        PHASE_BEGIN();
        const float* gfin = args.in[19];
        const int rpx = M / 8, rbase = (bid & 7) * rpx;
        for (int row = rbase + (bid >> 3) * 8 + wave; row < rbase + rpx; row += (G >> 3) * 8) {
            float s = SS[(size_t)row * 32 + (lane & 31)];
#pragma unroll
            for (int o = 1; o < 32; o <<= 1) s += shx(s, o, lane);
            const float r = rsqrtf(s * (1.0f / DM) + RMS_EPS);
            f32x4* xo = (f32x4*)(X + (size_t)row * DM) + lane; const f32x4* gp = (const f32x4*)gfin + lane;
#pragma unroll
            for (int jj = 0; jj < 8; ++jj) { const f32x4 v = xo[64 * jj]; xo[64 * jj] = v * r * gp[64 * jj]; }
        }
    }
}

extern "C" void kernel_launch(void* const* d_in, const int* in_sizes, int n_in, void* d_out, int out_size, void* d_ws, size_t ws_size, hipStream_t stream) {
    static int grid = 0;
    if (grid == 0) {
        if (n_in != 20 || out_size != M * DM || ws_size < WS_END_V1) { fprintf(stderr, "kernel_launch: unexpected shapes (n_in %d out %d ws %zu)\n", n_in, out_size, ws_size); grid = -1; return; }
        int dev = 0, cus = 0, per_cu = 0;
        (void)hipGetDevice(&dev); (void)hipDeviceGetAttribute(&cus, hipDeviceAttributeMultiprocessorCount, dev);
        if (hipFuncSetAttribute((const void*)fwd_kernel, hipFuncAttributeMaxDynamicSharedMemorySize, LDS_BYTES) != hipSuccess) { fprintf(stderr, "kernel_launch: hipFuncSetAttribute failed\n"); grid = -1; return; }
        (void)hipOccupancyMaxActiveBlocksPerMultiprocessor(&per_cu, (const void*)fwd_kernel, 512, LDS_BYTES);
        (void)hipGetLastError();
        grid = cus > 0 ? cus : 256;
        fprintf(stderr, "kernel_launch: grid %d (occupancy query %d)\n", grid, per_cu);
    }
    if (grid < 0) return;
    (void)hipMemsetAsync((char*)d_ws + WS_CTL, 0, CTL_ZERO_BYTES, stream);
    Args a{};
    for (int i = 0; i < 20; ++i) a.in[i] = (const float*)d_in[i];
    a.out = (float*)d_out; a.ws = (unsigned char*)d_ws;
    hipLaunchKernelGGL(fwd_kernel, dim3(grid), dim3(512), LDS_BYTES, stream, a);
}
```

```cpp
#include <hip/hip_runtime.h>
#include <cstdio>
#include <cstdint>

#define LAS __attribute__((address_space(3)))
#define GAS __attribute__((address_space(1)))
typedef unsigned short bf16_t;
typedef short bf16x8 __attribute__((ext_vector_type(8)));
typedef short s16x4 __attribute__((ext_vector_type(4)));
typedef float f32x4 __attribute__((ext_vector_type(4)));
typedef float f32x16 __attribute__((ext_vector_type(16)));
typedef float f32x2 __attribute__((ext_vector_type(2)));
typedef unsigned u32x4 __attribute__((ext_vector_type(4)));
typedef unsigned u32x2 __attribute__((ext_vector_type(2)));
typedef GAS unsigned gu32;

constexpr int BATCH = 2, SEQ = 16384, M = BATCH * SEQ, DM = 2048, FF = 5504, NFF = 2 * FF, DEPTH = 4;
constexpr int NMIX = 4864, NMIX_LOG = 4684, NUP = 2816, LATW = 1024;
constexpr float RMS_EPS = 1e-6f;

__device__ __forceinline__ unsigned cvt_pk_bf16(float lo, float hi) { unsigned r; asm volatile("v_cvt_pk_bf16_f32 %0, %1, %2" : "=v"(r) : "v"(lo), "v"(hi)); return r; }
__device__ __forceinline__ float shx(float v, int mask, int lane) { return __int_as_float(__builtin_amdgcn_ds_bpermute((lane ^ mask) << 2, __float_as_int(v))); }
__device__ __forceinline__ unsigned shxu(unsigned v, int mask, int lane) { return (unsigned)__builtin_amdgcn_ds_bpermute((lane ^ mask) << 2, (int)v); }
__device__ __forceinline__ __amdgpu_buffer_rsrc_t mk_rsrc(const void* p) {
    const uintptr_t a = (uintptr_t)p; const unsigned lo = __builtin_amdgcn_readfirstlane((unsigned)a), hi = __builtin_amdgcn_readfirstlane((unsigned)(a >> 32));
    return __builtin_amdgcn_make_buffer_rsrc((void*)(((uintptr_t)hi << 32) | lo), 0, 0x7ffffff0, 0x00020000); }
__device__ __forceinline__ bf16x8 ld_sc1(__amdgpu_buffer_rsrc_t r, int byte_off) { const u32x4 v = __builtin_amdgcn_raw_buffer_load_b128(r, byte_off, 0, 16); return __builtin_bit_cast(bf16x8, v); }
#define LDS_WAIT() asm volatile("s_waitcnt lgkmcnt(0)" ::: "memory")
#define VM_WAIT() asm volatile("s_waitcnt vmcnt(0)" ::: "memory")

namespace pg8 {
constexpr int BM = 256, BK = 64, HALF = 128, HTB = HALF * BK * 2, STAGE_BYTES = 8 * HTB, NXCD = 8, WGM = 8;
__host__ __device__ __forceinline__ int lds_byte(int r, int c) { const int st = (r >> 4) * 2 + (c >> 5), rr = r & 15, cc = c & 31, ob = rr * 64 + cc * 2; return st * 1024 + (ob ^ (((ob >> 9) & 1) << 5)); }
__host__ __device__ __forceinline__ void stage_rc(int b, int& R, int& C) { const int st = b / 1024, sb = b % 1024, swz = sb ^ (((sb >> 9) & 1) << 5); R = (st >> 1) * 16 + swz / 64; C = (st & 1) * 32 + (swz % 64) / 2; }
__host__ __device__ __forceinline__ int perm32(int rho) { const int n = rho >> 4, i = rho & 15; return 8 * (i >> 2) + 4 * n + (i & 3); }
struct Unit { int pm, pn; };
struct Gemm { const bf16_t* A; const bf16_t* Bt; int M, N, K, lda; };
struct StaticOrder {
    int nM, nN, nwg, G, c, acol_pn, acol_off, wgm = 4, rev = 0;
    __device__ void init(int M_, int N_, int G_, int c_) { nM = M_ / BM; nN = N_ / BM; nwg = nM * nN; G = G_; c = c_; acol_pn = 1 << 30; acol_off = 0; }
    __device__ bool next(int i, Unit& u) const {
        if (c < 0) return false;
        if (rev && (long)i * G + c >= nwg) return false;
        const long L = (long)(rev ? (nwg / G - 1 - i) : i) * G + c; if (L >= nwg || L < 0) return false;
        int wgid = (int)L; { const int q = nwg / NXCD, r = nwg % NXCD, xcd = wgid % NXCD, off = wgid / NXCD; wgid = (xcd < r ? xcd * (q + 1) : r * (q + 1) + (xcd - r) * q) + off; }
        const int nig = wgm * nN, gid = wgid / nig, fm = gid * wgm, gsz = (nM - fm) < wgm ? (nM - fm) : wgm;
        u.pm = fm + ((wgid % nig) % gsz); u.pn = (wgid % nig) / gsz; return true;
    }
    __device__ __forceinline__ int acol(const Unit& u) const { return u.pn >= acol_pn ? acol_off : 0; }
};

struct ChainOrder : StaticOrder {
    static constexpr bool CHAIN = true;
    const unsigned* need_cnt; unsigned need; unsigned* done_cnt; unsigned* tmo;
    __device__ __forceinline__ unsigned peek(const Unit& u, bool valid, int wid) const {
        if (need_cnt != nullptr && valid && wid == 0) return __hip_atomic_load(need_cnt + 16 * u.pm, __ATOMIC_RELAXED, __HIP_MEMORY_SCOPE_AGENT);
        return 0u; }
    __device__ __forceinline__ void a_ready(const Unit& u, bool valid, int wid, unsigned first = 0u) const {
        if (need_cnt != nullptr && valid) {
            if (wid == 0) {
                const unsigned* p = need_cnt + 16 * u.pm; unsigned sp = 0u;
                if ((unsigned)__builtin_amdgcn_readfirstlane(first) < need)
                while ((unsigned)__builtin_amdgcn_readfirstlane(__hip_atomic_load(p, __ATOMIC_RELAXED, __HIP_MEMORY_SCOPE_AGENT)) < need) {
                    __builtin_amdgcn_s_sleep(2);
                    if ((++sp & 255u) == 0u) { if (__builtin_amdgcn_readfirstlane(__hip_atomic_load(tmo, __ATOMIC_RELAXED, __HIP_MEMORY_SCOPE_AGENT)) != 0u) break;
                        if (sp > (1u << 18)) { __hip_atomic_store(tmo, 1u, __ATOMIC_RELAXED, __HIP_MEMORY_SCOPE_AGENT); break; } } }
                asm volatile("buffer_inv sc0\n\ts_waitcnt vmcnt(0)" ::: "memory");
            }
            asm volatile("" ::: "memory"); __builtin_amdgcn_s_barrier(); asm volatile("" ::: "memory");
        }
    }
    __device__ __forceinline__ void done(const Unit& u, int lane) const {
        if (done_cnt != nullptr) { asm volatile("s_waitcnt vmcnt(0)" ::: "memory");
            if (lane == 0) (void)__hip_atomic_fetch_add(done_cnt + 16 * u.pm, 1u, __ATOMIC_RELAXED, __HIP_MEMORY_SCOPE_AGENT); }
    }
};
template <class T> struct is_chain { static constexpr bool v = false; };
template <> struct is_chain<ChainOrder> { static constexpr bool v = true; };
template <class Epi, class Sched, bool ALIGN_EPI>
__device__ __forceinline__ void gemm_phase(LAS unsigned char* lds, const Gemm g, const Sched& S, const Epi& E, const int tid) {
    const int wid = __builtin_amdgcn_readfirstlane(tid >> 6), lane = tid & 63, wr = wid >> 2, wc = wid & 3, fr = lane & 15, fq = lane >> 4;
    const int K = g.K, nt = K / BK, lda = g.lda;
    unsigned voffA[2], voffB[2];
#pragma unroll
    for (int i = 0; i < 2; ++i) { int R, C; stage_rc(tid * 16 + i * 8192, R, C); const int Rb = Epi::PERM ? ((R & ~31) + perm32(R & 31)) : R;
        voffA[i] = (unsigned)(R * lda + C) * 2u; voffB[i] = (unsigned)(Rb * K + C) * 2u; }
    const size_t kstep = (size_t)(BK * 2);
    const size_t hsA = (size_t)HALF * lda * 2, hsB = (size_t)HALF * K * 2;
    const size_t tsA = 2 * hsA, tsB = 2 * hsB;
    const unsigned ldsw = (unsigned)wid * 1024u;
    const int aoff = lds_byte(wr * 64 + fr, fq * 8), boff = lds_byte(wc * 32 + fr, fq * 8);
#define PG8_SA(b, h) (((b) * 2 + (h)) * HTB)
#define PG8_SB(b, h) ((4 + (b) * 2 + (h)) * HTB)
#define PG8_STAGE(bufoff, gbase, voff) do { _Pragma("unroll") for (int _i = 0; _i < 2; ++_i) \
        __builtin_amdgcn_global_load_lds((const unsigned*)((const char*)(gbase) + (voff)[_i]), (LAS unsigned*)(lds + (bufoff) + ldsw + _i * 8192), 16, 0, 0); } while (0)
#define PG8_LDA(dst, b, h) do { _Pragma("unroll") for (int m = 0; m < 4; ++m) _Pragma("unroll") for (int k = 0; k < 2; ++k) dst[m][k] = *(const LAS bf16x8*)(lds + PG8_SA(b, h) + aoff + m * 2048 + k * 1024); } while (0)
#define PG8_LDB(dst, b, h) do { _Pragma("unroll") for (int n = 0; n < 2; ++n) _Pragma("unroll") for (int k = 0; k < 2; ++k) dst[n][k] = *(const LAS bf16x8*)(lds + PG8_SB(b, h) + boff + n * 2048 + k * 1024); } while (0)
#define PG8_MMA(ai, bj, At, Bt) do { __builtin_amdgcn_s_setprio(1); _Pragma("unroll") for (int m = 0; m < 4; ++m) _Pragma("unroll") for (int n = 0; n < 2; ++n) _Pragma("unroll") for (int k = 0; k < 2; ++k) \
        acc[ai][bj][m][n] = __builtin_amdgcn_mfma_f32_16x16x32_bf16(Bt[n][k], At[m][k], acc[ai][bj][m][n], 0, 0, 0); __builtin_amdgcn_s_setprio(0); } while (0)
#define PG8_WAIT_V(n) asm volatile("s_waitcnt vmcnt(" #n ")" ::: "memory")
#define PG8_WAIT_L(n) asm volatile("s_waitcnt lgkmcnt(" #n ")" ::: "memory")
#define PG8_BAR __builtin_amdgcn_s_barrier()
#define PG8_SCHED __builtin_amdgcn_sched_barrier(0)
    Unit cur, nxt; int ui = 0;
    if (!S.next(0, cur)) return;
    if constexpr (is_chain<Sched>::v) { S.a_ready(cur, true, wid); Unit u1_; const bool h1_ = S.next(1, u1_); S.a_ready(u1_, h1_, wid); }
    f32x4 acc[2][2][4][2];
#pragma unroll
    for (int a = 0; a < 2; ++a)
#pragma unroll
        for (int b = 0; b < 2; ++b)
#pragma unroll
            for (int m = 0; m < 4; ++m)
#pragma unroll
                for (int n = 0; n < 2; ++n) acc[a][b][m][n] = (f32x4){0.f, 0.f, 0.f, 0.f};
    bf16x8 At[4][2], B0[2][2], B1[2][2];
    const char* cA = (const char*)g.A + (size_t)cur.pm * tsA + (size_t)S.acol(cur) * 2; const char* cB = (const char*)g.Bt + (size_t)cur.pn * tsB;
    PG8_STAGE(PG8_SB(0, 0), cB, voffB); PG8_STAGE(PG8_SB(0, 1), cB + hsB, voffB); PG8_STAGE(PG8_SA(0, 0), cA, voffA); PG8_STAGE(PG8_SA(0, 1), cA + hsA, voffA);
    if (wr == 1) PG8_BAR;
    PG8_WAIT_V(2); PG8_BAR;
    PG8_STAGE(PG8_SB(1, 0), cB + kstep, voffB); PG8_STAGE(PG8_SA(1, 0), cA + kstep, voffA); PG8_STAGE(PG8_SB(1, 1), cB + hsB + kstep, voffB);
    PG8_WAIT_V(6); PG8_BAR;
    for (;;) {
        const bool has_next = S.next(ui + 1, nxt);
        const char* nA = has_next ? (const char*)g.A + (size_t)nxt.pm * tsA + (size_t)S.acol(nxt) * 2 : cA; const char* nB = has_next ? (const char*)g.Bt + (size_t)nxt.pn * tsB : cB;
        for (int t = 0; t < nt; t += 2) {
            const bool last = (t == nt - 2);
            const char* a1 = cA + (size_t)(t + 1) * kstep;
            const char* a2 = last ? nA : cA + (size_t)(t + 2) * kstep; const char* b2 = last ? nB : cB + (size_t)(t + 2) * kstep;
            const char* a3 = a2 + kstep; const char* b3 = b2 + kstep;
            PG8_LDB(B0, 0, 0); PG8_LDB(B1, 0, 1); PG8_SCHED; PG8_LDA(At, 0, 0); PG8_STAGE(PG8_SA(1, 1), a1 + hsA, voffA);
            PG8_WAIT_V(8); PG8_WAIT_L(0); PG8_BAR; PG8_MMA(0, 0, At, B0); PG8_MMA(0, 1, At, B1); PG8_BAR; PG8_SCHED;
            PG8_LDA(At, 0, 1); PG8_STAGE(PG8_SB(0, 0), b2, voffB); PG8_STAGE(PG8_SB(0, 1), b2 + hsB, voffB); PG8_STAGE(PG8_SA(0, 0), a2, voffA);
            PG8_WAIT_V(8); PG8_WAIT_L(0); PG8_BAR; PG8_MMA(1, 0, At, B0); PG8_MMA(1, 1, At, B1); PG8_BAR; PG8_SCHED;
            PG8_LDB(B0, 1, 0); PG8_LDB(B1, 1, 1); PG8_SCHED; PG8_LDA(At, 1, 0); PG8_STAGE(PG8_SA(0, 1), a2 + hsA, voffA);
            PG8_WAIT_V(8); PG8_WAIT_L(0); PG8_BAR; PG8_MMA(0, 0, At, B0); PG8_MMA(0, 1, At, B1); PG8_BAR; PG8_SCHED;
            PG8_LDA(At, 1, 1); PG8_STAGE(PG8_SB(1, 0), b3, voffB); PG8_STAGE(PG8_SB(1, 1), b3 + hsB, voffB); PG8_STAGE(PG8_SA(1, 0), a3, voffA);
            PG8_WAIT_V(8); PG8_WAIT_L(0); PG8_BAR; PG8_MMA(1, 0, At, B0); PG8_MMA(1, 1, At, B1); PG8_BAR; PG8_SCHED;
        }
        if constexpr (ALIGN_EPI) { if (wr == 0) PG8_BAR; }
        Unit u2_; bool h2_ = false; unsigned pk_ = 0u;
        if constexpr (is_chain<Sched>::v) { h2_ = has_next && S.next(ui + 2, u2_); pk_ = S.peek(u2_, h2_, wid); }
        E(acc, cur, wr, wc, fr, fq);
        if constexpr (is_chain<Sched>::v) S.done(cur, lane);
        if (!has_next) break;
        if constexpr (is_chain<Sched>::v) S.a_ready(u2_, h2_, wid, pk_);
#pragma unroll
        for (int a = 0; a < 2; ++a)
#pragma unroll
            for (int b = 0; b < 2; ++b)
#pragma unroll
                for (int m = 0; m < 4; ++m)
#pragma unroll
                    for (int n = 0; n < 2; ++n) acc[a][b][m][n] = (f32x4){0.f, 0.f, 0.f, 0.f};
        cur = nxt; cA = nA; cB = nB; ++ui;
        if constexpr (ALIGN_EPI) { if (wr == 1) PG8_BAR; }
    }
    PG8_WAIT_V(0);
    if constexpr (!ALIGN_EPI) { if (wr == 0) PG8_BAR; }
    PG8_BAR;
#undef PG8_SA
#undef PG8_SB
#undef PG8_STAGE
#undef PG8_LDA
#undef PG8_LDB
#undef PG8_MMA
#undef PG8_WAIT_V
#undef PG8_WAIT_L
#undef PG8_BAR
#undef PG8_SCHED
}

template <int NS>
__device__ __forceinline__ void load_rstd8(const float* SS, int row0, int fq, int lane, float inv_n, float (&rs)[2][4]) {
#pragma unroll
    for (int ai = 0; ai < 2; ++ai)
#pragma unroll
        for (int m = 0; m < 4; ++m) { const float* p = SS + (size_t)(row0 + ai * HALF + m * 16) * NS + fq * (NS / 4); float s = 0.f;
#pragma unroll
            for (int j = 0; j < NS / 4; ++j) s += p[j];
            s += shx(s, 16, lane); s += shx(s, 32, lane); rs[ai][m] = rsqrtf(s * inv_n + RMS_EPS); }
}
constexpr int RC_OFF = 133120, RC_WAVE = 1024;
__device__ __forceinline__ void rstd8_cached(LAS float* rc, const float* SS, int pm, int row0, int fr, int fq, float (&rs)[2][4]) {
    const int tag = __builtin_amdgcn_readfirstlane(((LAS const int*)rc)[128]);
    if (tag == pm) {
#pragma unroll
        for (int ai = 0; ai < 2; ++ai)
#pragma unroll
            for (int m = 0; m < 4; ++m) rs[ai][m] = rc[ai * 64 + m * 16 + fr];
    } else {
        load_rstd8<32>(SS, row0, fq, fq * 16 + fr, 1.0f / DM, rs);
        if (fq == 0) {
#pragma unroll
            for (int ai = 0; ai < 2; ++ai)
#pragma unroll
                for (int m = 0; m < 4; ++m) rc[ai * 64 + m * 16 + fr] = rs[ai][m]; }
        if (fq * 16 + fr == 0) ((LAS int*)rc)[128] = pm;
    }
}
__device__ __forceinline__ float silu_mul(float g, float u) { return g * __builtin_amdgcn_rcpf(1.0f + __builtin_amdgcn_exp2f(-1.4426950408889634f * g)) * u; }

struct EpiSwiGLU {
    static constexpr bool PERM = true;
    bf16_t* H; const float* SS; LAS float* rc;
    __device__ __forceinline__ void operator()(const f32x4 (&acc)[2][2][4][2], const Unit& u, int wr, int wc, int fr, int fq) const {
        const int row0 = u.pm * BM + wr * 64 + fr, col0 = u.pn * HALF + wc * 32 + 8 * fq;
        float rs[2][4]; rstd8_cached(rc, SS, u.pm, row0, fr, fq, rs);
#pragma unroll
        for (int ai = 0; ai < 2; ++ai)
#pragma unroll
            for (int m = 0; m < 4; ++m) { const float r = rs[ai][m]; bf16_t* rowp = H + (size_t)(row0 + ai * HALF + m * 16) * FF + col0;
                const f32x4 g0 = acc[ai][0][m][0] * r, g1 = acc[ai][0][m][1] * r, u0 = acc[ai][1][m][0] * r, u1 = acc[ai][1][m][1] * r;
                u32x4 w; w.x = cvt_pk_bf16(silu_mul(g0[0], u0[0]), silu_mul(g0[1], u0[1])); w.y = cvt_pk_bf16(silu_mul(g0[2], u0[2]), silu_mul(g0[3], u0[3]));
                w.z = cvt_pk_bf16(silu_mul(g1[0], u1[0]), silu_mul(g1[1], u1[1])); w.w = cvt_pk_bf16(silu_mul(g1[2], u1[2]), silu_mul(g1[3], u1[3]));
                *(u32x4*)rowp = w; }
    }
};
struct EpiResid {
    static constexpr bool PERM = false;
    const float* Xin32; float* Xout32; bf16_t* XB; float* SS; float scale;
    __device__ __forceinline__ void operator()(const f32x4 (&acc)[2][2][4][2], const Unit& u, int wr, int wc, int fr, int fq) const {
        const int row0 = u.pm * BM + wr * 64 + fr, col0 = u.pn * BM + wc * 32 + 4 * fq;
#pragma unroll
        for (int ai = 0; ai < 2; ++ai) {
            f32x4 xo[4][2][2];
            if (Xin32 != nullptr) {
#pragma unroll
                for (int m = 0; m < 4; ++m)
#pragma unroll
                    for (int bj = 0; bj < 2; ++bj)
#pragma unroll
                        for (int n = 0; n < 2; ++n) xo[m][bj][n] = *(const f32x4*)(Xin32 + (size_t)(row0 + ai * HALF + m * 16) * DM + col0 + bj * HALF + n * 16);
            } else {
                u32x2 xr[4][2][2];
#pragma unroll
                for (int m = 0; m < 4; ++m)
#pragma unroll
                    for (int bj = 0; bj < 2; ++bj)
#pragma unroll
                        for (int n = 0; n < 2; ++n) xr[m][bj][n] = *(const u32x2*)(XB + (size_t)(row0 + ai * HALF + m * 16) * DM + col0 + bj * HALF + n * 16);
#pragma unroll
                for (int m = 0; m < 4; ++m)
#pragma unroll
                    for (int bj = 0; bj < 2; ++bj)
#pragma unroll
                        for (int n = 0; n < 2; ++n) { const u32x2 w = xr[m][bj][n];
                            xo[m][bj][n] = (f32x4){__uint_as_float(w.x << 16), __uint_as_float(w.x & 0xffff0000u), __uint_as_float(w.y << 16), __uint_as_float(w.y & 0xffff0000u)}; }
            }
            asm volatile("" ::: "memory");
#pragma unroll
            for (int m = 0; m < 4; ++m) { const int row = row0 + ai * HALF + m * 16; const size_t off = (size_t)row * DM + col0; float ss = 0.f;
#pragma unroll
                for (int bj = 0; bj < 2; ++bj)
#pragma unroll
                    for (int n = 0; n < 2; ++n) { const size_t o = off + bj * HALF + n * 16; const f32x4 xn = xo[m][bj][n] + acc[ai][bj][m][n] * scale;
                        if (Xout32 != nullptr) *(f32x4*)(Xout32 + o) = xn;
                        else { u32x2 w; w.x = cvt_pk_bf16(xn[0], xn[1]); w.y = cvt_pk_bf16(xn[2], xn[3]); *(u32x2*)(XB + o) = w; }
                        ss += (xn[0] * xn[0] + xn[1] * xn[1]) + (xn[2] * xn[2] + xn[3] * xn[3]); }
                ss += shx(ss, 16, fq * 16 + fr); ss += shx(ss, 32, fq * 16 + fr);
                if (fq == 0) SS[(size_t)row * 32 + u.pn * 4 + wc] = ss; }
        }
    }
};

constexpr float QSCALE_D = 0.08838834764831845f * 1.4426950408889634f;
constexpr float QSCALE_M = 0.07216878364870322f * 1.4426950408889634f;
template <int NS>
__device__ __forceinline__ void load_rstd8_lat(const float* SS16, int slot0, int row0, int fq, int lane, float inv_n, float (&rs)[2][4]) {
#pragma unroll
    for (int ai = 0; ai < 2; ++ai)
#pragma unroll
        for (int m = 0; m < 4; ++m) { const float* p = SS16 + (size_t)(row0 + ai * HALF + m * 16) * 16 + slot0 + fq * (NS / 4); float s = 0.f;
#pragma unroll
            for (int j = 0; j < NS / 4; ++j) s += p[j];
            s += shx(s, 16, lane); s += shx(s, 32, lane); rs[ai][m] = rsqrtf(s * inv_n + RMS_EPS); }
}
__device__ __forceinline__ u32x4 pack8f(const f32x4 a, const f32x4 b) { u32x4 w; w.x = cvt_pk_bf16(a[0], a[1]); w.y = cvt_pk_bf16(a[2], a[3]); w.z = cvt_pk_bf16(b[0], b[1]); w.w = cvt_pk_bf16(b[2], b[3]); return w; }
__device__ __forceinline__ void rope8(f32x4& a, f32x4& b, const float* cs, int pos, int i0) {
    const f32x4 t0 = *(const f32x4*)(cs + ((size_t)pos * 32 + i0) * 2), t1 = *(const f32x4*)(cs + ((size_t)pos * 32 + i0 + 2) * 2);
    const f32x4 x = a, y = b;
    a[0] = x[0] * t0[0] - x[1] * t0[1]; a[1] = x[1] * t0[0] + x[0] * t0[1]; a[2] = x[2] * t0[2] - x[3] * t0[3]; a[3] = x[3] * t0[2] + x[2] * t0[3];
    b[0] = y[0] * t1[0] - y[1] * t1[1]; b[1] = y[1] * t1[0] + y[0] * t1[1]; b[2] = y[2] * t1[2] - y[3] * t1[3]; b[3] = y[3] * t1[2] + y[2] * t1[3];
}
struct MixBufs { bf16_t *LAT, *DQ, *DK, *DV, *NQ, *NKV  , *MK; float *LATSS, *GATES; const float* ROPE; };
struct EpiMixIn {
    static constexpr bool PERM = true;
    MixBufs B; const float* SS; LAS float* rc;
    __device__ __forceinline__ void operator()(const f32x4 (&acc)[2][2][4][2], const Unit& u, int wr, int wc, int fr, int fq) const {
        const int row0 = u.pm * BM + wr * 64 + fr, cw = wc * 32 + 8 * fq, pn = u.pn;
        float rs[2][4]; rstd8_cached(rc, SS, u.pm, row0, fr, fq, rs);
#pragma unroll
        for (int ai = 0; ai < 2; ++ai)
#pragma unroll
            for (int m = 0; m < 4; ++m) { const float r = rs[ai][m]; const int row = row0 + ai * HALF + m * 16;
                f32x4 v00 = acc[ai][0][m][0] * r, v01 = acc[ai][0][m][1] * r, v10 = acc[ai][1][m][0] * r, v11 = acc[ai][1][m][1] * r;
                if (pn < 4) {
                    bf16_t* p = B.LAT + (size_t)row * LATW + pn * 256 + cw; *(u32x4*)p = pack8f(v00, v01); *(u32x4*)(p + HALF) = pack8f(v10, v11);
                    float ss = 0.f;
#pragma unroll
                    for (int e = 0; e < 4; ++e) ss += v00[e] * v00[e] + v01[e] * v01[e] + v10[e] * v10[e] + v11[e] * v11[e];
                    ss += shx(ss, 16, fq * 16 + fr); ss += shx(ss, 32, fq * 16 + fr);
                    if (fq == 0) B.LATSS[(size_t)row * 16 + pn * 4 + wc] = ss;
                } else if (pn < 13) {
                    const int t = pn - 4, seg = t / 3, c = (t - seg * 3) * 256 + cw; bf16_t* base = B.DQ + (size_t)seg * ((size_t)M * 768);
                    const float sc = seg == 0 ? QSCALE_D : 1.0f;
                    bf16_t* p = base + (size_t)row * 768 + c; *(u32x4*)p = pack8f(v00 * sc, v01 * sc); *(u32x4*)(p + HALF) = pack8f(v10 * sc, v11 * sc);
                } else if (pn < 15) {
                    bf16_t* p = B.NQ + (size_t)row * 512 + (pn - 13) * 256 + cw; *(u32x4*)p = pack8f(v00 * QSCALE_D, v01 * QSCALE_D); *(u32x4*)(p + HALF) = pack8f(v10 * QSCALE_D, v11 * QSCALE_D);
                } else if (pn < 18) {
                    bf16_t* p0 = B.NKV + (size_t)(2 * (pn - 15)) * ((size_t)M * 128) + (size_t)row * 128 + cw; *(u32x4*)p0 = pack8f(v00, v01);
                    *(u32x4*)(p0 + (size_t)M * 128) = pack8f(v10, v11);
                } else {
                    if (wc < 2) { rope8(v00, v01, B.ROPE, row & (SEQ - 1), cw >> 1); const u32x4 w = pack8f(v00, v01);
#pragma unroll
                        for (int h = 0; h < 6; ++h) *(u32x4*)(B.MK + (size_t)row * 1152 + h * 192 + 128 + cw) = w;
                    } else if (wc == 2 && fq < 2) {
                        float* gp = B.GATES + (size_t)row * 16 + 8 * fq; f32x4 s0, s1;
#pragma unroll
                        for (int e = 0; e < 4; ++e) { s0[e] = __builtin_amdgcn_rcpf(1.0f + __builtin_amdgcn_exp2f(-1.4426950408889634f * v00[e])); s1[e] = __builtin_amdgcn_rcpf(1.0f + __builtin_amdgcn_exp2f(-1.4426950408889634f * v01[e])); }
                        *(f32x4*)gp = s0; *(f32x4*)(gp + 4) = s1;
                    }
                }
            }
    }
};
struct EpiUp {
    static constexpr bool PERM = true;
    bf16_t *MQ, *MK, *MV; const float* LATSS; const float* ROPE;
    __device__ __forceinline__ void operator()(const f32x4 (&acc)[2][2][4][2], const Unit& u, int wr, int wc, int fr, int fq) const {
        const int row0 = u.pm * BM + wr * 64 + fr, cw = wc * 32 + 8 * fq, pn = u.pn;
        float rs[2][4]; load_rstd8_lat<8>(LATSS, pn < 5 ? 0 : 8, row0, fq, fq * 16 + fr, 1.0f / 512.0f, rs);
#pragma unroll
        for (int ai = 0; ai < 2; ++ai)
#pragma unroll
            for (int m = 0; m < 4; ++m) { const int row = row0 + ai * HALF + m * 16;
                if (pn < 5) { const float r = rs[ai][m] * QSCALE_M;
#pragma unroll
                    for (int bj = 0; bj < 2; ++bj) { const int c = pn * 256 + bj * HALF + cw; if (c < 1152) { f32x4 a = acc[ai][bj][m][0] * r, b = acc[ai][bj][m][1] * r; const int w = c % 192;
                        if (w >= 128) rope8(a, b, ROPE, row & (SEQ - 1), (w - 128) >> 1);
                        *(u32x4*)(MQ + (size_t)row * 1152 + c) = pack8f(a, b); } }
                } else { const float r = rs[ai][m]; const int h = pn - 5;
                    *(u32x4*)(MK + (size_t)row * 1152 + h * 192 + cw) = pack8f(acc[ai][0][m][0] * r, acc[ai][0][m][1] * r);
                    *(u32x4*)(MV + (size_t)row * 768 + h * 128 + cw) = pack8f(acc[ai][1][m][0] * r, acc[ai][1][m][1] * r); }
            }
    }
};
struct EpiCmp {
    static constexpr bool PERM = true;
    bf16_t* H1; const float* CB;
    __device__ __forceinline__ void operator()(const f32x4 (&acc)[2][2][4][2], const Unit& u, int wr, int wc, int fr, int fq) const {
        const int row0 = u.pm * BM + wr * 64 + fr, cw = wc * 32 + 8 * fq;
        const f32x4 b0 = *(const f32x4*)(CB + cw), b1 = *(const f32x4*)(CB + cw + 4);
#pragma unroll
        for (int ai = 0; ai < 2; ++ai)
#pragma unroll
            for (int m = 0; m < 4; ++m) { const int row = row0 + ai * HALF + m * 16; f32x4 a = acc[ai][0][m][0] + b0, b = acc[ai][0][m][1] + b1;
#pragma unroll
                for (int e = 0; e < 4; ++e) { a[e] = silu_mul(a[e], 1.0f); b[e] = silu_mul(b[e], 1.0f); }
                *(u32x4*)(H1 + (size_t)row * 128 + cw) = pack8f(a, b); }
    }
};
}


namespace att {
#ifndef DIL_DMA
#define DIL_DMA true
#endif
constexpr int SHM_V = 16384;
constexpr float THR2 = 11.5f;
#define SBAR() __builtin_amdgcn_sched_barrier(0)
__device__ __forceinline__ int v_st(int k, int c) { const int kk = (k & ~0xC) | ((k & 4) << 1) | ((k & 8) >> 1); return ((kk >> 3) * 4 + (c >> 5)) * 512 + ((kk & 7) * 32 + (c & 31)) * 2; }
__device__ __forceinline__ int v_rd_base(int lane) { return ((lane & 3) << 3) | (((lane >> 2) & 3) << 6) | (((lane >> 4) & 1) << 5) | (((lane >> 5) & 1) << 8); }
constexpr int v_rd_off(int d0, int ks, int half) { return d0 * 512 + ks * 4096 + half * 2048; }
__device__ __forceinline__ int crow(int r, int hi) { return (r & 3) + 8 * (r >> 2) + 4 * hi; }
__device__ __forceinline__ void mask_tile(f32x16& p0, f32x16& p1, int dq, unsigned W) {
    const float NEG = -__builtin_inff();
#pragma unroll
    for (int r = 0; r < 16; ++r) { const int c = (r & 3) + 8 * (r >> 2);
        if ((unsigned)(dq - c) >= W) p0[r] = NEG;
        if ((unsigned)(dq - c - 32) >= W) p1[r] = NEG; }
}
__device__ __forceinline__ void bias_tile(f32x16& p0, f32x16& p1, int dq, float sl2) {
    const float base = -sl2 * (float)dq;
#pragma unroll
    for (int r = 0; r < 16; ++r) { const int c = (r & 3) + 8 * (r >> 2); p0[r] += fmaf(sl2, (float)c, base); p1[r] += fmaf(sl2, (float)(c + 32), base); }
}
template <bool FIXEDM>
__device__ __forceinline__ void partialSM(f32x16& p0, f32x16& p1, float& m_reg, float& mn, float& alpha) {
    if constexpr (FIXEDM) { mn = m_reg; alpha = 1.f; }
    else {
        float pmax = p0[0];
#pragma unroll
        for (int r = 1; r < 16; ++r) pmax = fmaxf(pmax, p0[r]);
#pragma unroll
        for (int r = 0; r < 16; ++r) pmax = fmaxf(pmax, p1[r]);
        { auto rr = __builtin_amdgcn_permlane32_swap(__float_as_uint(pmax), __float_as_uint(pmax), false, false); pmax = fmaxf(__uint_as_float(rr[0]), __uint_as_float(rr[1])); }
        if (__builtin_expect(__all(pmax - m_reg <= THR2), 1)) { mn = m_reg; alpha = 1.f; }
        else { mn = fmaxf(m_reg, pmax); alpha = __builtin_amdgcn_exp2f(m_reg - mn); m_reg = mn; }
    }
#pragma unroll
    for (int r = 0; r < 16; ++r) { p0[r] -= mn; p1[r] -= mn; }
#pragma unroll
    for (int r = 0; r < 16; ++r) p0[r] = __builtin_amdgcn_exp2f(p0[r]);
}
__device__ __forceinline__ void finishSM_exp(f32x16& p0, f32x16& p1, float alpha, float& l_reg) {
#pragma unroll
    for (int r = 0; r < 16; ++r) p1[r] = __builtin_amdgcn_exp2f(p1[r]);
    float ps = 0;
#pragma unroll
    for (int r = 0; r < 16; ++r) ps += p0[r];
#pragma unroll
    for (int r = 0; r < 16; ++r) ps += p1[r];
    { auto rr = __builtin_amdgcn_permlane32_swap(__float_as_uint(ps), __float_as_uint(ps), false, false); ps = __uint_as_float(rr[0]) + __uint_as_float(rr[1]); }
    l_reg = l_reg * alpha + ps;
}
__device__ __forceinline__ void finishSM_pack(const f32x16& p0, const f32x16& p1, bf16x8& pa0, bf16x8& pa1, bf16x8& pa2, bf16x8& pa3) {
#define PK4(P, B_, OUT) do { unsigned a0 = cvt_pk_bf16(P[B_+0], P[B_+1]), a1 = cvt_pk_bf16(P[B_+2], P[B_+3]); unsigned b0 = cvt_pk_bf16(P[B_+4], P[B_+5]), b1 = cvt_pk_bf16(P[B_+6], P[B_+7]); \
        auto r0 = __builtin_amdgcn_permlane32_swap(a0, b0, false, false); auto r1 = __builtin_amdgcn_permlane32_swap(a1, b1, false, false); \
        u32x4 w = {r0[0], r1[0], r0[1], r1[1]}; OUT = *reinterpret_cast<bf16x8*>(&w); } while (0)
    PK4(p0, 0, pa0); PK4(p0, 8, pa1); PK4(p1, 0, pa2); PK4(p1, 8, pa3);
#undef PK4
}
template <int DQK> __device__ __forceinline__ int kswz(int r) { return DQK == 192 ? ((r >> 1) & 7) : (r & 7); }
template <int KB, int DQK, int NQR>
__device__ __forceinline__ void qkt(f32x16& p0, f32x16& p1, LAS const unsigned char* K_lds, int r32, int hi, const bf16x8* qr, LAS const unsigned char* qlds, bool act) {
    constexpr int KROWB = DQK * 2, SHM_K = 64 * KROWB;
    if (!act) { const float NEG = -__builtin_inff();
#pragma unroll
        for (int r = 0; r < 16; ++r) { p0[r] = NEG; p1[r] = NEG; } return; }
    p0 = f32x16{}; p1 = f32x16{};
    if constexpr (NQR == DQK / 16) {
        constexpr int NF = DQK / 8;
        int r_ = r32; asm volatile("" : "+v"(r_));
        const int rowa = (int)(uintptr_t)(K_lds + KB * SHM_K) + r_ * KROWB, xr = kswz<DQK>(r_) << 4;
        int kbA[4];
#pragma unroll
        for (int dd = 0; dd < 4; ++dd) kbA[dd] = rowa + (((dd * 16 + hi * 8) * 2) ^ xr);
#define KADDR(f) "v"(kbA[((f) >> 1) & 3]), "i"((((f) >> 1) >> 2) * 128 + ((f) & 1) * 32 * KROWB)
#define KRD0(dst, f) asm volatile("ds_read_b128 %0, %1 offset:%2" : "=&v"(dst) : KADDR(f) : "memory")
#define KRDP(dst, f, P) asm volatile("ds_read_b128 %0, %2 offset:%3" : "=&v"(dst), "+v"(P) : KADDR(f) : "memory")
#define KWAIT(n, F) asm volatile("s_waitcnt lgkmcnt(%1)" : "+v"(F) : "i"(n) : "memory")
        bf16x8 F0, F1, F2, F3;
        KRD0(F0, 0); KRD0(F1, 1); KRD0(F2, 2); KRD0(F3, 3);
    if constexpr (0 < NF) { KWAIT((NF - 1 - 0) < 3 ? (NF - 1 - 0) : 3, F0); p0 = __builtin_amdgcn_mfma_f32_32x32x16_bf16(F0, qr[0], p0, 0, 0, 0); if constexpr (0 + 4 < NF) KRDP(F0, 0 + 4, p0); }
    if constexpr (1 < NF) { KWAIT((NF - 1 - 1) < 3 ? (NF - 1 - 1) : 3, F1); p1 = __builtin_amdgcn_mfma_f32_32x32x16_bf16(F1, qr[0], p1, 0, 0, 0); if constexpr (1 + 4 < NF) KRDP(F1, 1 + 4, p1); }
    if constexpr (2 < NF) { KWAIT((NF - 1 - 2) < 3 ? (NF - 1 - 2) : 3, F2); p0 = __builtin_amdgcn_mfma_f32_32x32x16_bf16(F2, qr[1], p0, 0, 0, 0); if constexpr (2 + 4 < NF) KRDP(F2, 2 + 4, p0); }
    if constexpr (3 < NF) { KWAIT((NF - 1 - 3) < 3 ? (NF - 1 - 3) : 3, F3); p1 = __builtin_amdgcn_mfma_f32_32x32x16_bf16(F3, qr[1], p1, 0, 0, 0); if constexpr (3 + 4 < NF) KRDP(F3, 3 + 4, p1); }
    if constexpr (4 < NF) { KWAIT((NF - 1 - 4) < 3 ? (NF - 1 - 4) : 3, F0); p0 = __builtin_amdgcn_mfma_f32_32x32x16_bf16(F0, qr[2], p0, 0, 0, 0); if constexpr (4 + 4 < NF) KRDP(F0, 4 + 4, p0); }
    if constexpr (5 < NF) { KWAIT((NF - 1 - 5) < 3 ? (NF - 1 - 5) : 3, F1); p1 = __builtin_amdgcn_mfma_f32_32x32x16_bf16(F1, qr[2], p1, 0, 0, 0); if constexpr (5 + 4 < NF) KRDP(F1, 5 + 4, p1); }
    if constexpr (6 < NF) { KWAIT((NF - 1 - 6) < 3 ? (NF - 1 - 6) : 3, F2); p0 = __builtin_amdgcn_mfma_f32_32x32x16_bf16(F2, qr[3], p0, 0, 0, 0); if constexpr (6 + 4 < NF) KRDP(F2, 6 + 4, p0); }
    if constexpr (7 < NF) { KWAIT((NF - 1 - 7) < 3 ? (NF - 1 - 7) : 3, F3); p1 = __builtin_amdgcn_mfma_f32_32x32x16_bf16(F3, qr[3], p1, 0, 0, 0); if constexpr (7 + 4 < NF) KRDP(F3, 7 + 4, p1); }
    if constexpr (8 < NF) { KWAIT((NF - 1 - 8) < 3 ? (NF - 1 - 8) : 3, F0); p0 = __builtin_amdgcn_mfma_f32_32x32x16_bf16(F0, qr[4], p0, 0, 0, 0); if constexpr (8 + 4 < NF) KRDP(F0, 8 + 4, p0); }
    if constexpr (9 < NF) { KWAIT((NF - 1 - 9) < 3 ? (NF - 1 - 9) : 3, F1); p1 = __builtin_amdgcn_mfma_f32_32x32x16_bf16(F1, qr[4], p1, 0, 0, 0); if constexpr (9 + 4 < NF) KRDP(F1, 9 + 4, p1); }
    if constexpr (10 < NF) { KWAIT((NF - 1 - 10) < 3 ? (NF - 1 - 10) : 3, F2); p0 = __builtin_amdgcn_mfma_f32_32x32x16_bf16(F2, qr[5], p0, 0, 0, 0); if constexpr (10 + 4 < NF) KRDP(F2, 10 + 4, p0); }
    if constexpr (11 < NF) { KWAIT((NF - 1 - 11) < 3 ? (NF - 1 - 11) : 3, F3); p1 = __builtin_amdgcn_mfma_f32_32x32x16_bf16(F3, qr[5], p1, 0, 0, 0); if constexpr (11 + 4 < NF) KRDP(F3, 11 + 4, p1); }
    if constexpr (12 < NF) { KWAIT((NF - 1 - 12) < 3 ? (NF - 1 - 12) : 3, F0); p0 = __builtin_amdgcn_mfma_f32_32x32x16_bf16(F0, qr[6], p0, 0, 0, 0); if constexpr (12 + 4 < NF) KRDP(F0, 12 + 4, p0); }
    if constexpr (13 < NF) { KWAIT((NF - 1 - 13) < 3 ? (NF - 1 - 13) : 3, F1); p1 = __builtin_amdgcn_mfma_f32_32x32x16_bf16(F1, qr[6], p1, 0, 0, 0); if constexpr (13 + 4 < NF) KRDP(F1, 13 + 4, p1); }
    if constexpr (14 < NF) { KWAIT((NF - 1 - 14) < 3 ? (NF - 1 - 14) : 3, F2); p0 = __builtin_amdgcn_mfma_f32_32x32x16_bf16(F2, qr[7], p0, 0, 0, 0); if constexpr (14 + 4 < NF) KRDP(F2, 14 + 4, p0); }
    if constexpr (15 < NF) { KWAIT((NF - 1 - 15) < 3 ? (NF - 1 - 15) : 3, F3); p1 = __builtin_amdgcn_mfma_f32_32x32x16_bf16(F3, qr[7], p1, 0, 0, 0); if constexpr (15 + 4 < NF) KRDP(F3, 15 + 4, p1); }
    if constexpr (16 < NF) { KWAIT((NF - 1 - 16) < 3 ? (NF - 1 - 16) : 3, F0); p0 = __builtin_amdgcn_mfma_f32_32x32x16_bf16(F0, qr[8], p0, 0, 0, 0); if constexpr (16 + 4 < NF) KRDP(F0, 16 + 4, p0); }
    if constexpr (17 < NF) { KWAIT((NF - 1 - 17) < 3 ? (NF - 1 - 17) : 3, F1); p1 = __builtin_amdgcn_mfma_f32_32x32x16_bf16(F1, qr[8], p1, 0, 0, 0); if constexpr (17 + 4 < NF) KRDP(F1, 17 + 4, p1); }
    if constexpr (18 < NF) { KWAIT((NF - 1 - 18) < 3 ? (NF - 1 - 18) : 3, F2); p0 = __builtin_amdgcn_mfma_f32_32x32x16_bf16(F2, qr[9], p0, 0, 0, 0); if constexpr (18 + 4 < NF) KRDP(F2, 18 + 4, p0); }
    if constexpr (19 < NF) { KWAIT((NF - 1 - 19) < 3 ? (NF - 1 - 19) : 3, F3); p1 = __builtin_amdgcn_mfma_f32_32x32x16_bf16(F3, qr[9], p1, 0, 0, 0); if constexpr (19 + 4 < NF) KRDP(F3, 19 + 4, p1); }
    if constexpr (20 < NF) { KWAIT((NF - 1 - 20) < 3 ? (NF - 1 - 20) : 3, F0); p0 = __builtin_amdgcn_mfma_f32_32x32x16_bf16(F0, qr[10], p0, 0, 0, 0); if constexpr (20 + 4 < NF) KRDP(F0, 20 + 4, p0); }
    if constexpr (21 < NF) { KWAIT((NF - 1 - 21) < 3 ? (NF - 1 - 21) : 3, F1); p1 = __builtin_amdgcn_mfma_f32_32x32x16_bf16(F1, qr[10], p1, 0, 0, 0); if constexpr (21 + 4 < NF) KRDP(F1, 21 + 4, p1); }
    if constexpr (22 < NF) { KWAIT((NF - 1 - 22) < 3 ? (NF - 1 - 22) : 3, F2); p0 = __builtin_amdgcn_mfma_f32_32x32x16_bf16(F2, qr[11], p0, 0, 0, 0); if constexpr (22 + 4 < NF) KRDP(F2, 22 + 4, p0); }
    if constexpr (23 < NF) { KWAIT((NF - 1 - 23) < 3 ? (NF - 1 - 23) : 3, F3); p1 = __builtin_amdgcn_mfma_f32_32x32x16_bf16(F3, qr[11], p1, 0, 0, 0); if constexpr (23 + 4 < NF) KRDP(F3, 23 + 4, p1); }
#undef KRD0
#undef KRDP
#undef KADDR
#undef KWAIT
    } else {
    LAS const unsigned char* kb[4];
#pragma unroll
    for (int dd = 0; dd < 4; ++dd) kb[dd] = K_lds + KB * SHM_K + r32 * KROWB + (((dd * 16 + hi * 8) * 2) ^ (kswz<DQK>(r32) << 4));
#pragma unroll
    for (int d0 = 0; d0 < DQK / 16; ++d0) { LAS const unsigned char* a = kb[d0 & 3] + (d0 >> 2) * 128;
        bf16x8 b0 = *reinterpret_cast<LAS const bf16x8*>(a);
        bf16x8 b1 = *reinterpret_cast<LAS const bf16x8*>(a + 32 * KROWB);
        bf16x8 q; if (d0 < NQR) q = qr[d0]; else q = *reinterpret_cast<LAS const bf16x8*>(qlds + (d0 - NQR) * 1024);
        p0 = __builtin_amdgcn_mfma_f32_32x32x16_bf16(b0, q, p0, 0, 0, 0);
        p1 = __builtin_amdgcn_mfma_f32_32x32x16_bf16(b1, q, p1, 0, 0, 0); }
    }
}
template <int C>
__device__ __forceinline__ void fin_item(f32x16& y0, f32x16& y1, float& ps0, float& ps1, unsigned (&wv)[16]) {
    if constexpr (C < 16) { const float e = __builtin_amdgcn_exp2f(y1[C]); y1[C] = e; ps0 += y0[C]; ps1 += e; }
    else { constexpr int j = C - 16, q = j >> 1, h = j & 1, B_ = (q & 1) * 8 + 2 * h; unsigned a, b;
        if constexpr (q < 2) { a = cvt_pk_bf16(y0[B_], y0[B_ + 1]); b = cvt_pk_bf16(y0[B_ + 4], y0[B_ + 5]); } else { a = cvt_pk_bf16(y1[B_], y1[B_ + 1]); b = cvt_pk_bf16(y1[B_ + 4], y1[B_ + 5]); }
        auto r = __builtin_amdgcn_permlane32_swap(a, b, false, false); wv[q * 4 + h] = r[0]; wv[q * 4 + 2 + h] = r[1];
        asm volatile("" : "+v"(wv[q * 4 + h]), "+v"(wv[q * 4 + 2 + h])); }
}
template <int A, int B>
__device__ __forceinline__ void fin_range(f32x16& y0, f32x16& y1, float& ps0, float& ps1, unsigned (&wv)[16]) { if constexpr (A < B) { fin_item<A>(y0, y1, ps0, ps1, wv); fin_range<A + 1, B>(y0, y1, ps0, ps1, wv); } }
template <int KB, int DQK, class DMF>
__device__ __forceinline__ void qkt_fin(f32x16& p0, f32x16& p1, LAS const unsigned char* K_lds, int r32, int hi, const bf16x8* qr, bool act,
                                        f32x16& y0, f32x16& y1, float alpha, float& l_reg, bf16x8& pa0, bf16x8& pa1, bf16x8& pa2, bf16x8& pa3, const DMF& dm) {
    if (!act) { _Pragma("unroll") for (int f_ = 0; f_ < DQK / 8; ++f_) dm(f_); qkt<KB, DQK, DQK / 16>(p0, p1, K_lds, r32, hi, qr, nullptr, false); finishSM_exp(y0, y1, alpha, l_reg); finishSM_pack(y0, y1, pa0, pa1, pa2, pa3); return; }
    constexpr int KROWB = DQK * 2, SHM_K = 64 * KROWB, NF = DQK / 8;
    p0 = f32x16{}; p1 = f32x16{};
    int r_ = r32; asm volatile("" : "+v"(r_));
    const int rowa = (int)(uintptr_t)(K_lds + KB * SHM_K) + r_ * KROWB, xr = kswz<DQK>(r_) << 4;
    int kbA[4];
#pragma unroll
    for (int dd = 0; dd < 4; ++dd) kbA[dd] = rowa + (((dd * 16 + hi * 8) * 2) ^ xr);
    float ps0 = 0.f, ps1 = 0.f; unsigned wv[16];
#define KADDR(f) "v"(kbA[((f) >> 1) & 3]), "i"((((f) >> 1) >> 2) * 128 + ((f) & 1) * 32 * KROWB)
#define KRD0(dst, f) asm volatile("ds_read_b128 %0, %1 offset:%2" : "=&v"(dst) : KADDR(f) : "memory")
#define KRDP(dst, f, P) asm volatile("ds_read_b128 %0, %2 offset:%3" : "=&v"(dst), "+v"(P) : KADDR(f) : "memory")
#define KWAIT(n, F) asm volatile("s_waitcnt lgkmcnt(%1)" : "+v"(F) : "i"(n) : "memory")
#define FTIE(P) asm volatile("" : "+v"(y0), "+v"(y1), "+v"(ps0), "+v"(ps1), "+v"(P))
    bf16x8 F0, F1, F2, F3;
    KRD0(F0, 0); KRD0(F1, 1); KRD0(F2, 2); KRD0(F3, 3);
    if constexpr (0 < NF) { KWAIT((NF - 1 - 0) < 3 ? (NF - 1 - 0) : 3, F0); p0 = __builtin_amdgcn_mfma_f32_32x32x16_bf16(F0, qr[0], p0, 0, 0, 0); if constexpr (0 + 4 < NF) KRDP(F0, 0 + 4, p0); fin_range<(0 * 24) / NF, ((0 + 1) * 24) / NF>(y0, y1, ps0, ps1, wv); FTIE(p0); dm(0); }
    if constexpr (1 < NF) { KWAIT((NF - 1 - 1) < 3 ? (NF - 1 - 1) : 3, F1); p1 = __builtin_amdgcn_mfma_f32_32x32x16_bf16(F1, qr[0], p1, 0, 0, 0); if constexpr (1 + 4 < NF) KRDP(F1, 1 + 4, p1); fin_range<(1 * 24) / NF, ((1 + 1) * 24) / NF>(y0, y1, ps0, ps1, wv); FTIE(p1); dm(1); }
    if constexpr (2 < NF) { KWAIT((NF - 1 - 2) < 3 ? (NF - 1 - 2) : 3, F2); p0 = __builtin_amdgcn_mfma_f32_32x32x16_bf16(F2, qr[1], p0, 0, 0, 0); if constexpr (2 + 4 < NF) KRDP(F2, 2 + 4, p0); fin_range<(2 * 24) / NF, ((2 + 1) * 24) / NF>(y0, y1, ps0, ps1, wv); FTIE(p0); dm(2); }
    if constexpr (3 < NF) { KWAIT((NF - 1 - 3) < 3 ? (NF - 1 - 3) : 3, F3); p1 = __builtin_amdgcn_mfma_f32_32x32x16_bf16(F3, qr[1], p1, 0, 0, 0); if constexpr (3 + 4 < NF) KRDP(F3, 3 + 4, p1); fin_range<(3 * 24) / NF, ((3 + 1) * 24) / NF>(y0, y1, ps0, ps1, wv); FTIE(p1); dm(3); }
    if constexpr (4 < NF) { KWAIT((NF - 1 - 4) < 3 ? (NF - 1 - 4) : 3, F0); p0 = __builtin_amdgcn_mfma_f32_32x32x16_bf16(F0, qr[2], p0, 0, 0, 0); if constexpr (4 + 4 < NF) KRDP(F0, 4 + 4, p0); fin_range<(4 * 24) / NF, ((4 + 1) * 24) / NF>(y0, y1, ps0, ps1, wv); FTIE(p0); dm(4); }
    if constexpr (5 < NF) { KWAIT((NF - 1 - 5) < 3 ? (NF - 1 - 5) : 3, F1); p1 = __builtin_amdgcn_mfma_f32_32x32x16_bf16(F1, qr[2], p1, 0, 0, 0); if constexpr (5 + 4 < NF) KRDP(F1, 5 + 4, p1); fin_range<(5 * 24) / NF, ((5 + 1) * 24) / NF>(y0, y1, ps0, ps1, wv); FTIE(p1); dm(5); }
    if constexpr (6 < NF) { KWAIT((NF - 1 - 6) < 3 ? (NF - 1 - 6) : 3, F2); p0 = __builtin_amdgcn_mfma_f32_32x32x16_bf16(F2, qr[3], p0, 0, 0, 0); if constexpr (6 + 4 < NF) KRDP(F2, 6 + 4, p0); fin_range<(6 * 24) / NF, ((6 + 1) * 24) / NF>(y0, y1, ps0, ps1, wv); FTIE(p0); dm(6); }
    if constexpr (7 < NF) { KWAIT((NF - 1 - 7) < 3 ? (NF - 1 - 7) : 3, F3); p1 = __builtin_amdgcn_mfma_f32_32x32x16_bf16(F3, qr[3], p1, 0, 0, 0); if constexpr (7 + 4 < NF) KRDP(F3, 7 + 4, p1); fin_range<(7 * 24) / NF, ((7 + 1) * 24) / NF>(y0, y1, ps0, ps1, wv); FTIE(p1); dm(7); }
    if constexpr (8 < NF) { KWAIT((NF - 1 - 8) < 3 ? (NF - 1 - 8) : 3, F0); p0 = __builtin_amdgcn_mfma_f32_32x32x16_bf16(F0, qr[4], p0, 0, 0, 0); if constexpr (8 + 4 < NF) KRDP(F0, 8 + 4, p0); fin_range<(8 * 24) / NF, ((8 + 1) * 24) / NF>(y0, y1, ps0, ps1, wv); FTIE(p0); dm(8); }
    if constexpr (9 < NF) { KWAIT((NF - 1 - 9) < 3 ? (NF - 1 - 9) : 3, F1); p1 = __builtin_amdgcn_mfma_f32_32x32x16_bf16(F1, qr[4], p1, 0, 0, 0); if constexpr (9 + 4 < NF) KRDP(F1, 9 + 4, p1); fin_range<(9 * 24) / NF, ((9 + 1) * 24) / NF>(y0, y1, ps0, ps1, wv); FTIE(p1); dm(9); }
    if constexpr (10 < NF) { KWAIT((NF - 1 - 10) < 3 ? (NF - 1 - 10) : 3, F2); p0 = __builtin_amdgcn_mfma_f32_32x32x16_bf16(F2, qr[5], p0, 0, 0, 0); if constexpr (10 + 4 < NF) KRDP(F2, 10 + 4, p0); fin_range<(10 * 24) / NF, ((10 + 1) * 24) / NF>(y0, y1, ps0, ps1, wv); FTIE(p0); dm(10); }
    if constexpr (11 < NF) { KWAIT((NF - 1 - 11) < 3 ? (NF - 1 - 11) : 3, F3); p1 = __builtin_amdgcn_mfma_f32_32x32x16_bf16(F3, qr[5], p1, 0, 0, 0); if constexpr (11 + 4 < NF) KRDP(F3, 11 + 4, p1); fin_range<(11 * 24) / NF, ((11 + 1) * 24) / NF>(y0, y1, ps0, ps1, wv); FTIE(p1); dm(11); }
    if constexpr (12 < NF) { KWAIT((NF - 1 - 12) < 3 ? (NF - 1 - 12) : 3, F0); p0 = __builtin_amdgcn_mfma_f32_32x32x16_bf16(F0, qr[6], p0, 0, 0, 0); if constexpr (12 + 4 < NF) KRDP(F0, 12 + 4, p0); fin_range<(12 * 24) / NF, ((12 + 1) * 24) / NF>(y0, y1, ps0, ps1, wv); FTIE(p0); dm(12); }
    if constexpr (13 < NF) { KWAIT((NF - 1 - 13) < 3 ? (NF - 1 - 13) : 3, F1); p1 = __builtin_amdgcn_mfma_f32_32x32x16_bf16(F1, qr[6], p1, 0, 0, 0); if constexpr (13 + 4 < NF) KRDP(F1, 13 + 4, p1); fin_range<(13 * 24) / NF, ((13 + 1) * 24) / NF>(y0, y1, ps0, ps1, wv); FTIE(p1); dm(13); }
    if constexpr (14 < NF) { KWAIT((NF - 1 - 14) < 3 ? (NF - 1 - 14) : 3, F2); p0 = __builtin_amdgcn_mfma_f32_32x32x16_bf16(F2, qr[7], p0, 0, 0, 0); if constexpr (14 + 4 < NF) KRDP(F2, 14 + 4, p0); fin_range<(14 * 24) / NF, ((14 + 1) * 24) / NF>(y0, y1, ps0, ps1, wv); FTIE(p0); dm(14); }
    if constexpr (15 < NF) { KWAIT((NF - 1 - 15) < 3 ? (NF - 1 - 15) : 3, F3); p1 = __builtin_amdgcn_mfma_f32_32x32x16_bf16(F3, qr[7], p1, 0, 0, 0); if constexpr (15 + 4 < NF) KRDP(F3, 15 + 4, p1); fin_range<(15 * 24) / NF, ((15 + 1) * 24) / NF>(y0, y1, ps0, ps1, wv); FTIE(p1); dm(15); }
    if constexpr (16 < NF) { KWAIT((NF - 1 - 16) < 3 ? (NF - 1 - 16) : 3, F0); p0 = __builtin_amdgcn_mfma_f32_32x32x16_bf16(F0, qr[8], p0, 0, 0, 0); if constexpr (16 + 4 < NF) KRDP(F0, 16 + 4, p0); fin_range<(16 * 24) / NF, ((16 + 1) * 24) / NF>(y0, y1, ps0, ps1, wv); FTIE(p0); dm(16); }
    if constexpr (17 < NF) { KWAIT((NF - 1 - 17) < 3 ? (NF - 1 - 17) : 3, F1); p1 = __builtin_amdgcn_mfma_f32_32x32x16_bf16(F1, qr[8], p1, 0, 0, 0); if constexpr (17 + 4 < NF) KRDP(F1, 17 + 4, p1); fin_range<(17 * 24) / NF, ((17 + 1) * 24) / NF>(y0, y1, ps0, ps1, wv); FTIE(p1); dm(17); }
    if constexpr (18 < NF) { KWAIT((NF - 1 - 18) < 3 ? (NF - 1 - 18) : 3, F2); p0 = __builtin_amdgcn_mfma_f32_32x32x16_bf16(F2, qr[9], p0, 0, 0, 0); if constexpr (18 + 4 < NF) KRDP(F2, 18 + 4, p0); fin_range<(18 * 24) / NF, ((18 + 1) * 24) / NF>(y0, y1, ps0, ps1, wv); FTIE(p0); dm(18); }
    if constexpr (19 < NF) { KWAIT((NF - 1 - 19) < 3 ? (NF - 1 - 19) : 3, F3); p1 = __builtin_amdgcn_mfma_f32_32x32x16_bf16(F3, qr[9], p1, 0, 0, 0); if constexpr (19 + 4 < NF) KRDP(F3, 19 + 4, p1); fin_range<(19 * 24) / NF, ((19 + 1) * 24) / NF>(y0, y1, ps0, ps1, wv); FTIE(p1); dm(19); }
    if constexpr (20 < NF) { KWAIT((NF - 1 - 20) < 3 ? (NF - 1 - 20) : 3, F0); p0 = __builtin_amdgcn_mfma_f32_32x32x16_bf16(F0, qr[10], p0, 0, 0, 0); if constexpr (20 + 4 < NF) KRDP(F0, 20 + 4, p0); fin_range<(20 * 24) / NF, ((20 + 1) * 24) / NF>(y0, y1, ps0, ps1, wv); FTIE(p0); dm(20); }
    if constexpr (21 < NF) { KWAIT((NF - 1 - 21) < 3 ? (NF - 1 - 21) : 3, F1); p1 = __builtin_amdgcn_mfma_f32_32x32x16_bf16(F1, qr[10], p1, 0, 0, 0); if constexpr (21 + 4 < NF) KRDP(F1, 21 + 4, p1); fin_range<(21 * 24) / NF, ((21 + 1) * 24) / NF>(y0, y1, ps0, ps1, wv); FTIE(p1); dm(21); }
    if constexpr (22 < NF) { KWAIT((NF - 1 - 22) < 3 ? (NF - 1 - 22) : 3, F2); p0 = __builtin_amdgcn_mfma_f32_32x32x16_bf16(F2, qr[11], p0, 0, 0, 0); if constexpr (22 + 4 < NF) KRDP(F2, 22 + 4, p0); fin_range<(22 * 24) / NF, ((22 + 1) * 24) / NF>(y0, y1, ps0, ps1, wv); FTIE(p0); dm(22); }
    if constexpr (23 < NF) { KWAIT((NF - 1 - 23) < 3 ? (NF - 1 - 23) : 3, F3); p1 = __builtin_amdgcn_mfma_f32_32x32x16_bf16(F3, qr[11], p1, 0, 0, 0); if constexpr (23 + 4 < NF) KRDP(F3, 23 + 4, p1); fin_range<(23 * 24) / NF, ((23 + 1) * 24) / NF>(y0, y1, ps0, ps1, wv); FTIE(p1); dm(23); }
#undef KADDR
#undef KRD0
#undef KRDP
#undef KWAIT
#undef FTIE
    float ps = ps0 + ps1;
    { auto rr = __builtin_amdgcn_permlane32_swap(__float_as_uint(ps), __float_as_uint(ps), false, false); ps = __uint_as_float(rr[0]) + __uint_as_float(rr[1]); }
    l_reg = l_reg * alpha + ps;
    { u32x4 w = {wv[0], wv[1], wv[2], wv[3]}; pa0 = *reinterpret_cast<bf16x8*>(&w); } { u32x4 w = {wv[4], wv[5], wv[6], wv[7]}; pa1 = *reinterpret_cast<bf16x8*>(&w); }
    { u32x4 w = {wv[8], wv[9], wv[10], wv[11]}; pa2 = *reinterpret_cast<bf16x8*>(&w); } { u32x4 w = {wv[12], wv[13], wv[14], wv[15]}; pa3 = *reinterpret_cast<bf16x8*>(&w); }
}
template <int VB>
__device__ __forceinline__ void pv_tile(f32x16* o, int vb0, bf16x8 pa0, bf16x8 pa1, bf16x8 pa2, bf16x8 pa3, bool act) {
    if (!act) return;
#define TRRD(dst, off) asm volatile("ds_read_b64_tr_b16 %0, %1 offset:%2" : "=&v"(dst) : "v"(vb0), "i"(off) : "memory")
#define PV_D0(d0) do { s16x4 l0, l1, l2, l3, h0, h1, h2, h3; constexpr int b_ = VB * SHM_V + v_rd_off(d0, 0, 0); \
        TRRD(l0, b_); TRRD(h0, b_ + 2048); TRRD(l1, b_ + 4096); TRRD(h1, b_ + 6144); TRRD(l2, b_ + 8192); TRRD(h2, b_ + 10240); TRRD(l3, b_ + 12288); TRRD(h3, b_ + 14336); \
        asm volatile("s_waitcnt lgkmcnt(0)" ::: "memory"); SBAR(); \
        o[d0] = __builtin_amdgcn_mfma_f32_32x32x16_bf16(pa0, (bf16x8){l0[0], l0[1], l0[2], l0[3], h0[0], h0[1], h0[2], h0[3]}, o[d0], 0, 0, 0); \
        o[d0] = __builtin_amdgcn_mfma_f32_32x32x16_bf16(pa1, (bf16x8){l1[0], l1[1], l1[2], l1[3], h1[0], h1[1], h1[2], h1[3]}, o[d0], 0, 0, 0); \
        o[d0] = __builtin_amdgcn_mfma_f32_32x32x16_bf16(pa2, (bf16x8){l2[0], l2[1], l2[2], l2[3], h2[0], h2[1], h2[2], h2[3]}, o[d0], 0, 0, 0); \
        o[d0] = __builtin_amdgcn_mfma_f32_32x32x16_bf16(pa3, (bf16x8){l3[0], l3[1], l3[2], l3[3], h3[0], h3[1], h3[2], h3[3]}, o[d0], 0, 0, 0); } while (0)
    PV_D0(0); PV_D0(1); PV_D0(2); PV_D0(3);
#undef PV_D0
#undef TRRD
}

__device__ __forceinline__ void pv_sm(f32x16* o, int vb, bf16x8 pa0, bf16x8 pa1, bf16x8 pa2, bf16x8 pa3, bool act, f32x16& x0, f32x16& x1, float& m_reg, float& mn, float& alpha) {
    if (!act) { partialSM<false>(x0, x1, m_reg, mn, alpha); return; }
    s16x4 S0, S1, S2, S3, S4, S5, S6, S7; float pm = -__builtin_inff();
#define TRRD(dst, off) asm volatile("ds_read_b64_tr_b16 %0, %1 offset:%2" : "=&v"(dst) : "v"(vb), "i"(off) : "memory")
#define TRRDT(dst, off, O) asm volatile("ds_read_b64_tr_b16 %0, %2 offset:%3" : "=&v"(dst), "+v"(O) : "v"(vb), "i"(off) : "memory")
#define VWAIT(n, A, B) asm volatile("s_waitcnt lgkmcnt(%2)" : "+v"(A), "+v"(B) : "i"(n) : "memory")
#define PTIE(O) asm volatile("" : "+v"(x0), "+v"(x1), "+v"(pm), "+v"(O))
#define XV(j) ((j) < 16 ? x0[(j) & 15] : x1[(j) & 15])
    TRRD(S0, 0); TRRD(S1, 2048); TRRD(S2, 4096); TRRD(S3, 6144); TRRD(S4, 8192); TRRD(S5, 10240); TRRD(S6, 12288); TRRD(S7, 14336);
    VWAIT(6, S0, S1); o[0] = __builtin_amdgcn_mfma_f32_32x32x16_bf16(pa0, (bf16x8){S0[0], S0[1], S0[2], S0[3], S1[0], S1[1], S1[2], S1[3]}, o[0], 0, 0, 0); TRRDT(S0, 512, o[0]); TRRD(S1, 2560); pm = fmaxf(fmaxf(pm, XV(0)), XV(1)); pm = fmaxf(fmaxf(pm, XV(2)), XV(3)); pm = fmaxf(fmaxf(pm, XV(4)), XV(5)); pm = fmaxf(fmaxf(pm, XV(6)), XV(7)); PTIE(o[0]);
    VWAIT(6, S2, S3); o[0] = __builtin_amdgcn_mfma_f32_32x32x16_bf16(pa1, (bf16x8){S2[0], S2[1], S2[2], S2[3], S3[0], S3[1], S3[2], S3[3]}, o[0], 0, 0, 0); TRRDT(S2, 4608, o[0]); TRRD(S3, 6656); pm = fmaxf(fmaxf(pm, XV(8)), XV(9)); pm = fmaxf(fmaxf(pm, XV(10)), XV(11)); pm = fmaxf(fmaxf(pm, XV(12)), XV(13)); pm = fmaxf(fmaxf(pm, XV(14)), XV(15)); PTIE(o[0]);
    VWAIT(6, S4, S5); o[0] = __builtin_amdgcn_mfma_f32_32x32x16_bf16(pa2, (bf16x8){S4[0], S4[1], S4[2], S4[3], S5[0], S5[1], S5[2], S5[3]}, o[0], 0, 0, 0); TRRDT(S4, 8704, o[0]); TRRD(S5, 10752); pm = fmaxf(fmaxf(pm, XV(16)), XV(17)); pm = fmaxf(fmaxf(pm, XV(18)), XV(19)); pm = fmaxf(fmaxf(pm, XV(20)), XV(21)); pm = fmaxf(fmaxf(pm, XV(22)), XV(23)); PTIE(o[0]);
    VWAIT(6, S6, S7); o[0] = __builtin_amdgcn_mfma_f32_32x32x16_bf16(pa3, (bf16x8){S6[0], S6[1], S6[2], S6[3], S7[0], S7[1], S7[2], S7[3]}, o[0], 0, 0, 0); TRRDT(S6, 12800, o[0]); TRRD(S7, 14848); pm = fmaxf(fmaxf(pm, XV(24)), XV(25)); pm = fmaxf(fmaxf(pm, XV(26)), XV(27)); pm = fmaxf(fmaxf(pm, XV(28)), XV(29)); pm = fmaxf(fmaxf(pm, XV(30)), XV(31)); PTIE(o[0]);
    VWAIT(6, S0, S1); o[1] = __builtin_amdgcn_mfma_f32_32x32x16_bf16(pa0, (bf16x8){S0[0], S0[1], S0[2], S0[3], S1[0], S1[1], S1[2], S1[3]}, o[1], 0, 0, 0); TRRDT(S0, 1024, o[1]); TRRD(S1, 3072); { auto rr = __builtin_amdgcn_permlane32_swap(__float_as_uint(pm), __float_as_uint(pm), false, false); pm = fmaxf(__uint_as_float(rr[0]), __uint_as_float(rr[1])); } { const bool ok_ = __all(pm - m_reg <= THR2); const float mx_ = fmaxf(m_reg, pm); mn = ok_ ? m_reg : mx_; alpha = __builtin_amdgcn_exp2f(m_reg - mn); m_reg = mn; asm volatile("" : "+v"(mn), "+v"(alpha)); } PTIE(o[1]);
    VWAIT(6, S2, S3); o[1] = __builtin_amdgcn_mfma_f32_32x32x16_bf16(pa1, (bf16x8){S2[0], S2[1], S2[2], S2[3], S3[0], S3[1], S3[2], S3[3]}, o[1], 0, 0, 0); TRRDT(S2, 5120, o[1]); TRRD(S3, 7168); x0[0] = __builtin_amdgcn_exp2f(x0[0] - mn); x1[0] -= mn; PTIE(o[1]);
    VWAIT(6, S4, S5); o[1] = __builtin_amdgcn_mfma_f32_32x32x16_bf16(pa2, (bf16x8){S4[0], S4[1], S4[2], S4[3], S5[0], S5[1], S5[2], S5[3]}, o[1], 0, 0, 0); TRRDT(S4, 9216, o[1]); TRRD(S5, 11264); x0[1] = __builtin_amdgcn_exp2f(x0[1] - mn); x1[1] -= mn; PTIE(o[1]);
    VWAIT(6, S6, S7); o[1] = __builtin_amdgcn_mfma_f32_32x32x16_bf16(pa3, (bf16x8){S6[0], S6[1], S6[2], S6[3], S7[0], S7[1], S7[2], S7[3]}, o[1], 0, 0, 0); TRRDT(S6, 13312, o[1]); TRRD(S7, 15360); x0[2] = __builtin_amdgcn_exp2f(x0[2] - mn); x1[2] -= mn; x0[3] = __builtin_amdgcn_exp2f(x0[3] - mn); x1[3] -= mn; PTIE(o[1]);
    VWAIT(6, S0, S1); o[2] = __builtin_amdgcn_mfma_f32_32x32x16_bf16(pa0, (bf16x8){S0[0], S0[1], S0[2], S0[3], S1[0], S1[1], S1[2], S1[3]}, o[2], 0, 0, 0); TRRDT(S0, 1536, o[2]); TRRD(S1, 3584); x0[4] = __builtin_amdgcn_exp2f(x0[4] - mn); x1[4] -= mn; PTIE(o[2]);
    VWAIT(6, S2, S3); o[2] = __builtin_amdgcn_mfma_f32_32x32x16_bf16(pa1, (bf16x8){S2[0], S2[1], S2[2], S2[3], S3[0], S3[1], S3[2], S3[3]}, o[2], 0, 0, 0); TRRDT(S2, 5632, o[2]); TRRD(S3, 7680); x0[5] = __builtin_amdgcn_exp2f(x0[5] - mn); x1[5] -= mn; x0[6] = __builtin_amdgcn_exp2f(x0[6] - mn); x1[6] -= mn; PTIE(o[2]);
    VWAIT(6, S4, S5); o[2] = __builtin_amdgcn_mfma_f32_32x32x16_bf16(pa2, (bf16x8){S4[0], S4[1], S4[2], S4[3], S5[0], S5[1], S5[2], S5[3]}, o[2], 0, 0, 0); TRRDT(S4, 9728, o[2]); TRRD(S5, 11776); x0[7] = __builtin_amdgcn_exp2f(x0[7] - mn); x1[7] -= mn; PTIE(o[2]);
    VWAIT(6, S6, S7); o[2] = __builtin_amdgcn_mfma_f32_32x32x16_bf16(pa3, (bf16x8){S6[0], S6[1], S6[2], S6[3], S7[0], S7[1], S7[2], S7[3]}, o[2], 0, 0, 0); TRRDT(S6, 13824, o[2]); TRRD(S7, 15872); x0[8] = __builtin_amdgcn_exp2f(x0[8] - mn); x1[8] -= mn; x0[9] = __builtin_amdgcn_exp2f(x0[9] - mn); x1[9] -= mn; PTIE(o[2]);
    VWAIT(6, S0, S1); o[3] = __builtin_amdgcn_mfma_f32_32x32x16_bf16(pa0, (bf16x8){S0[0], S0[1], S0[2], S0[3], S1[0], S1[1], S1[2], S1[3]}, o[3], 0, 0, 0); x0[10] = __builtin_amdgcn_exp2f(x0[10] - mn); x1[10] -= mn; PTIE(o[3]);
    VWAIT(4, S2, S3); o[3] = __builtin_amdgcn_mfma_f32_32x32x16_bf16(pa1, (bf16x8){S2[0], S2[1], S2[2], S2[3], S3[0], S3[1], S3[2], S3[3]}, o[3], 0, 0, 0); x0[11] = __builtin_amdgcn_exp2f(x0[11] - mn); x1[11] -= mn; x0[12] = __builtin_amdgcn_exp2f(x0[12] - mn); x1[12] -= mn; PTIE(o[3]);
    VWAIT(2, S4, S5); o[3] = __builtin_amdgcn_mfma_f32_32x32x16_bf16(pa2, (bf16x8){S4[0], S4[1], S4[2], S4[3], S5[0], S5[1], S5[2], S5[3]}, o[3], 0, 0, 0); x0[13] = __builtin_amdgcn_exp2f(x0[13] - mn); x1[13] -= mn; PTIE(o[3]);
    VWAIT(0, S6, S7); o[3] = __builtin_amdgcn_mfma_f32_32x32x16_bf16(pa3, (bf16x8){S6[0], S6[1], S6[2], S6[3], S7[0], S7[1], S7[2], S7[3]}, o[3], 0, 0, 0); x0[14] = __builtin_amdgcn_exp2f(x0[14] - mn); x1[14] -= mn; x0[15] = __builtin_amdgcn_exp2f(x0[15] - mn); x1[15] -= mn; PTIE(o[3]);
#undef TRRD
#undef TRRDT
#undef VWAIT
#undef PTIE
#undef XV
}

template <class P>
__device__ __forceinline__ void attn_block(const P& p, LAS unsigned char* lds, const int tid_in, float& m_out, float& l_out) {
    int tid = tid_in; asm volatile("" : "+v"(tid));
    constexpr int DQK = P::DQK, NQF = DQK / 16, KROWB = DQK * 2, SHM_K = 64 * KROWB, KCH = DQK / 8, NKL = KCH * 64 / 512;
    const int wid = __builtin_amdgcn_readfirstlane(tid >> 6), lane = tid & 63, r32 = lane & 31, hi = lane >> 5;
    constexpr int NVB = P::DMA ? 3 : 2;
    LAS unsigned char* V_lds = lds; LAS unsigned char* K_lds = lds + NVB * SHM_V;
    LAS float* wsf = (LAS float*)(lds + NVB * SHM_V + 2 * SHM_K) + wid * 64; LAS float* li_l = wsf; LAS float* al_l = wsf + 32;
    const int NT = p.nt, row = wid * 32 + r32;
    constexpr int NQR = P::NQR;
    LAS unsigned char* qlds = lds + NVB * SHM_V + 2 * SHM_K + 2048 + wid * ((NQF - NQR) * 1024) + lane * 16;
    bf16x8 qr[NQR];
    { const bf16_t* qp = p.Q + (size_t)row * p.q_pitch + hi * 8;
#pragma unroll
      for (int d0 = 0; d0 < NQF; ++d0) { const bf16x8 v = *(const bf16x8*)(qp + d0 * 16); if (d0 < NQR) qr[d0] = v; else *(LAS bf16x8*)(qlds + (d0 - NQR) * 1024) = v; } }
    const int qm = p.pos(row) - 4 * hi;
    const int wlo = __builtin_amdgcn_readfirstlane(p.pos(wid * 32)), whi = __builtin_amdgcn_readfirstlane(p.pos(wid * 32 + 31));
    const unsigned W = (unsigned)p.W;
    float sl2 = 0.f; if constexpr (P::ALIBI) sl2 = p.slope2(row);
    float m_reg = -1e30f, l_reg = 0.f; if constexpr (P::FIXEDM) m_reg = p.mfix;
    f32x16 o[4] = {};
    const int vb0 = (int)(uintptr_t)V_lds + v_rd_base(lane);
    bf16x8 st_k[NKL], st_v0, st_v1;
#define VMW() asm volatile("s_waitcnt vmcnt(0)" ::: "memory")
#define SLOAD(t) do { int t_ = tid; asm volatile("" : "+v"(t_)); const int kb_ = p.kbase(t); const bf16_t* kp_ = p.K + (size_t)kb_ * p.k_pitch; \
        if constexpr (P::SC1) { const __amdgpu_buffer_rsrc_t kr_s = mk_rsrc(kp_); \
            _Pragma("unroll") for (int i_ = 0; i_ < NKL; ++i_) { const int id_ = t_ + 512 * i_, kr_ = id_ / KCH, kc_ = id_ - kr_ * KCH; st_k[i_] = ld_sc1(kr_s, (kr_ * p.k_pitch + kc_ * 8) * 2); } \
            if constexpr (P::PV) { const __amdgpu_buffer_rsrc_t vr_s = mk_rsrc(p.V + (size_t)kb_ * p.v_pitch); const int sr_ = t_ >> 4, sc_ = (t_ & 15) * 8; st_v0 = ld_sc1(vr_s, (sr_ * p.v_pitch + sc_) * 2); st_v1 = ld_sc1(vr_s, ((32 + sr_) * p.v_pitch + sc_) * 2); } \
        } else { \
        _Pragma("unroll") for (int i_ = 0; i_ < NKL; ++i_) { const int id_ = t_ + 512 * i_, kr_ = id_ / KCH, kc_ = id_ - kr_ * KCH; st_k[i_] = *(const bf16x8*)(kp_ + kr_ * p.k_pitch + kc_ * 8); } \
        if constexpr (P::PV) { const bf16_t* vp_ = p.V + (size_t)kb_ * p.v_pitch; const int sr_ = t_ >> 4, sc_ = (t_ & 15) * 8; st_v0 = *(const bf16x8*)(vp_ + sr_ * p.v_pitch + sc_); st_v1 = *(const bf16x8*)(vp_ + (32 + sr_) * p.v_pitch + sc_); } } } while (0)
#define SWRITE(bf) do { int t_ = tid; asm volatile("" : "+v"(t_)); \
        _Pragma("unroll") for (int i_ = 0; i_ < NKL; ++i_) { const int id_ = t_ + 512 * i_, kr_ = id_ / KCH, kc_ = id_ - kr_ * KCH; *(LAS bf16x8*)(K_lds + (bf) * SHM_K + kr_ * KROWB + ((kc_ * 16) ^ (kswz<DQK>(kr_) << 4))) = st_k[i_]; } \
        if constexpr (P::PV) { const int sr_ = t_ >> 4, sc_ = (t_ & 15) * 8; *(LAS bf16x8*)(V_lds + (bf) * SHM_V + v_st(sr_, sc_)) = st_v0; *(LAS bf16x8*)(V_lds + (bf) * SHM_V + v_st(32 + sr_, sc_)) = st_v1; } } while (0)
#define RESC(a) do { if constexpr (P::PV && !P::FIXEDM) { if (__any((a) < 1.f)) { if (hi == 0) al_l[r32] = (a); asm volatile("s_waitcnt lgkmcnt(0)" ::: "memory"); \
        _Pragma("unroll") for (int d_ = 0; d_ < 4; ++d_) _Pragma("unroll") for (int r = 0; r < 16; ++r) o[d_][r] *= al_l[crow(r, hi)]; } } } while (0)
#define ACT(t) (!P::SK || (p.kbase(t) <= whi && p.kbase(t) + 63 >= wlo - (int)W + 1 && (!P::SEL || p.sel_wave(wid, (t)))))
#define MASKT(P0_, P1_, t) do { const int kb_ = p.kbase(t); if (ACT(t)) { if constexpr (P::ALIBI) bias_tile(P0_, P1_, qm - kb_, sl2); \
        if (kb_ + 63 > wlo || kb_ <= whi - (int)W) mask_tile(P0_, P1_, qm - kb_, W); \
        if constexpr (P::SEL) { if (!p.sel_row(row, (t))) { const float NEG_ = -__builtin_inff(); _Pragma("unroll") for (int r = 0; r < 16; ++r) { P0_[r] = NEG_; P1_[r] = NEG_; } } } } } while (0)
#define FINISH(PY0, PY1, alY, t) do { finishSM_exp(PY0, PY1, alY, l_reg); p.hook(PY0, PY1, p.kbase(t), lane, ACT(t)); if constexpr (P::PV) finishSM_pack(PY0, PY1, pa0, pa1, pa2, pa3); } while (0)
#define PVT(VB, t) do { if constexpr (P::PV) pv_tile<VB>(o, vb0, pa0, pa1, pa2, pa3, ACT(t)); } while (0)
    f32x16 pA0, pA1, pB0, pB1; float mnA, mnB, alA, alB; bf16x8 pa0, pa1, pa2, pa3;
    if constexpr (P::DMA) {
    unsigned kvo[NKL], vvo[2];
#pragma unroll
    for (int i_ = 0; i_ < NKL; ++i_) { const int ci = tid + 512 * i_, kr_ = ci / KCH, pc_ = ci - kr_ * KCH, kc_ = pc_ ^ kswz<DQK>(kr_); kvo[i_] = (unsigned)((kr_ * p.k_pitch + kc_ * 8) * 2); }
#pragma unroll
    for (int j_ = 0; j_ < 2; ++j_) { const int ci = tid + 512 * j_, kk = ((ci >> 7) << 3) | ((ci & 31) >> 2), k_ = (kk & ~0xC) | ((kk & 4) << 1) | ((kk & 8) >> 1), c_ = ((ci >> 5) & 3) * 32 + (ci & 3) * 8;
        vvo[j_] = (unsigned)((k_ * p.v_pitch + c_) * 2); }
#define DMAT(t, KS, VS) do { const int kb_ = p.kbase(t); const char* kp_ = (const char*)(p.K + (size_t)kb_ * p.k_pitch); const char* vp_ = (const char*)(p.V + (size_t)kb_ * p.v_pitch); \
        _Pragma("unroll") for (int i_ = 0; i_ < NKL; ++i_) __builtin_amdgcn_global_load_lds((const unsigned*)(kp_ + kvo[i_]), (LAS unsigned*)(K_lds + (KS) * SHM_K + (i_ * 8 + wid) * 1024), 16, 0, 0); \
        _Pragma("unroll") for (int j_ = 0; j_ < 2; ++j_) __builtin_amdgcn_global_load_lds((const unsigned*)(vp_ + vvo[j_]), (LAS unsigned*)(V_lds + (VS) * SHM_V + (j_ * 8 + wid) * 1024), 16, 0, 0); } while (0)
#define PVR(vs, t) do { pv_tile<0>(o, vb0 + (vs) * SHM_V, pa0, pa1, pa2, pa3, ACT(t)); } while (0)
    DMAT(0, 0, 0); VMW(); __syncthreads();
    if (NT > 1) DMAT(1, 1, 1);
    SBAR(); qkt<0, DQK, NQR>(pA0, pA1, K_lds, r32, hi, qr, qlds, ACT(0)); SBAR();
    MASKT(pA0, pA1, 0); partialSM<P::FIXEDM>(pA0, pA1, m_reg, mnA, alA);
    VMW(); __syncthreads();
    int vr = 0;
#define DSTEP(PX0, PX1, mnX, alX, PY0, PY1, alY, t, KB) do { \
        const int tn_ = (t) + 1 < NT ? (t) + 1 : NT - 1, kbn_ = p.kbase(tn_), vw_ = vr == 0 ? 2 : vr - 1;        \
        const char* kpn_ = (const char*)(p.K + (size_t)kbn_ * p.k_pitch); const char* vpn_ = (const char*)(p.V + (size_t)kbn_ * p.v_pitch); \
        auto dm_ = [&](int f_) { _Pragma("unroll") for (int k_ = 0; k_ < NKL + 2; ++k_) if (f_ == (k_ * (DQK / 8)) / (NKL + 2) + 1) { \
            if (k_ < NKL) __builtin_amdgcn_global_load_lds((const unsigned*)(kpn_ + kvo[k_ < NKL ? k_ : 0]), (LAS unsigned*)(K_lds + ((KB) ^ 1) * SHM_K + (k_ * 8 + wid) * 1024), 16, 0, 0); \
            else __builtin_amdgcn_global_load_lds((const unsigned*)(vpn_ + vvo[k_ < NKL ? 0 : k_ - NKL]), (LAS unsigned*)(V_lds + vw_ * SHM_V + ((k_ - NKL) * 8 + wid) * 1024), 16, 0, 0); } }; \
        qkt_fin<KB, DQK>(PX0, PX1, K_lds, r32, hi, qr, ACT(t), PY0, PY1, alY, l_reg, pa0, pa1, pa2, pa3, dm_); \
        MASKT(PX0, PX1, (t)); pv_sm(o, vb0 + vr * SHM_V, pa0, pa1, pa2, pa3, ACT((t) - 1), PX0, PX1, m_reg, mnX, alX); RESC(alX); \
        vr = vr == 2 ? 0 : vr + 1; \
        VMW(); __syncthreads(); } while (0)
    for (int t = 1; t + 1 < NT; t += 2) {
        DSTEP(pB0, pB1, mnB, alB, pA0, pA1, alA, t, 1);
        DSTEP(pA0, pA1, mnA, alA, pB0, pB1, alB, t + 1, 0);
    }
    const bool even = (NT & 1) == 0;
    if (even) { SBAR(); qkt<1, DQK, NQR>(pB0, pB1, K_lds, r32, hi, qr, qlds, ACT(NT - 1)); SBAR(); }
    FINISH(pA0, pA1, alA, even ? NT - 2 : NT - 1); SBAR();
    PVR(vr, even ? NT - 2 : NT - 1);
    if (even) { MASKT(pB0, pB1, NT - 1); partialSM<P::FIXEDM>(pB0, pB1, m_reg, mnB, alB); RESC(alB);
        FINISH(pB0, pB1, alB, NT - 1); SBAR(); PVR(vr == 2 ? 0 : vr + 1, NT - 1); }
#undef DMAT
#undef PVR
#undef DSTEP
    } else {
    SLOAD(0); VMW(); SWRITE(0);
    if (NT > 1) SLOAD(1);
    __syncthreads();
    SBAR(); qkt<0, DQK, NQR>(pA0, pA1, K_lds, r32, hi, qr, qlds, ACT(0));
    MASKT(pA0, pA1, 0); partialSM<P::FIXEDM>(pA0, pA1, m_reg, mnA, alA);
    if (NT > 1) { VMW(); SWRITE(1); }
    __syncthreads();
#define HALF_STEP(PX0, PX1, mnX, alX, PY0, PY1, alY, t, KB, VB, SB) do { \
        SBAR(); if constexpr (NQR == NQF && P::PV) { qkt_fin<KB, DQK>(PX0, PX1, K_lds, r32, hi, qr, ACT(t), PY0, PY1, alY, l_reg, pa0, pa1, pa2, pa3); } \
        else { qkt<KB, DQK, NQR>(PX0, PX1, K_lds, r32, hi, qr, qlds, ACT(t)); FINISH(PY0, PY1, alY, (t) - 1); } SBAR(); \
        if ((t) + 1 < NT) { SLOAD((t) + 1); SBAR(); } \
        PVT(VB, (t) - 1); MASKT(PX0, PX1, (t)); partialSM<P::FIXEDM>(PX0, PX1, m_reg, mnX, alX); \
        __syncthreads(); \
        if ((t) + 1 < NT) { VMW(); SWRITE(SB); } \
        RESC(alX); __syncthreads(); } while (0)
    for (int t = 1; t + 1 < NT; t += 2) {
        HALF_STEP(pB0, pB1, mnB, alB, pA0, pA1, alA, t, 1, 0, 0);
        HALF_STEP(pA0, pA1, mnA, alA, pB0, pB1, alB, t + 1, 0, 1, 1);
    }
    const bool even = (NT & 1) == 0;
    if (even) { SBAR(); qkt<1, DQK, NQR>(pB0, pB1, K_lds, r32, hi, qr, qlds, ACT(NT - 1)); SBAR(); }
    FINISH(pA0, pA1, alA, even ? NT - 2 : NT - 1); SBAR();
    PVT(0, even ? NT - 2 : NT - 1);
    if (even) { MASKT(pB0, pB1, NT - 1); partialSM<P::FIXEDM>(pB0, pB1, m_reg, mnB, alB); RESC(alB);
        FINISH(pB0, pB1, alB, NT - 1); SBAR(); PVT(1, NT - 1); }
    }
    m_out = m_reg; l_out = l_reg;
    p.store(o, l_reg, m_reg, li_l, wid, lane, r32, hi);
    __syncthreads();
#undef VMW
#undef SLOAD
#undef SWRITE
#undef RESC
#undef ACT
#undef MASKT
#undef FINISH
#undef PVT
#undef HALF_STEP
}

struct PolBase {
    static constexpr bool DMA = false;
    const bf16_t* Q; const bf16_t* K; const bf16_t* V; int q_pitch, k_pitch, v_pitch; int nt, j0, P0, W; float mfix;
    __device__ __forceinline__ int kbase(int t) const { return (j0 + t) * 64; }
    __device__ __forceinline__ void hook(const f32x16&, const f32x16&, int, int, bool) const {}
    __device__ __forceinline__ bool sel_row(int, int) const { return true; }
    __device__ __forceinline__ bool sel_wave(int, int) const { return true; }
};
struct PolMLA : PolBase {
    static constexpr int DQK = 192, NQR = 12; static constexpr bool ALIBI = false, SK = false, SEL = false, FIXEDM = false, PV = true, SC1 = false, DMA = true;
    bf16_t* O; int o_pitch;
    __device__ __forceinline__ int pos(int row) const { return P0 + row; }
    __device__ __forceinline__ float slope2(int) const { return 0.f; }
    __device__ __forceinline__ void store(const f32x16 (&o)[4], float l_reg, float, LAS float* li_l, int wid, int lane, int r32, int hi) const {
        asm volatile("" : "+v"(r32), "+v"(hi));
        if (hi == 0) li_l[r32] = l_reg; asm volatile("s_waitcnt lgkmcnt(0)" ::: "memory");
        bf16_t* Ow = O + (size_t)(wid * 32) * o_pitch;
#pragma unroll
        for (int r = 0; r < 16; ++r) { const int orow = crow(r, hi); const float rl = __builtin_amdgcn_rcpf(li_l[orow]);
#pragma unroll
            for (int d0 = 0; d0 < 4; ++d0) { const float v = o[d0][r] * rl; const float vn = shx(v, 1, hi * 32 + r32);
                if ((r32 & 1) == 0) *(unsigned*)(Ow + (size_t)orow * o_pitch + d0 * 32 + r32) = cvt_pk_bf16(v, vn); } }
    }
};

__device__ __forceinline__ float alibi_slope(int i) { return __builtin_amdgcn_exp2f(-0.8f * (float)i); }
__device__ __forceinline__ float dpp_xor1(float v) { return __int_as_float(__builtin_amdgcn_update_dpp(0, __float_as_int(v), 0xB1, 0xF, 0xF, true)); }
__device__ __forceinline__ float dpp_xor2(float v) { return __int_as_float(__builtin_amdgcn_update_dpp(0, __float_as_int(v), 0x4E, 0xF, 0xF, true)); }

struct PolDil : PolBase {
    static constexpr int DQK = 128, NQR = 8; static constexpr bool ALIBI = true, SK = true, SEL = false, FIXEDM = false, PV = true, SC1 = false, DMA = DIL_DMA;
    bf16_t* O; int o_pitch; float* LSE; int lse_pitch; float sl2;
    __device__ __forceinline__ int pos(int row) const { return P0 + row; }
    __device__ __forceinline__ float slope2(int) const { return sl2; }
    __device__ __forceinline__ void store(const f32x16 (&o)[4], float l_reg, float m_reg, LAS float* li_l, int wid, int lane, int r32, int hi) const {
        asm volatile("" : "+v"(r32), "+v"(hi));
        if (hi == 0) { li_l[r32] = l_reg; LSE[(size_t)(wid * 32 + r32) * lse_pitch] = (m_reg + __builtin_amdgcn_logf(l_reg)) * 0.6931471805599453f; }
        asm volatile("s_waitcnt lgkmcnt(0)" ::: "memory");
        bf16_t* Ow = O + (size_t)(wid * 32) * o_pitch;
#pragma unroll
        for (int r = 0; r < 16; ++r) { const int orow = crow(r, hi); const float rl = __builtin_amdgcn_rcpf(li_l[orow]);
#pragma unroll
            for (int d0 = 0; d0 < 4; ++d0) { const float v = o[d0][r] * rl; const float vn = shx(v, 1, hi * 32 + r32);
                if ((r32 & 1) == 0) *(unsigned*)(Ow + (size_t)orow * o_pitch + d0 * 32 + r32) = cvt_pk_bf16(v, vn); } }
    }
};
struct PolNsaBase : PolBase {
    static constexpr int DQK = 128, NQR = 6;
    int t0;
    __device__ __forceinline__ float slope2(int row) const { return alibi_slope(7 + (row & 3)) * 1.4426950408889634f; }
};
struct PolCmp1 : PolNsaBase {
    static constexpr bool ALIBI = true, SK = false, SEL = false, FIXEDM = false, PV = false, SC1 = false;
    __device__ __forceinline__ int pos(int row) const { return (t0 + (row >> 2) - 31) >> 4; }
    __device__ __forceinline__ float slope2(int row) const { return 16.0f * PolNsaBase::slope2(row); }
    __device__ __forceinline__ void store(const f32x16 (&)[4], float, float, LAS float*, int, int, int, int) const {}
};
template <int BR>
__device__ __forceinline__ void nsa_store(const f32x16 (&o)[4], float l_reg, LAS float* li_l, int wid, int r32, int hi, const float* gates  , float* nsaf  , bf16_t* ocat  ) {
    asm volatile("" : "+v"(r32), "+v"(hi));
    if (hi == 0) { const int row = wid * 32 + r32; const float g = gates[(size_t)(row >> 2) * 16 + (row & 3) * 3 + BR];
        li_l[r32] = BR == 0 ? g : (l_reg > 0.f ? g * __builtin_amdgcn_rcpf(l_reg) : 0.f); }
    asm volatile("s_waitcnt lgkmcnt(0)" ::: "memory");
#pragma unroll
    for (int r = 0; r < 16; ++r) { const int grow = wid * 32 + crow(r, hi); const float f = li_l[crow(r, hi)];
#pragma unroll
        for (int d0 = 0; d0 < 4; ++d0) { float v = o[d0][r] * f; float* np = nsaf + (size_t)grow * 128 + d0 * 32 + r32;
            if (BR == 0) *np = v;
            else if (BR == 1) *np += v;
            else { v += *np; const float vn = shx(v, 1, hi * 32 + r32);
                if ((r32 & 1) == 0) *(unsigned*)(ocat + (size_t)(grow >> 2) * DM + (grow & 3) * 128 + d0 * 32 + r32) = cvt_pk_bf16(v, vn); } } }
}
struct PolCmp2 : PolNsaBase {
    static constexpr bool ALIBI = true, SK = false, SEL = false, FIXEDM = true, PV = true, SC1 = false;
    LAS float* score; const float* gates; float* nsaf; int wid_;
    __device__ __forceinline__ int pos(int row) const { return (t0 + (row >> 2) - 31) >> 4; }
    __device__ __forceinline__ float slope2(int row) const { return 16.0f * PolNsaBase::slope2(row); }
    __device__ __forceinline__ void hook(const f32x16& p0, const f32x16& p1, int kb, int lane, bool) const {
        const int r32 = lane & 31, hi = lane >> 5; LAS float* sc = score + (wid_ * 8 + (r32 >> 2)) * 256 + (kb >> 2) + hi;
        asm volatile("s_waitcnt lgkmcnt(0)" ::: "memory");
#pragma unroll
        for (int g = 0; g < 4; ++g) {
            float a = (p0[4 * g] + p0[4 * g + 1]) + (p0[4 * g + 2] + p0[4 * g + 3]), b = (p1[4 * g] + p1[4 * g + 1]) + (p1[4 * g + 2] + p1[4 * g + 3]);
            a += dpp_xor1(a); a += dpp_xor2(a); b += dpp_xor1(b); b += dpp_xor2(b);
            if ((r32 & 3) == 0) { sc[2 * g] += a; sc[8 + 2 * g] += b; } }
        asm volatile("s_waitcnt lgkmcnt(0)" ::: "memory");
#pragma unroll
        for (int g = 0; g < 4; ++g) {
            float ea = p0[4 * g + 3], eb = p1[4 * g + 3];
            ea += dpp_xor1(ea); ea += dpp_xor2(ea); eb += dpp_xor1(eb); eb += dpp_xor2(eb);
            if ((r32 & 3) == 0) { sc[2 * g + 1] += ea; if ((kb >> 2) + hi + 8 + 2 * g + 1 < 256) sc[8 + 2 * g + 1] += eb; } }
    }
    __device__ __forceinline__ void store(const f32x16 (&o)[4], float l_reg, float, LAS float* li_l, int wid, int, int r32, int hi) const { nsa_store<0>(o, l_reg, li_l, wid, r32, hi, gates, nsaf, nullptr); }
};
struct PolSlc : PolNsaBase {
    static constexpr bool ALIBI = true, SK = true, SEL = true, FIXEDM = false, PV = true, SC1 = true;
    LAS const int* tlist; LAS const unsigned* selm  ; LAS const unsigned* wunion  ; const float* gates; float* nsaf;
    __device__ __forceinline__ int kbase(int t) const { return __builtin_amdgcn_readfirstlane(tlist[t]) * 64; }
    __device__ __forceinline__ int pos(int row) const { return t0 + (row >> 2); }
    __device__ __forceinline__ bool sel_wave(int wid, int t) const { const int j = __builtin_amdgcn_readfirstlane(tlist[t]); return (__builtin_amdgcn_readfirstlane(wunion[wid * 8 + (j >> 5)]) >> (j & 31)) & 1u; }
    __device__ __forceinline__ bool sel_row(int row, int t) const { const int j = __builtin_amdgcn_readfirstlane(tlist[t]); return (selm[(row >> 2) * 8 + (j >> 5)] >> (j & 31)) & 1u; }
    __device__ __forceinline__ void store(const f32x16 (&o)[4], float l_reg, float, LAS float* li_l, int wid, int, int r32, int hi) const { nsa_store<1>(o, l_reg, li_l, wid, r32, hi, gates, nsaf, nullptr); }
};
struct PolWin : PolNsaBase {
    static constexpr bool ALIBI = true, SK = true, SEL = false, FIXEDM = false, PV = true, SC1 = true;
    const float* gates; float* nsaf; bf16_t* ocat;
    __device__ __forceinline__ int pos(int row) const { return t0 + (row >> 2); }
    __device__ __forceinline__ void store(const f32x16 (&o)[4], float l_reg, float, LAS float* li_l, int wid, int, int r32, int hi) const { nsa_store<2>(o, l_reg, li_l, wid, r32, hi, gates, nsaf, ocat); }
};

constexpr int NSA_SCORE_OFF = 83968, NSA_SEL_OFF = NSA_SCORE_OFF + 65536, NSA_WUN_OFF = NSA_SEL_OFF + 2048, NSA_UNI_OFF = NSA_WUN_OFF + 256, NSA_TL_OFF = NSA_UNI_OFF + 64, NSA_END = NSA_TL_OFF + 1028;
static_assert(NSA_END <= 159744, "NSA LDS map");
struct NsaBufs { const bf16_t* NQ; const bf16_t* NKV; const bf16_t* KC; const bf16_t* VC; const float* GATES; float* NSAF; bf16_t* OCAT; };
__device__ __forceinline__ void nsa_unit(const NsaBufs& nb, int b, int t0, LAS unsigned char* lds, const int tid_in) {
    int tid = tid_in; asm volatile("" : "+v"(tid));
    const int wid = __builtin_amdgcn_readfirstlane(tid >> 6), lane = tid & 63;
    LAS float* score = (LAS float*)(lds + NSA_SCORE_OFF); LAS unsigned* selm = (LAS unsigned*)(lds + NSA_SEL_OFF); LAS unsigned* wun = (LAS unsigned*)(lds + NSA_WUN_OFF);
    LAS unsigned* uni = (LAS unsigned*)(lds + NSA_UNI_OFF); LAS int* tl = (LAS int*)(lds + NSA_TL_OFF);
    const size_t tok0 = (size_t)b * SEQ + t0;
    const float* gates = nb.GATES + tok0 * 16; float* nsaf = nb.NSAF + tok0 * 512; const bf16_t* Q = nb.NQ + tok0 * 512;
    for (int e = tid; e < 64 * 256; e += 512) score[e] = 0.f;
    __syncthreads();
    const int maxc = (t0 + 32) >> 4, ntc = (maxc >> 6) + 1;
    float m1, l1;
    { PolCmp1 p; p.Q = Q; p.q_pitch = 128; p.K = nb.KC + (size_t)b * 1024 * 128; p.k_pitch = 128; p.V = nullptr; p.v_pitch = 0; p.nt = ntc; p.j0 = 0; p.P0 = 0; p.W = 0x40000000; p.mfix = 0.f; p.t0 = t0;
      attn_block(p, lds, tid, m1, l1); }
    { PolCmp2 p; p.Q = Q; p.q_pitch = 128; p.K = nb.KC + (size_t)b * 1024 * 128; p.k_pitch = 128; p.V = nb.VC + (size_t)b * 1024 * 128; p.v_pitch = 128; p.nt = ntc; p.j0 = 0; p.P0 = 0; p.W = 0x40000000; p.t0 = t0;
      p.mfix = l1 > 0.f ? m1 + __builtin_amdgcn_logf(l1) : 1e30f; p.score = score; p.gates = gates; p.nsaf = nsaf; p.wid_ = wid;
      float m2, l2; attn_block(p, lds, tid, m2, l2); }
    {
        asm volatile("s_waitcnt lgkmcnt(0)" ::: "memory");
        unsigned key[8][4], sel[8];
        const int curb = (t0 + wid * 8) >> 6;
#pragma unroll
        for (int k = 0; k < 8; ++k) { sel[k] = 0u;
#pragma unroll
            for (int q = 0; q < 4; ++q) { const int j = lane + 64 * q; const float sv = score[(wid * 8 + k) * 256 + j];
                key[k][q] = (j >= 1 && j <= curb - 2) ? ((__float_as_uint(sv) & 0xFFFFFF00u) | (unsigned)(255 - j)) : 0u; } }
        if (curb >= 3) {
            for (int it = 0; it < 13; ++it) {
                unsigned best[8], wm[8]; int bq[8];
#pragma unroll
                for (int k = 0; k < 8; ++k) { best[k] = key[k][0]; bq[k] = 0;
#pragma unroll
                    for (int q = 1; q < 4; ++q) if (key[k][q] > best[k]) { best[k] = key[k][q]; bq[k] = q; }
                    wm[k] = best[k]; }
#pragma unroll
                for (int of = 1; of < 64; of <<= 1) {
#pragma unroll
                    for (int k = 0; k < 8; ++k) { const unsigned o_ = shxu(wm[k], of, lane); wm[k] = o_ > wm[k] ? o_ : wm[k]; } }
                unsigned any = 0u;
#pragma unroll
                for (int k = 0; k < 8; ++k) { any |= wm[k];
                    if (best[k] == wm[k] && wm[k] != 0u) { sel[k] |= 1u << bq[k];
#pragma unroll
                        for (int q = 0; q < 4; ++q) if (q == bq[k]) key[k][q] = 0u; } }
                if (__builtin_amdgcn_readfirstlane(any) == 0u) break;
            }
        }
        unsigned long long wuni[4] = {0ull, 0ull, 0ull, 0ull};
#pragma unroll
        for (int k = 0; k < 8; ++k) { const int tokl = wid * 8 + k;
#pragma unroll
            for (int q = 0; q < 4; ++q) { const int j = lane + 64 * q; const bool on = ((sel[k] >> q) & 1u) || j == 0 || j == curb || j == curb - 1;
                const unsigned long long bm = __ballot(on); wuni[q] |= bm;
                if (lane == 0) { selm[tokl * 8 + 2 * q] = (unsigned)bm; selm[tokl * 8 + 2 * q + 1] = (unsigned)(bm >> 32); } } }
        if (lane == 0) {
#pragma unroll
            for (int q = 0; q < 4; ++q) { wun[wid * 8 + 2 * q] = (unsigned)wuni[q]; wun[wid * 8 + 2 * q + 1] = (unsigned)(wuni[q] >> 32); } }
    }
    __syncthreads();
    if (tid < 8) { unsigned u = 0u; for (int w = 0; w < 8; ++w) u |= wun[w * 8 + tid]; uni[tid] = u; }
    __syncthreads();
    int nts = 0;
    { unsigned pre = 0u;
#pragma unroll
      for (int w = 0; w < 8; ++w) { const unsigned u = uni[w]; if (tid < 256 && w < (tid >> 5)) pre += __builtin_popcount(u); nts += __builtin_popcount(u); }
      if (tid < 256) { const unsigned u = uni[tid >> 5]; if ((u >> (tid & 31)) & 1u) tl[pre + __builtin_popcount(u & ((1u << (tid & 31)) - 1u))] = tid; } }
    nts = __builtin_amdgcn_readfirstlane(nts);
    __syncthreads();
    { PolSlc p; p.Q = Q; p.q_pitch = 128; p.K = nb.NKV + 2 * ((size_t)M * 128) + (size_t)b * SEQ * 128; p.k_pitch = 128; p.V = nb.NKV + 3 * ((size_t)M * 128) + (size_t)b * SEQ * 128; p.v_pitch = 128;
      p.nt = nts; p.j0 = 0; p.P0 = 0; p.W = 0x40000000; p.mfix = 0.f; p.t0 = t0; p.tlist = tl; p.selm = selm; p.wunion = wun; p.gates = gates; p.nsaf = nsaf;
      float m_, l_; attn_block(p, lds, tid, m_, l_); }
    { PolWin p; p.Q = Q; p.q_pitch = 128; p.K = nb.NKV + 4 * ((size_t)M * 128) + (size_t)b * SEQ * 128; p.k_pitch = 128; p.V = nb.NKV + 5 * ((size_t)M * 128) + (size_t)b * SEQ * 128; p.v_pitch = 128;
      const int jl = (t0 >> 6) - 8 > 0 ? (t0 >> 6) - 8 : 0; p.j0 = jl; p.nt = (t0 >> 6) - jl + 1; p.P0 = 0; p.W = 512; p.mfix = 0.f; p.t0 = t0; p.gates = gates; p.nsaf = nsaf; p.ocat = nb.OCAT + tok0 * DM + 1536;
      float m_, l_; attn_block(p, lds, tid, m_, l_); }
}
}

constexpr size_t WS_CTL = 0, CTL_ZERO_BYTES = 1u << 20;
constexpr size_t SZ_W1 = (size_t)NFF * DM * 2, SZ_W2 = (size_t)DM * FF * 2, SZ_WM = (size_t)NMIX * DM * 2, SZ_WU = (size_t)NUP * 512 * 2, SZ_WO = (size_t)DM * DM * 2, SZ_WC = (size_t)256 * 4096 * 2;
constexpr size_t LW_W1A = 0, LW_W2A = LW_W1A + SZ_W1, LW_W1B = LW_W2A + SZ_W2, LW_W2B = LW_W1B + SZ_W1, LW_WM = LW_W2B + SZ_W2, LW_WU = LW_WM + SZ_WM, LW_WO = LW_WU + SZ_WU,
                 LW_WCK = LW_WO + SZ_WO, LW_WCV = LW_WCK + SZ_WC, LW_SIZE = LW_WCV + SZ_WC;
constexpr size_t WS_W = CTL_ZERO_BYTES;
constexpr size_t WS_XB = WS_W + DEPTH * LW_SIZE;
constexpr size_t WS_SS = WS_XB + (size_t)M * DM * 2;
constexpr size_t WS_ROPE = WS_SS + (size_t)M * 32 * 4;
constexpr size_t WS_CB = WS_ROPE + (size_t)SEQ * 32 * 2 * 4;
constexpr size_t WS_BIG = WS_CB + 4096;
constexpr size_t WS_HID = WS_BIG;
constexpr size_t OV_LAT = 0, OV_LATSS = OV_LAT + (size_t)M * LATW * 2, OV_DQ = OV_LATSS + (size_t)M * 16 * 4, OV_DK = OV_DQ + (size_t)M * 768 * 2, OV_DV = OV_DK + (size_t)M * 768 * 2,
                 OV_NQ = OV_DV + (size_t)M * 768 * 2, OV_NKV = OV_NQ + (size_t)M * 512 * 2, OV_GATES = OV_NKV + 6 * (size_t)M * 128 * 2 + 65536, OV_MQ = OV_GATES + (size_t)DEPTH * M * 16 * 4,
                 OV_MK = OV_MQ + (size_t)M * 1152 * 2, OV_MV = OV_MK + (size_t)M * 1152 * 2, OV_END = OV_MV + (size_t)M * 768 * 2;
constexpr size_t BIG_BYTES = OV_END > (size_t)M * FF * 2 ? OV_END : (size_t)M * FF * 2;
constexpr size_t WS_OCAT = WS_BIG + BIG_BYTES;
constexpr size_t WS_DLSE = WS_OCAT + (size_t)M * DM * 2;
constexpr size_t WS_KC = WS_DLSE + (size_t)DEPTH * M * 8 * 4;
constexpr size_t WS_H1 = WS_KC + (size_t)DEPTH * 2 * 2048 * 128 * 2;
constexpr size_t WS_NSAF = WS_H1 + (size_t)DEPTH * 2 * 2048 * 128 * 2;
constexpr size_t WS_END_V1 = WS_NSAF + (size_t)M * 512 * 4;
static_assert(WS_END_V1 <= 1610670080ull, "d_ws map too large");
static_assert(OV_DK == OV_DQ + (size_t)M * 768 * 2 && OV_DV == OV_DK + (size_t)M * 768 * 2, "DQ|DK|DV contiguous");

constexpr int CW_CHAIN = 32768;
constexpr int CW_BAR = 4096, CW_QUEUE = 8192;
constexpr int RING_BYTES = 131072, LDSCTL_OFF = 159744, MISC_OFF = LDSCTL_OFF + 320, LDS_BYTES = 163840;

#define XB_TMO      128
#define XB_XCNT(j)  (256  + 64 * (j))
#define XB_XSUB(j)  (1280 + 64 * (j))
#define XB_XGEN(j)  (2304 + 64 * (j))
#define XB_TOP      3328
#define XB_TOPGEN   3392
#define XCD_BAR_WORDS 3456
#define XB_SPIN_CAP (1u << 18)
__device__ __forceinline__ unsigned xb_ld(unsigned* p)              { return __hip_atomic_load(p, __ATOMIC_RELAXED, __HIP_MEMORY_SCOPE_AGENT); }
__device__ __forceinline__ unsigned xb_add(unsigned* p, unsigned v) { return __hip_atomic_fetch_add(p, v, __ATOMIC_RELAXED, __HIP_MEMORY_SCOPE_AGENT); }
__device__ __forceinline__ unsigned xb_xcc_id() { return (unsigned)__builtin_amdgcn_s_getreg((3 << 11) | 20) & 0xFu; }
#define XB_SPIN(cond, bar) do { unsigned _sp = 0; while (cond) { __builtin_amdgcn_s_sleep(1); \
    if ((++_sp & 255u) == 0u) { if (xb_ld(&(bar)[XB_TMO])) break; if (_sp > XB_SPIN_CAP) { atomicAdd(&(bar)[XB_TMO], 1u); break; } } } } while (0)
struct XcdBarrier { unsigned* bar; unsigned x; volatile LAS unsigned* st; };
__device__ __forceinline__ XcdBarrier xcd_barrier_post(unsigned* bar, volatile LAS unsigned* st) {
    XcdBarrier b; b.bar = bar; b.x = xb_xcc_id(); b.st = st;
    if (threadIdx.x == 0) (void)xb_add(&bar[XB_XCNT(b.x)], 1u);
    return b;
}
__device__ __forceinline__ void xcd_barrier_complete(unsigned* bar, unsigned x, unsigned& nloc, unsigned& nx) {
    const unsigned G = gridDim.x * gridDim.y * gridDim.z;
    unsigned sum, cnt, mine, sp = 0u;
    for (;;) {
        sum = 0u; cnt = 0u; mine = 0u;
#pragma unroll
        for (unsigned j = 0; j < 16; ++j) { const unsigned c = xb_ld(&bar[XB_XCNT(j)]); sum += c; cnt += (c > 0u) ? 1u : 0u; mine = (j == x) ? c : mine; }
        if (sum == G) break;
        __builtin_amdgcn_s_sleep(1);
        if ((++sp & 255u) == 0u) { if (xb_ld(&bar[XB_TMO])) break; if (sp > XB_SPIN_CAP) { atomicAdd(&bar[XB_TMO], 1u); break; } }
    }
    nloc = mine > 0u ? mine : 1u; nx = cnt > 0u ? cnt : 1u;
}
__device__ __forceinline__ void xcd_barrier(const XcdBarrier& b, const int tid0) {
    asm volatile("s_waitcnt vmcnt(0)" ::: "memory");
    __syncthreads();
    if (tid0 == 0) {
        unsigned* bar = b.bar; asm volatile("" : "+s"(bar));
        unsigned bx = b.x; asm volatile("" : "+s"(bx));
        __builtin_amdgcn_s_waitcnt(0);
        unsigned nloc = b.st[0], nx = b.st[1];
        if (nloc == 0u) { xcd_barrier_complete(bar, bx, nloc, nx); b.st[0] = nloc; b.st[1] = nx; }
        const unsigned old = xb_add(&bar[XB_XSUB(bx)], 1u);
        const unsigned gen = old / nloc;
        if (old + 1u == (gen + 1u) * nloc) {
            __builtin_amdgcn_fence(__ATOMIC_RELEASE, "agent");
            asm volatile("s_waitcnt vmcnt(0)" ::: "memory");
            const unsigned og = xb_add(&bar[XB_TOP], 1u);
            const unsigned tg = og / nx;
            if (og + 1u == (tg + 1u) * nx) xb_add(&bar[XB_TOPGEN], 1u);
            else XB_SPIN(xb_ld(&bar[XB_TOPGEN]) == tg, bar);
            __builtin_amdgcn_fence(__ATOMIC_ACQUIRE, "agent");
            xb_add(&bar[XB_XGEN(bx)], 1u);
            asm volatile("s_waitcnt vmcnt(0)" ::: "memory");
        } else {
            XB_SPIN(xb_ld(&bar[XB_XGEN(bx)]) == gen, bar);
            __builtin_amdgcn_fence(__ATOMIC_ACQUIRE, "agent");
            asm volatile("s_waitcnt vmcnt(0)" ::: "memory");
        }
    }
    __syncthreads();
}

#define XL_OFF      (16384 - CW_BAR)
#define XL_SUB(j)   (XL_OFF + 64 * (j))
#define XL_GEN(j)   (XL_OFF + 1024 + 64 * (j))
#define XL_MM       (XL_OFF + 2048)
__device__ __forceinline__ void xcd_local_barrier(const XcdBarrier& b, const int tid0) {
    asm volatile("s_waitcnt vmcnt(0)" ::: "memory");
    __syncthreads();
    if (tid0 == 0) {
        unsigned* bar = b.bar; const unsigned bx = b.x;
        __builtin_amdgcn_s_waitcnt(0);
        const unsigned nloc = b.st[0];
        const unsigned old = xb_add(&bar[XL_SUB(bx)], 1u);
        const unsigned gen = old / nloc;
        if (old + 1u == (gen + 1u) * nloc) xb_add(&bar[XL_GEN(bx)], 1u);
        else XB_SPIN(xb_ld(&bar[XL_GEN(bx)]) == gen, bar);
        asm volatile("buffer_inv sc0\n\ts_waitcnt vmcnt(0)" ::: "memory");
    }
    __syncthreads();
}

struct Args { const float* in[20]; float* out; unsigned char* ws; };

struct MapId { int N; __device__ __forceinline__ int operator()(int n) const { return n < N ? n : -1; } };
struct MapSwiglu { __device__ __forceinline__ int operator()(int n) const { const int pn = n >> 8, j = n & 255; return j < 128 ? pn * 128 + j : FF + pn * 128 + (j - 128); } };
struct MapMix { __device__ __forceinline__ int operator()(int n) const {
    if (n < 1024) return n;
    if (n < 4608) return n + 64;
    if (n < 4672) { const int j = n - 4608; return 1024 + (j & 1) * 32 + (j >> 1); }
    if (n < 4684) return n;
    return -1; } };
struct MapUp { __device__ __forceinline__ int operator()(int n) const {
    if (n >= 1152) return -1;
    const int hd = n / 192, w = n - hd * 192; if (w < 128) return n;
    const int j = w - 128; return hd * 192 + 128 + (j & 1) * 32 + (j >> 1); } };

constexpr int CI_W1 = (DM / 64) * (NFF / 64), CI_W2 = (FF / 64) * (DM / 64), CI_WM = (DM / 64) * (NMIX / 64), CI_UQ = 8 * 20, CI_UKV = 8 * 24, CI_WO = (DM / 64) * (DM / 64), CI_WC = 64 * 4;
constexpr int CI_LAYER = 2 * CI_W1 + 2 * CI_W2 + CI_WM + CI_UQ + CI_UKV + CI_WO + 2 * CI_WC, CI_TOTAL = DEPTH * CI_LAYER;
struct ConvItem { const float* src; const float* gain; bf16_t* dst; int Nlog, K, lc; };
__device__ __forceinline__ void conv_decode(int it, const Args& args, unsigned char* ws, int lane, ConvItem& c) {
    const int l = it / CI_LAYER; int r = it - l * CI_LAYER; unsigned char* lw = ws + WS_W + (size_t)l * LW_SIZE;
    const float* W; const float* gain = nullptr; bf16_t* WT; int Nlog, K, nblk, mapid;
    if (r < CI_W1) { W = args.in[2] + (size_t)l * DM * NFF; gain = args.in[1] + l * DM; WT = (bf16_t*)(lw + LW_W1A); Nlog = NFF; K = DM; nblk = NFF / 64; mapid = 1; }
    else if ((r -= CI_W1) < CI_W2) { W = args.in[3] + (size_t)l * FF * DM; WT = (bf16_t*)(lw + LW_W2A); Nlog = DM; K = FF; nblk = DM / 64; mapid = 0; }
    else if ((r -= CI_W2) < CI_W1) { W = args.in[17] + (size_t)l * DM * NFF; gain = args.in[16] + l * DM; WT = (bf16_t*)(lw + LW_W1B); Nlog = NFF; K = DM; nblk = NFF / 64; mapid = 1; }
    else if ((r -= CI_W1) < CI_W2) { W = args.in[18] + (size_t)l * FF * DM; WT = (bf16_t*)(lw + LW_W2B); Nlog = DM; K = FF; nblk = DM / 64; mapid = 0; }
    else if ((r -= CI_W2) < CI_WM) { W = args.in[5] + (size_t)l * DM * NMIX_LOG; gain = args.in[4] + l * DM; WT = (bf16_t*)(lw + LW_WM); Nlog = NMIX_LOG; K = DM; nblk = NMIX / 64; mapid = 2; }
    else if ((r -= CI_WM) < CI_UQ) { W = args.in[7] + (size_t)l * 512 * 1152; gain = args.in[6] + l * 512; WT = (bf16_t*)(lw + LW_WU); Nlog = 1152; K = 512; nblk = 20; mapid = 3; }
    else if ((r -= CI_UQ) < CI_UKV) { W = args.in[9] + (size_t)l * 512 * 1536; gain = args.in[8] + l * 512; WT = (bf16_t*)(lw + LW_WU) + (size_t)1280 * 512; Nlog = 1536; K = 512; nblk = 24; mapid = 0; }
    else if ((r -= CI_UKV) < CI_WO) { W = args.in[15] + (size_t)l * DM * DM; WT = (bf16_t*)(lw + LW_WO); Nlog = DM; K = DM; nblk = DM / 64; mapid = 0; }
    else if ((r -= CI_WO) < CI_WC) { W = args.in[11] + (size_t)l * 4096 * 128; WT = (bf16_t*)(lw + LW_WCK); Nlog = 128; K = 4096; nblk = 4; mapid = 0; }
    else { r -= CI_WC; W = args.in[13] + (size_t)l * 4096 * 128; WT = (bf16_t*)(lw + LW_WCV); Nlog = 128; K = 4096; nblk = 4; mapid = 0; }
    const int kb = r / nblk, nb = r - kb * nblk, k0 = kb * 64, n0 = nb * 64, n = n0 + lane;
    int lc;
    if (mapid == 0) lc = n < Nlog ? n : -1; else if (mapid == 1) lc = MapSwiglu{}(n); else if (mapid == 2) lc = MapMix{}(n); else lc = MapUp{}(n);
    c.src = W + (size_t)k0 * Nlog + (lc >= 0 ? lc : 0); c.gain = gain ? gain + k0 : nullptr; c.dst = WT + (size_t)n0 * K + k0; c.Nlog = Nlog; c.K = K; c.lc = lc;
}
__device__ __forceinline__ void conv_load(const ConvItem& c, float (&v)[64]) {
#pragma unroll
    for (int kk = 0; kk < 64; ++kk) v[kk] = __builtin_nontemporal_load(c.src + (size_t)kk * c.Nlog);
}
__device__ __forceinline__ void conv_store(const ConvItem& c, const float (&v)[64], LAS float* scr, int lane) {
#pragma unroll
    for (int kk = 0; kk < 64; ++kk) { float x = v[kk]; if (c.gain) x *= c.gain[kk]; scr[kk * 65 + lane] = c.lc >= 0 ? x : 0.f; }
    LDS_WAIT();
    const int ch = lane & 7;
#pragma unroll
    for (int j = 0; j < 8; ++j) { const int n = (lane >> 3) + 8 * j; const LAS float* sp = scr + (8 * ch) * 65 + n;
        u32x4 o; o.x = cvt_pk_bf16(sp[0], sp[65]); o.y = cvt_pk_bf16(sp[2 * 65], sp[3 * 65]); o.z = cvt_pk_bf16(sp[4 * 65], sp[5 * 65]); o.w = cvt_pk_bf16(sp[6 * 65], sp[7 * 65]);
        *(u32x4*)(c.dst + (size_t)n * c.K + 8 * ch) = o; }
    LDS_WAIT();
}

__device__ __forceinline__ void sincos_acc(float angf, float& c, float& s) {
    const double a = (double)angf;
    const double k = __builtin_rint(a * 0.63661977236758134308);
    const double r = (a - k * 1.57079632679489655800) - k * 6.12323399573676603587e-17;
    const double r2 = r * r;
    double sp = -2.50521083854417187751e-08; sp = sp * r2 + 2.75573192239858906526e-06; sp = sp * r2 - 1.98412698412698412698e-04; sp = sp * r2 + 8.33333333333333333333e-03; sp = sp * r2 - 1.66666666666666666667e-01;
    const double sr = r + r * r2 * sp + r * r2 * r2 * r2 * r2 * r2 * r2 * 1.60590438368216145994e-10;
    double cp = 2.08767569878680989792e-09; cp = cp * r2 - 2.75573192239858906526e-07; cp = cp * r2 + 2.48015873015873015873e-05; cp = cp * r2 - 1.38888888888888888889e-03; cp = cp * r2 + 4.16666666666666666667e-02; cp = cp * r2 - 0.5;
    const double cr = 1.0 + r2 * cp;
    const int q = ((int)(long long)k) & 3;
    const double sv = (q == 0) ? sr : (q == 1) ? cr : (q == 2) ? -sr : -cr;
    const double cv = (q == 0) ? cr : (q == 1) ? -sr : (q == 2) ? -cr : sr;
    c = (float)cv; s = (float)sv;
}

__global__ void __launch_bounds__(512, 2) fwd_kernel(Args args) {
    extern __shared__ __attribute__((aligned(16))) unsigned char lds_raw[];
    LAS unsigned char* lds = (LAS unsigned char*)lds_raw;
    volatile LAS unsigned* MISC = (volatile LAS unsigned*)(lds + MISC_OFF);
    for (int u = threadIdx.x; u < (LDS_BYTES - LDSCTL_OFF) / 4; u += 512) ((LAS unsigned*)(lds + LDSCTL_OFF))[u] = 0u;
    __syncthreads();
    XcdBarrier bar = xcd_barrier_post((unsigned*)(args.ws + WS_CTL) + CW_BAR, MISC + 8);
    {   unsigned bq_ = blockIdx.x; asm volatile("" : "+s"(bq_)); const unsigned mmv_ = __builtin_amdgcn_readfirstlane(bar.x != (bq_ & 7u) ? 1u : 0u);
        if (mmv_ != 0u && threadIdx.x == 0) (void)xb_add(&bar.bar[XL_MM], 1u); }
    const int G = gridDim.x;
    const int wave_s = __builtin_amdgcn_readfirstlane(threadIdx.x >> 6);
#define TID_NOW(var) int var; { int z_ = 0; asm volatile("" : "+s"(z_)); var = wave_s * 64 + (int)__builtin_amdgcn_mbcnt_hi(~0u, __builtin_amdgcn_mbcnt_lo(~0u, (unsigned)z_)); }
#define GRID_BARRIER() do { TID_NOW(tb_); xcd_barrier(bar, tb_); } while (0)
#define LOC_OK() ({ int zq_ = 0; asm volatile("" : "+s"(zq_)); __builtin_amdgcn_readfirstlane(MISC[10 + zq_]); })
#define SEAM_LOCAL() do { TID_NOW(tb_); if (LOC_OK()) xcd_local_barrier(bar, tb_); else xcd_barrier(bar, tb_); } while (0)
#define PHASE_BEGIN() TID_NOW(tid); int bid = blockIdx.x; asm volatile("" : "+s"(bid)); unsigned char* ws = args.ws; asm volatile("" : "+s"(ws)); \
    const int lane = tid & 63, wave = __builtin_amdgcn_readfirstlane(tid >> 6); const int gw = bid * 8 + wave, ngw = G * 8; (void)lane; (void)wave; (void)gw; (void)ngw; \
    float* X = args.out; bf16_t* XB = (bf16_t*)(ws + WS_XB); float* SS = (float*)(ws + WS_SS); (void)X; (void)XB; (void)SS;
#define MIXBUFS() pg8::MixBufs MB; { unsigned char* ov = ws + WS_BIG; MB.LAT = (bf16_t*)(ov + OV_LAT); MB.LATSS = (float*)(ov + OV_LATSS); MB.DQ = (bf16_t*)(ov + OV_DQ); MB.DK = (bf16_t*)(ov + OV_DK); MB.DV = (bf16_t*)(ov + OV_DV); \
      MB.NQ = (bf16_t*)(ov + OV_NQ); MB.NKV = (bf16_t*)(ov + OV_NKV); MB.GATES = (float*)(ov + OV_GATES) + (size_t)l * M * 16; MB.MK = (bf16_t*)(ov + OV_MK); MB.ROPE = (const float*)(ws + WS_ROPE); } \
    bf16_t* MQ = (bf16_t*)(ws + WS_BIG + OV_MQ); bf16_t* MV = (bf16_t*)(ws + WS_BIG + OV_MV); (void)MQ; (void)MV;


    {
        PHASE_BEGIN();
        LAS float* scr = (LAS float*)(lds + wave * 16640);
        {
        {
            float va[64], vb[64]; ConvItem ca, cb; int it = gw;
            if (it < CI_TOTAL) { conv_decode(it, args, ws, lane, ca); conv_load(ca, va); }
            while (it < CI_TOTAL) {
                const int it1 = it + ngw;
                if (it1 < CI_TOTAL) { conv_decode(it1, args, ws, lane, cb); conv_load(cb, vb); }
                conv_store(ca, va, scr, lane);
                if (it1 >= CI_TOTAL) break;
                const int it2 = it1 + ngw;
                if (it2 < CI_TOTAL) { conv_decode(it2, args, ws, lane, ca); conv_load(ca, va); }
                conv_store(cb, vb, scr, lane);
                it = it2;
            }
        }
        {
            const float INVF[32] = {0x1.0000000000000p+0f, 0x1.7ff2240000000p-1f, 0x1.1feb340000000p-1f, 0x1.afd1360000000p-2f, 0x1.43d1360000000p-2f, 0x1.e5a8480000000p-3f, 0x1.6c310e0000000p-3f, 0x1.111aec0000000p-3f,
                0x1.99999a0000000p-4f, 0x1.33281a0000000p-4f, 0x1.ccab860000000p-5f, 0x1.59742c0000000p-5f, 0x1.030dc40000000p-5f, 0x1.8486a00000000p-6f, 0x1.235a720000000p-6f, 0x1.b4f7e40000000p-7f,
                0x1.47ae140000000p-7f, 0x1.eb735e0000000p-8f, 0x1.7089380000000p-8f, 0x1.145cee0000000p-8f, 0x1.9e7c6e0000000p-9f, 0x1.36d2180000000p-9f, 0x1.d22a500000000p-10f, 0x1.5d931c0000000p-10f,
                0x1.0624de0000000p-10f, 0x1.89291a0000000p-11f, 0x1.26d42c0000000p-11f, 0x1.ba2e4c0000000p-12f, 0x1.4b96be0000000p-12f, 0x1.f150280000000p-13f, 0x1.74eea60000000p-13f, 0x1.17a8e40000000p-13f};
            float* rope = (float*)(ws + WS_ROPE);
            for (int e = bid * 512 + tid; e < SEQ * 32; e += G * 512) { const int pos = e >> 5, i = e & 31; float fi = INVF[0];
#pragma unroll
                for (int q = 1; q < 32; ++q) fi = (i == q) ? INVF[q] : fi;
                const float ang = (float)pos * fi; float c, sn; sincos_acc(ang, c, sn); rope[2 * e] = c; rope[2 * e + 1] = sn; }
        }
        {
            float* cb = (float*)(ws + WS_CB);
            for (int o = gw; o < DEPTH * 2 * 128; o += ngw) { const int l = o >> 8, kv = (o >> 7) & 1, n = o & 127;
                const float* pe = args.in[10] + (size_t)l * 4096; const float* w1 = (kv ? args.in[13] : args.in[11]) + (size_t)l * 4096 * 128 + n; float a = 0.f;
                for (int r = lane; r < 4096; r += 64) a += pe[r] * w1[(size_t)r * 128];
#pragma unroll
                for (int of = 1; of < 64; of <<= 1) a += shx(a, of, lane);
                if (lane == 0) cb[o] = a; }
        }
        const float* x0 = args.in[0];
        for (int row = gw; row < M; row += ngw) {
            const f32x4* xr = (const f32x4*)(x0 + (size_t)row * DM) + lane; u32x2* xb = (u32x2*)(XB + (size_t)row * DM) + lane;
            float s = 0.f;
#pragma unroll
            for (int j = 0; j < 8; ++j) { const f32x4 v = xr[64 * j]; u32x2 w; w.x = cvt_pk_bf16(v[0], v[1]); w.y = cvt_pk_bf16(v[2], v[3]); xb[64 * j] = w; s += (v[0] * v[0] + v[1] * v[1]) + (v[2] * v[2] + v[3] * v[3]); }
#pragma unroll
            for (int o = 1; o < 64; o <<= 1) s += shx(s, o, lane);
            if (lane < 32) SS[(size_t)row * 32 + lane] = lane == 0 ? s : 0.f;
        }
        }
    }
    GRID_BARRIER();
    {   TID_NOW(t0_); if (t0_ == 0) { unsigned* bb_ = bar.bar; MISC[10] = (xb_ld(&bb_[XL_MM]) == 0u && MISC[8] * 8u == (unsigned)G && MISC[9] == 8u) ? 1u : 0u; }
        __syncthreads(); }

    for (int j = 0; j < 2 * DEPTH; ++j) {
        const int l = j >> 1, which = j & 1;
        {
            PHASE_BEGIN(); unsigned char* lw = ws + WS_W + (size_t)l * LW_SIZE;
            const bool lok = LOC_OK() != 0u; unsigned* cc = (unsigned*)(ws + WS_CTL) + CW_CHAIN;
            pg8::Gemm g{XB, (const bf16_t*)(lw + (which ? LW_W1B : LW_W1A)), M, NFF, DM, DM}; pg8::ChainOrder S; S.init(M, NFF, G, (lok && !which) ? ((bid + 128) & 255) : bid);
            S.need_cnt = (lok && j > 0) ? cc + (which ? 3 * (j - 1) + 2 : 3 * (j - 1) + 1) * 2048 : nullptr; S.need = 64u; S.done_cnt = lok ? cc + (3 * j) * 2048 : nullptr; S.tmo = (unsigned*)(ws + WS_CTL) + CW_BAR + XB_TMO;
            LAS float* rc = (LAS float*)(lds + pg8::RC_OFF + wave * pg8::RC_WAVE); if (lane == 0) ((LAS int*)rc)[128] = -1;
            pg8::EpiSwiGLU E{(bf16_t*)(ws + WS_HID), SS, rc};
            pg8::gemm_phase<pg8::EpiSwiGLU, pg8::ChainOrder, true>(lds, g, S, E, tid);
        }
        if (!LOC_OK()) GRID_BARRIER();
        {
            PHASE_BEGIN(); unsigned char* lw = ws + WS_W + (size_t)l * LW_SIZE;
            const bool lok = LOC_OK() != 0u; unsigned* cc = (unsigned*)(ws + WS_CTL) + CW_CHAIN;
            pg8::Gemm g{(const bf16_t*)(ws + WS_HID), (const bf16_t*)(lw + (which ? LW_W2B : LW_W2A)), M, DM, FF, FF}; pg8::ChainOrder S; S.init(M, DM, G, bid); S.rev = 1;
            S.need_cnt = lok ? cc + (3 * j) * 2048 : nullptr; S.need = (unsigned)(NFF / 256) * 8u; S.done_cnt = lok ? cc + (3 * j + 1) * 2048 : nullptr; S.tmo = (unsigned*)(ws + WS_CTL) + CW_BAR + XB_TMO;
            pg8::EpiResid E{j == 0 ? args.in[0] : nullptr, j + 1 == 2 * DEPTH ? X : nullptr, XB, SS, 0.5f};
            pg8::gemm_phase<pg8::EpiResid, pg8::ChainOrder, true>(lds, g, S, E, tid);
        }
        if (which) { if (j + 1 == 2 * DEPTH || !LOC_OK()) SEAM_LOCAL(); continue; }
        GRID_BARRIER();
        {
            PHASE_BEGIN(); MIXBUFS(); unsigned char* lw = ws + WS_W + (size_t)l * LW_SIZE;
            pg8::Gemm g{XB, (const bf16_t*)(lw + LW_WM), M, NMIX, DM, DM}; pg8::StaticOrder S; S.init(M, NMIX, G, bid);
            LAS float* rc = (LAS float*)(lds + pg8::RC_OFF + wave * pg8::RC_WAVE); if (lane == 0) ((LAS int*)rc)[128] = -1;
            pg8::EpiMixIn E{MB, SS, rc};
            pg8::gemm_phase<pg8::EpiMixIn, pg8::StaticOrder, true>(lds, g, S, E, tid);
        }
        GRID_BARRIER();
        {
            PHASE_BEGIN(); MIXBUFS(); unsigned char* lw = ws + WS_W + (size_t)l * LW_SIZE; const int c_ = bid;
            if (c_ >= 16) {
                pg8::Gemm g{MB.LAT, (const bf16_t*)(lw + LW_WU), M, NUP, 512, LATW}; pg8::StaticOrder S; S.init(M, NUP, G - 16, c_ - 16); S.acol_pn = 5; S.acol_off = 512;
                pg8::EpiUp E{MQ, MB.MK, MV, MB.LATSS, MB.ROPE};
                pg8::gemm_phase<pg8::EpiUp, pg8::StaticOrder, true>(lds, g, S, E, tid);
            } else {
                const int kv = c_ >> 3;
                const bf16_t* Ain = MB.NKV + (size_t)kv * ((size_t)M * 128);
                bf16_t* H1 = (bf16_t*)(ws + WS_H1) + ((size_t)l * 2 + kv) * 2048 * 128;
                pg8::Gemm g{Ain, (const bf16_t*)(lw + (kv ? LW_WCV : LW_WCK)), 2048, 256, 4096, 2048}; pg8::StaticOrder S; S.init(2048, 256, 8, c_ & 7);
                pg8::EpiCmp E{H1, (const float*)(ws + WS_CB) + (l * 2 + kv) * 128};
                pg8::gemm_phase<pg8::EpiCmp, pg8::StaticOrder, true>(lds, g, S, E, tid);
                VM_WAIT(); __syncthreads();
                const float* w2 = (kv ? args.in[14] : args.in[12]) + (size_t)l * 128 * 128;
                LAS bf16_t* w2t = (LAS bf16_t*)lds;
                for (int e = tid; e < 128 * 128; e += 512) { const int k = e >> 7, n = e & 127; const float wv = w2[e]; const unsigned hb = cvt_pk_bf16(wv, 0.f) & 0xffffu;
                    w2t[n * 136 + k] = (bf16_t)hb; w2t[128 * 136 + n * 136 + k] = (bf16_t)(cvt_pk_bf16(wv - __uint_as_float(hb << 16), 0.f) & 0xffffu); }
                __syncthreads();
                {
                    bf16_t* KC = (bf16_t*)(ws + WS_KC) + ((size_t)l * 2 + kv) * 2048 * 128;
                    const int r32 = lane & 31, hi = lane >> 5, rowb = (c_ & 7) * 256 + wave * 32;
                    bf16x8 af[8];
#pragma unroll
                    for (int ks = 0; ks < 8; ++ks) af[ks] = *(const bf16x8*)(H1 + (size_t)(rowb + r32) * 128 + ks * 16 + hi * 8);
#pragma unroll
                    for (int nb = 0; nb < 4; ++nb) { f32x16 acc = {};
#pragma unroll
                        for (int ks = 0; ks < 8; ++ks) { const bf16x8 bfr = *(const LAS bf16x8*)(w2t + (nb * 32 + r32) * 136 + ks * 16 + hi * 8);
                            const bf16x8 bfl = *(const LAS bf16x8*)(w2t + 128 * 136 + (nb * 32 + r32) * 136 + ks * 16 + hi * 8);
                            acc = __builtin_amdgcn_mfma_f32_32x32x16_bf16(af[ks], bfr, acc, 0, 0, 0); acc = __builtin_amdgcn_mfma_f32_32x32x16_bf16(af[ks], bfl, acc, 0, 0, 0); }
#pragma unroll
                        for (int r = 0; r < 16; ++r) KC[(size_t)(rowb + att::crow(r, hi)) * 128 + nb * 32 + r32] = (bf16_t)(cvt_pk_bf16(acc[r], 0.f) & 0xffffu); }
                }
                __syncthreads();
            }
            {
            gu32* qctr = (gu32*)(ws + WS_CTL) + CW_QUEUE + (l * 2 + 0) * 64;
            for (;;) {
                TID_NOW(tq);
                if (tq == 0) MISC[0] = __hip_atomic_fetch_add(qctr, 1u, __ATOMIC_RELAXED, __HIP_MEMORY_SCOPE_AGENT);
                __syncthreads();
                const int u = (int)MISC[0];
                __syncthreads();
                if (u >= 768) break;
                const int g = u >> 8, v = u & 255, dsh = 2 * g, d = 1 << dsh, nlb = 64 >> dsh;
                const int lb = v % nlb, w = v / nlb, r = w & (d - 1), bs = w >> dsh, sl = bs & 1, b = bs >> 1, head = 2 * g + sl;
                const size_t tokb = (size_t)b * SEQ + r;
                att::PolDil p; p.Q = MB.DQ + (tokb + (size_t)lb * 256 * d) * 768 + head * 128; p.q_pitch = 768 * d;
                p.K = MB.DK + tokb * 768 + head * 128; p.k_pitch = 768 * d; p.V = MB.DV + tokb * 768 + head * 128; p.v_pitch = 768 * d;
                p.P0 = lb * 256; p.W = 129; p.j0 = lb == 0 ? 0 : 4 * lb - 2; p.nt = 4 * lb + 4 - p.j0; p.mfix = 0.f;
                p.sl2 = att::alibi_slope(head + 1) * (float)d * 1.4426950408889634f;
                p.O = (bf16_t*)(ws + WS_OCAT) + (tokb + (size_t)lb * 256 * d) * DM + 768 + head * 128; p.o_pitch = DM * d;
                p.LSE = (float*)(ws + WS_DLSE) + (size_t)l * M * 8 + (tokb + (size_t)lb * 256 * d) * 8 + head; p.lse_pitch = 8 * d;
                float m_, l_; att::attn_block(p, lds, tq, m_, l_);
            }
            }
        }
        GRID_BARRIER();
        {
            PHASE_BEGIN(); MIXBUFS();
            att::NsaBufs nb; nb.NQ = MB.NQ; nb.NKV = MB.NKV; nb.KC = (const bf16_t*)(ws + WS_KC) + (size_t)l * 2 * 2048 * 128; nb.VC = nb.KC + 2048 * 128; nb.GATES = MB.GATES; nb.NSAF = (float*)(ws + WS_NSAF); nb.OCAT = (bf16_t*)(ws + WS_OCAT);
            {
            gu32* qctr = (gu32*)(ws + WS_CTL) + CW_QUEUE + (l * 2 + 1) * 64;
            const int ntot = 552 + 512 + 216 + 128;
            for (;;) {
                TID_NOW(tq); const int lane_q = tq & 63, wave_q = tq >> 6;
                if (tq == 0) MISC[0] = __hip_atomic_fetch_add(qctr, 1u, __ATOMIC_RELAXED, __HIP_MEMORY_SCOPE_AGENT);
                __syncthreads();
                int u = (int)MISC[0];
                __syncthreads();
                if (u >= ntot) break;
                int mla = -1;
                if (u < 552) mla = u; else if (u < 552 + 512) { const int n = u - 552; att::nsa_unit(nb, n >> 8, (n & 255) * 64, lds, tq); }
                else if (u < 552 + 512 + 216) mla = u - 512;
                else {
                    const int tb = (u - (552 + 512 + 216)) * 256; const float* dl = (const float*)(ws + WS_DLSE) + (size_t)l * M * 8; bf16_t* oc = (bf16_t*)(ws + WS_OCAT);
                    for (int k = wave_q; k < 256; k += 8) { const size_t tok = (size_t)tb + k; const float* lp = dl + tok * 8;
                        for (int ch = lane_q; ch < 96; ch += 64) { const int head = ch >> 4, slot = head & 1;
                            const float a0 = lp[slot], a1 = lp[2 + slot], a2 = lp[4 + slot], mx = fmaxf(a0, fmaxf(a1, a2));
                            const float e0 = __expf(a0 - mx), e1 = __expf(a1 - mx), e2 = __expf(a2 - mx), mine = head < 2 ? e0 : (head < 4 ? e1 : e2), al = mine / (e0 + e1 + e2);
                            u32x4* pp = (u32x4*)(oc + tok * DM + 768 + ch * 8); u32x4 w = *pp; unsigned* wp = (unsigned*)&w;
#pragma unroll
                            for (int e = 0; e < 4; ++e) { const float lo = __uint_as_float(wp[e] << 16) * al, hi_ = __uint_as_float(wp[e] & 0xffff0000u) * al; wp[e] = cvt_pk_bf16(lo, hi_); }
                            *pp = w; } }
                }
                if (mla >= 0) {
                    const int qb = 63 - mla / 12, bh = mla % 12, b = bh / 6, h = bh - b * 6;
                    att::PolMLA p; p.Q = MQ + ((size_t)b * SEQ + (size_t)qb * 256) * 1152 + h * 192; p.q_pitch = 1152;
                    p.K = MB.MK + (size_t)b * SEQ * 1152 + h * 192; p.k_pitch = 1152; p.V = MV + (size_t)b * SEQ * 768 + h * 128; p.v_pitch = 768;
                    p.nt = 4 * (qb + 1); p.j0 = 0; p.P0 = qb * 256; p.W = 0x40000000; p.mfix = 0.f;
                    p.O = (bf16_t*)(ws + WS_OCAT) + ((size_t)b * SEQ + (size_t)qb * 256) * DM + h * 128; p.o_pitch = DM;
                    float m_, l_; att::attn_block(p, lds, tq, m_, l_);
                }
            }
            }
        }
        GRID_BARRIER();
        {
            PHASE_BEGIN(); unsigned char* lw = ws + WS_W + (size_t)l * LW_SIZE;
            const bool lok = LOC_OK() != 0u; unsigned* cc = (unsigned*)(ws + WS_CTL) + CW_CHAIN;
            pg8::Gemm g{(const bf16_t*)(ws + WS_OCAT), (const bf16_t*)(lw + LW_WO), M, DM, DM, DM}; pg8::ChainOrder S; S.init(M, DM, G, bid); S.rev = 1;
            S.need_cnt = nullptr; S.need = 0u; S.done_cnt = lok ? cc + (3 * j + 2) * 2048 : nullptr; S.tmo = (unsigned*)(ws + WS_CTL) + CW_BAR + XB_TMO;
            pg8::EpiResid E{nullptr, nullptr, XB, SS, 1.0f};
            pg8::gemm_phase<pg8::EpiResid, pg8::ChainOrder, true>(lds, g, S, E, tid);
        }
        if (!LOC_OK()) GRID_BARRIER();
    }

    {
        PHASE_BEGIN();
        const float* gfin = args.in[19];
        const int rpx = M / 8, rbase = (bid & 7) * rpx;
        for (int row = rbase + (bid >> 3) * 8 + wave; row < rbase + rpx; row += (G >> 3) * 8) {
            float s = SS[(size_t)row * 32 + (lane & 31)];
#pragma unroll
            for (int o = 1; o < 32; o <<= 1) s += shx(s, o, lane);
            const float r = rsqrtf(s * (1.0f / DM) + RMS_EPS);
            f32x4* xo = (f32x4*)(X + (size_t)row * DM) + lane; const f32x4* gp = (const f32x4*)gfin + lane;
#pragma unroll
            for (int jj = 0; jj < 8; ++jj) { const f32x4 v = xo[64 * jj]; xo[64 * jj] = v * r * gp[64 * jj]; }
        }
    }
}

extern "C" void kernel_launch(void* const* d_in, const int* in_sizes, int n_in, void* d_out, int out_size, void* d_ws, size_t ws_size, hipStream_t stream) {
    static int grid = 0;
    if (grid == 0) {
        if (n_in != 20 || out_size != M * DM || ws_size < WS_END_V1) { fprintf(stderr, "kernel_launch: unexpected shapes (n_in %d out %d ws %zu)\n", n_in, out_size, ws_size); grid = -1; return; }
        int dev = 0, cus = 0, per_cu = 0;
        (void)hipGetDevice(&dev); (void)hipDeviceGetAttribute(&cus, hipDeviceAttributeMultiprocessorCount, dev);
        if (hipFuncSetAttribute((const void*)fwd_kernel, hipFuncAttributeMaxDynamicSharedMemorySize, LDS_BYTES) != hipSuccess) { fprintf(stderr, "kernel_launch: hipFuncSetAttribute failed\n"); grid = -1; return; }
        (void)hipOccupancyMaxActiveBlocksPerMultiprocessor(&per_cu, (const void*)fwd_kernel, 512, LDS_BYTES);
        (void)hipGetLastError();
        grid = cus > 0 ? cus : 256;
        fprintf(stderr, "kernel_launch: grid %d (occupancy query %d)\n", grid, per_cu);
    }
    if (grid < 0) return;
    (void)hipMemsetAsync((char*)d_ws + WS_CTL, 0, CTL_ZERO_BYTES, stream);
    Args a{};
    for (int i = 0; i < 20; ++i) a.in[i] = (const float*)d_in[i];
    a.out = (float*)d_out; a.ws = (unsigned char*)d_ws;
    hipLaunchKernelGGL(fwd_kernel, dim3(grid), dim3(512), LDS_BYTES, stream, a);
}
```
